# Optimizing an MI355X kernel written in HIP

```python
import jax, jax.numpy as jnp
from jax import lax
import numpy as np

D_MODEL = 1024
BATCH = 2
SEQ = 8192
DEPTH = 1

CHUNK = 64
HEAD_DIM = 64
RWKV_HEADS = 8
D_RWKV = RWKV_HEADS * HEAD_DIM
SB_HEADS = 8
D_SB = SB_HEADS * HEAD_DIM
DECAY_LORA = 64
AAA_LORA = 64
GATE_LORA = 128
D_FF = 4 * D_MODEL
Q_BLOCK = 128
DEEPNORM_ALPHA = (2.0 * DEPTH) ** 0.25
DEEPNORM_BETA = (8.0 * DEPTH) ** -0.25
LN_EPS = 1e-5
ADALN_EPS = 1e-6
GN_EPS = 64e-5
RW_SIZES = (D_RWKV, D_RWKV, D_RWKV, DECAY_LORA, AAA_LORA, GATE_LORA)
REST_SIZES = (D_SB, D_SB, D_SB, D_MODEL, D_MODEL)
D_SHIFT = sum(RW_SIZES)
D_IN = D_SHIFT + sum(REST_SIZES)

kernel_name = 'rwkv7_stickbreaking_hybrid_deepnorm_adaln'


def _split(t, sizes):
    return jnp.split(t, np.cumsum(sizes)[:-1].tolist(), axis=-1)


def _layernorm(x, g, b):
    x32 = x.astype(jnp.float32)
    mu = jnp.mean(x32, axis=-1, keepdims=True)
    var = jnp.mean(jnp.square(x32 - mu), axis=-1, keepdims=True)
    return (x32 - mu) * lax.rsqrt(var + LN_EPS) * g + b


def _modulate(x, shift, scale):
    x32 = x.astype(jnp.float32)
    mu = jnp.mean(x32, axis=-1, keepdims=True)
    var = jnp.mean(jnp.square(x32 - mu), axis=-1, keepdims=True)
    return (x32 - mu) * lax.rsqrt(var + ADALN_EPS) * (1.0 + scale) + shift


def _rwkv7_scan(r, w, k, v, a, b):
    def step(state, inp):
        r_t, w_t, k_t, v_t, a_t, b_t = inp
        sa = jnp.einsum('bhvk,bhk->bhv', state, a_t)
        state = (state * w_t[:, :, None, :] + sa[..., None] * b_t[:, :, None, :]
                 + v_t[..., None] * k_t[:, :, None, :])
        return state, jnp.einsum('bhvk,bhk->bhv', state, r_t)
    bsz, _, nh, n = r.shape
    xs = tuple(jnp.moveaxis(t, 1, 0) for t in (r, w, k, v, a, b))
    _, y = lax.scan(step, jnp.zeros((bsz, nh, n, n), jnp.float32), xs)
    return jnp.moveaxis(y, 0, 1)


def _stick_breaking(q, k, v):
    bsz, s_len, nh, d = q.shape
    nb = s_len // Q_BLOCK
    scale = d ** -0.5
    qh = q.astype(jnp.float32).transpose(0, 2, 1, 3)
    kh = k.astype(jnp.float32).transpose(0, 2, 1, 3)
    vh = v.astype(jnp.float32).transpose(0, 2, 1, 3)
    qb = qh.reshape(bsz, nh, nb, Q_BLOCK, d).transpose(2, 0, 1, 3, 4)
    key_pos = jnp.arange(s_len)

    def block(args):
        q_blk, i = args
        q_pos = i * Q_BLOCK + jnp.arange(Q_BLOCK)
        mask = key_pos[None, :] < q_pos[:, None]
        z = jnp.einsum('bhqd,bhkd->bhqk', q_blk, kh) * scale
        log_beta = jax.nn.log_sigmoid(z)
        log_1m = jnp.where(mask, jax.nn.log_sigmoid(-z), 0.0)
        between = lax.cumsum(log_1m, axis=3, reverse=True) - log_1m
        att = jnp.where(mask, jnp.exp(log_beta + between), 0.0)
        return jnp.einsum('bhqk,bhkd->bhqd', att, vh)

    o = lax.map(block, (qb, jnp.arange(nb)))
    return o.transpose(1, 0, 3, 2, 4).reshape(bsz, s_len, nh * d)


def _group_norm(y, g, b):
    mu = jnp.mean(y, axis=-1, keepdims=True)
    var = jnp.mean(jnp.square(y - mu), axis=-1, keepdims=True)
    return (y - mu) * lax.rsqrt(var + GN_EPS) * g.reshape(RWKV_HEADS, HEAD_DIM) + b.reshape(RWKV_HEADS, HEAD_DIM)


def _time_mix(h, w_in, mu_shift, rw_w0, rw_w2, rw_a0, rw_a2, rw_g2, rw_kk, rw_ka, rw_rk,
              rw_gn_g, rw_gn_b, w_branch_a, w_branch_b, w_out):
    bsz, s_len, _ = h.shape
    z = h @ w_in
    z_rw, z_rest = z[..., :D_SHIFT], z[..., D_SHIFT:]
    z_prev = jnp.pad(z_rw, ((0, 0), (1, 0), (0, 0)))[:, :s_len]
    z_rw = z_rw + mu_shift * (z_prev - z_rw)
    r, k, v, zw, za, zg = _split(z_rw, RW_SIZES)
    q_sb, k_sb, v_sb, gate_a, gate_b = _split(z_rest, REST_SIZES)

    heads = lambda t: t.reshape(bsz, s_len, RWKV_HEADS, HEAD_DIM).astype(jnp.float32)
    w_log = -jax.nn.softplus(-(rw_w0 + jnp.tanh(zw) @ rw_w2)) - 0.5
    decay = jnp.exp(-jnp.exp(w_log.astype(jnp.float32)))
    a_rate = jax.nn.sigmoid(rw_a0 + za @ rw_a2)
    g = jax.nn.sigmoid(zg) @ rw_g2
    kk = heads(k * rw_kk)
    kk = kk / jnp.maximum(jnp.sqrt(jnp.sum(kk * kk, axis=-1, keepdims=True)), 1e-12)
    k = k * (1.0 + (a_rate - 1.0) * rw_ka)
    rh, kh, vh, ah = heads(r), heads(k), heads(v), heads(a_rate)
    y = _rwkv7_scan(rh, heads(decay), kh, vh, -kk, kk * ah)
    y = _group_norm(y, rw_gn_g, rw_gn_b)
    y = y + jnp.sum(rh * kh * rw_rk, axis=-1, keepdims=True) * vh
    y_a = (y.reshape(bsz, s_len, D_RWKV) * g) @ w_branch_a

    sb_heads = lambda t: t.reshape(bsz, s_len, SB_HEADS, HEAD_DIM)
    o = _stick_breaking(sb_heads(q_sb), sb_heads(k_sb), sb_heads(v_sb))
    y_b = o @ w_branch_b

    merged = jax.nn.sigmoid(gate_a) * y_a + jax.nn.sigmoid(gate_b) * y_b
    return merged @ w_out


def _layer(x, c, w_ada, b_ada, w_in, mu_shift, rw_w0, rw_w2, rw_a0, rw_a2, rw_g2, rw_kk, rw_ka,
           rw_rk, rw_gn_g, rw_gn_b, w_branch_a, w_branch_b, w_out, ln1_g, ln1_b,
           w_ff1, b_ff1, w_ff2, b_ff2, ln2_g, ln2_b):
    ada = jax.nn.silu(c) @ w_ada + b_ada
    sh1, sc1, g1, sh2, sc2, g2 = jnp.split(ada[:, None, :], 6, axis=-1)
    h = _modulate(x, sh1, sc1)
    mix = _time_mix(h, w_in, mu_shift, rw_w0, rw_w2, rw_a0, rw_a2, rw_g2, rw_kk, rw_ka, rw_rk,
                    rw_gn_g, rw_gn_b, w_branch_a, w_branch_b, w_out)
    x = _layernorm(DEEPNORM_ALPHA * x + g1 * mix, ln1_g, ln1_b)
    h = _modulate(x, sh2, sc2)
    ff = jnp.square(jax.nn.relu(h @ w_ff1 + b_ff1)) @ w_ff2 + b_ff2
    return _layernorm(DEEPNORM_ALPHA * x + g2 * ff, ln2_g, ln2_b)


def setup_inputs(seed: int = 0) -> dict:
    key = jax.random.key(seed)
    ks = jax.random.split(key, 28)
    nrm = lambda i, shape, s: jax.random.normal(ks[i], shape, jnp.float32) * s
    L = DEPTH
    beta = DEEPNORM_BETA
    col_scale = jnp.concatenate([
        jnp.ones((2 * D_RWKV,), jnp.float32), jnp.full((D_RWKV,), beta, jnp.float32),
        jnp.ones((DECAY_LORA + AAA_LORA + GATE_LORA + 2 * D_SB,), jnp.float32),
        jnp.full((D_SB,), beta, jnp.float32), jnp.ones((2 * D_MODEL,), jnp.float32)])
    return {
        'x': nrm(0, (BATCH, SEQ, D_MODEL), 1.0),
        'c': nrm(1, (BATCH, D_MODEL), 1.0),
        'w_ada': nrm(2, (L, D_MODEL, 6 * D_MODEL), D_MODEL ** -0.5),
        'b_ada': nrm(3, (L, 6 * D_MODEL), 0.02),
        'w_in': nrm(4, (L, D_MODEL, D_IN), D_MODEL ** -0.5) * col_scale,
        'mu_shift': jax.random.uniform(ks[5], (L, D_SHIFT), jnp.float32),
        'rw_w0': jax.random.uniform(ks[6], (L, D_RWKV), jnp.float32, -6.0, 1.0),
        'rw_w2': nrm(7, (L, DECAY_LORA, D_RWKV), 0.1 * DECAY_LORA ** -0.5),
        'rw_a0': nrm(8, (L, D_RWKV), 0.5),
        'rw_a2': nrm(9, (L, AAA_LORA, D_RWKV), 0.5 * AAA_LORA ** -0.5),
        'rw_g2': nrm(10, (L, GATE_LORA, D_RWKV), GATE_LORA ** -0.5),
        'rw_kk': 0.85 + nrm(11, (L, D_RWKV), 0.05),
        'rw_ka': 1.0 + nrm(12, (L, D_RWKV), 0.05),
        'rw_rk': nrm(13, (L, RWKV_HEADS, HEAD_DIM), 0.1),
        'rw_gn_g': 1.0 + nrm(14, (L, D_RWKV), 0.05),
        'rw_gn_b': nrm(15, (L, D_RWKV), 0.02),
        'w_branch_a': nrm(16, (L, D_RWKV, D_MODEL), beta * D_RWKV ** -0.5),
        'w_branch_b': nrm(17, (L, D_SB, D_MODEL), beta * D_SB ** -0.5),
        'w_out': nrm(18, (L, D_MODEL, D_MODEL), beta * D_MODEL ** -0.5),
        'ln1_g': 1.0 + nrm(19, (L, D_MODEL), 0.05),
        'ln1_b': nrm(20, (L, D_MODEL), 0.02),
        'w_ff1': nrm(21, (L, D_MODEL, D_FF), beta * D_MODEL ** -0.5),
        'b_ff1': nrm(22, (L, D_FF), 0.02),
        'w_ff2': nrm(23, (L, D_FF, D_MODEL), beta * D_FF ** -0.5),
        'b_ff2': nrm(24, (L, D_MODEL), 0.02),
        'ln2_g': 1.0 + nrm(25, (L, D_MODEL), 0.05),
        'ln2_b': nrm(26, (L, D_MODEL), 0.02),
    }


def reference(x, c, w_ada, b_ada, w_in, mu_shift, rw_w0, rw_w2, rw_a0, rw_a2, rw_g2, rw_kk, rw_ka,
              rw_rk, rw_gn_g, rw_gn_b, w_branch_a, w_branch_b, w_out, ln1_g, ln1_b,
              w_ff1, b_ff1, w_ff2, b_ff2, ln2_g, ln2_b):
    in_dtype = x.dtype
    layer_params = (w_ada, b_ada, w_in, mu_shift, rw_w0, rw_w2, rw_a0, rw_a2, rw_g2, rw_kk, rw_ka,
                    rw_rk, rw_gn_g, rw_gn_b, w_branch_a, w_branch_b, w_out, ln1_g, ln1_b,
                    w_ff1, b_ff1, w_ff2, b_ff2, ln2_g, ln2_b)
    for l in range(DEPTH):
        x = _layer(x, c, *[p[l] for p in layer_params])
    return x.astype(in_dtype)
```

```cpp
#include <hip/hip_runtime.h>
#include <hip/hip_cooperative_groups.h>
#include <cstdio>
#include <cstdint>
namespace cg = cooperative_groups;
namespace pg8 {
#define PG8_LAS __attribute__((address_space(3)))
typedef unsigned short bf16_t;
typedef _Float16 bf16x8 __attribute__((ext_vector_type(8)));
typedef float f32x4 __attribute__((ext_vector_type(4)));
typedef unsigned u32x4 __attribute__((ext_vector_type(4)));
constexpr int BM = 256, BK = 64, HALF = 128, HTB = HALF * BK * 2  , STAGE_BYTES = 8 * HTB, NXCD = 8, WGM = 8;

__host__ __device__ __forceinline__ int lds_byte(int r, int c) { const int st = (r >> 4) * 2 + (c >> 5), rr = r & 15, cc = c & 31, ob = rr * 64 + cc * 2; return st * 1024 + (ob ^ (((ob >> 9) & 1) << 5)); }
__host__ __device__ __forceinline__ void stage_rc(int b, int& R, int& C) { const int st = b / 1024, sb = b % 1024, swz = sb ^ (((sb >> 9) & 1) << 5); R = (st >> 1) * 16 + swz / 64; C = (st & 1) * 32 + (swz % 64) / 2; }
__host__ __device__ __forceinline__ int perm32(int rho) { const int n = rho >> 4, i = rho & 15; return 8 * (i >> 2) + 4 * n + (i & 3); }

struct Unit { int pm, pn; };
struct Gemm { const bf16_t* A; const bf16_t* Bt; int M, N, K; };

struct StaticOrder {
    int nM, nN, nwg, G, c;
    __host__ __device__ void init(int M, int N, int G_, int c_) { nM = M / BM; nN = N / BM; nwg = nM * nN; G = G_; c = c_; }
    __host__ __device__ bool next(int i, Unit& u) const {
        const long L = (long)i * G + c; if (L >= nwg) return false;
        int wgid = (int)L; { const int q = nwg / NXCD, r = nwg % NXCD, xcd = wgid % NXCD, off = wgid / NXCD; wgid = (xcd < r ? xcd * (q + 1) : r * (q + 1) + (xcd - r) * q) + off; }
        const int nig = WGM * nN, gid = wgid / nig, fm = gid * WGM, gsz = (nM - fm) < WGM ? (nM - fm) : WGM;
        u.pm = fm + ((wgid % nig) % gsz); u.pn = (wgid % nig) / gsz; return true;
    }
    __device__ __forceinline__ void a_ready(const Unit&) const {}
    __device__ __forceinline__ void done(const Unit&) const {}
};
template <class Epi, class Sched, bool ALIGN_EPI = false, bool SP2 = false>
__device__ __forceinline__ void gemm_phase(PG8_LAS unsigned char* lds, const Gemm g, const Sched& S, const Epi& E) {
    int tid_ = threadIdx.x; asm volatile("" : "+v"(tid_)); const int tid = tid_, wid = __builtin_amdgcn_readfirstlane(tid >> 6), lane = tid & 63, wr = wid >> 2, wc = wid & 3, fr = lane & 15, fq = lane >> 4;
    const int K = g.K, nt = K / BK;
    unsigned voffA[2], voffB[2];
#pragma unroll
    for (int i = 0; i < 2; ++i) { int R, C; stage_rc(tid * 16 + i * 8192, R, C); const int Rb = Epi::PERM ? ((R & ~31) + perm32(R & 31)) : R;
        voffA[i] = (unsigned)(R * K + C) * 2u; voffB[i] = (unsigned)(Rb * K + C) * 2u; }
    const size_t kstep = (size_t)(BK * 2);
    const size_t hstep = (size_t)HALF * K * 2;
    const size_t tstep = 2 * hstep;
    const unsigned ldsw = (unsigned)wid * 1024u;
    const int aoff = lds_byte(wr * 64 + fr, fq * 8), boff = lds_byte(wc * 32 + fr, fq * 8);
#define PG8_SA(b, h) (((b) * 2 + (h)) * HTB)
#define PG8_SB(b, h) ((4 + (b) * 2 + (h)) * HTB)
#define PG8_STAGE(bufoff, gbase, voff) do { _Pragma("unroll") for (int _i = 0; _i < 2; ++_i) \
        __builtin_amdgcn_global_load_lds((const unsigned*)((const char*)(gbase) + (voff)[_i]), (PG8_LAS unsigned*)(lds + (bufoff) + ldsw + _i * 8192), 16, 0, 0); } while (0)
#define PG8_LDA(dst, b, h) do { _Pragma("unroll") for (int m = 0; m < 4; ++m) _Pragma("unroll") for (int k = 0; k < 2; ++k) dst[m][k] = *(const PG8_LAS bf16x8*)(lds + PG8_SA(b, h) + aoff + m * 2048 + k * 1024); } while (0)
#define PG8_LDB(dst, b, h) do { _Pragma("unroll") for (int n = 0; n < 2; ++n) _Pragma("unroll") for (int k = 0; k < 2; ++k) dst[n][k] = *(const PG8_LAS bf16x8*)(lds + PG8_SB(b, h) + boff + n * 2048 + k * 1024); } while (0)
#define PG8_MMA(ai, bj, At, Bt) do { __builtin_amdgcn_s_setprio(1); _Pragma("unroll") for (int m = 0; m < 4; ++m) _Pragma("unroll") for (int n = 0; n < 2; ++n) _Pragma("unroll") for (int k = 0; k < 2; ++k) \
        acc[ai][bj][m][n] = __builtin_amdgcn_mfma_f32_16x16x32_f16(Bt[n][k], At[m][k], acc[ai][bj][m][n], 0, 0, 0); __builtin_amdgcn_s_setprio(0); } while (0)
#define PG8_WAIT_V(n) asm volatile("s_waitcnt vmcnt(" #n ")" ::: "memory")
#define PG8_WAIT_L(n) asm volatile("s_waitcnt lgkmcnt(" #n ")" ::: "memory")
#define PG8_BAR __builtin_amdgcn_s_barrier()
#define PG8_SCHED __builtin_amdgcn_sched_barrier(0)
    Unit cur, nxt; int ui = 0;
    if (!S.next(0, cur)) return;
    f32x4 acc[2][2][4][2];
#pragma unroll
    for (int a = 0; a < 2; ++a)
#pragma unroll
        for (int b = 0; b < 2; ++b)
#pragma unroll
            for (int m = 0; m < 4; ++m)
#pragma unroll
                for (int n = 0; n < 2; ++n) acc[a][b][m][n] = (f32x4){0.f, 0.f, 0.f, 0.f};
    bf16x8 At[4][2], B0[2][2], B1[2][2];
    const char* cA = (const char*)g.A + (size_t)cur.pm * tstep; const char* cB = (const char*)g.Bt + (size_t)cur.pn * tstep;
    S.a_ready(cur);
    if constexpr (SP2) {
        PG8_STAGE(PG8_SB(0, 0), cB, voffB); PG8_STAGE(PG8_SB(0, 1), cB + hstep, voffB); PG8_STAGE(PG8_SA(0, 0), cA, voffA); PG8_STAGE(PG8_SA(0, 1), cA + hstep, voffA);
        if (wr == 1) PG8_BAR;
        PG8_WAIT_V(2); PG8_BAR;
        PG8_STAGE(PG8_SB(1, 0), cB + kstep, voffB); PG8_STAGE(PG8_SA(1, 0), cA + kstep, voffA); PG8_STAGE(PG8_SB(1, 1), cB + hstep + kstep, voffB);
        PG8_WAIT_V(6); PG8_BAR;
    } else {
        PG8_STAGE(PG8_SB(0, 0), cB, voffB); PG8_STAGE(PG8_SA(0, 0), cA, voffA); PG8_STAGE(PG8_SB(0, 1), cB + hstep, voffB); PG8_STAGE(PG8_SA(0, 1), cA + hstep, voffA);
        if (wr == 1) PG8_BAR;
        PG8_WAIT_V(4); PG8_BAR;
        PG8_STAGE(PG8_SB(1, 0), cB + kstep, voffB); PG8_STAGE(PG8_SA(1, 0), cA + kstep, voffA); PG8_STAGE(PG8_SB(1, 1), cB + hstep + kstep, voffB);
        PG8_WAIT_V(6); PG8_BAR;
    }
    for (;;) {
        const bool has_next = S.next(ui + 1, nxt);
        const char* nA = has_next ? (const char*)g.A + (size_t)nxt.pm * tstep : cA; const char* nB = has_next ? (const char*)g.Bt + (size_t)nxt.pn * tstep : cB;
        for (int t = 0; t < nt; t += 2) {
            const bool last = (t == nt - 2);
            const char* a1 = cA + (size_t)(t + 1) * kstep;
            const char* a2 = last ? nA : cA + (size_t)(t + 2) * kstep; const char* b2 = last ? nB : cB + (size_t)(t + 2) * kstep;
            const char* a3 = a2 + kstep; const char* b3 = b2 + kstep;
            if (last && has_next) S.a_ready(nxt);
            if constexpr (SP2) {
            PG8_LDB(B0, 0, 0); PG8_LDB(B1, 0, 1); PG8_SCHED; PG8_LDA(At, 0, 0); PG8_STAGE(PG8_SA(1, 1), a1 + hstep, voffA);
            PG8_WAIT_V(8); PG8_WAIT_L(0); PG8_BAR; PG8_MMA(0, 0, At, B0); PG8_MMA(0, 1, At, B1); PG8_BAR; PG8_SCHED;
            PG8_LDA(At, 0, 1); PG8_STAGE(PG8_SB(0, 0), b2, voffB); PG8_STAGE(PG8_SB(0, 1), b2 + hstep, voffB); PG8_STAGE(PG8_SA(0, 0), a2, voffA);
            PG8_WAIT_V(8); PG8_WAIT_L(0); PG8_BAR; PG8_MMA(1, 0, At, B0); PG8_MMA(1, 1, At, B1); PG8_BAR; PG8_SCHED;
            PG8_LDB(B0, 1, 0); PG8_LDB(B1, 1, 1); PG8_SCHED; PG8_LDA(At, 1, 0); PG8_STAGE(PG8_SA(0, 1), a2 + hstep, voffA);
            PG8_WAIT_V(8); PG8_WAIT_L(0); PG8_BAR; PG8_MMA(0, 0, At, B0); PG8_MMA(0, 1, At, B1); PG8_BAR; PG8_SCHED;
            PG8_LDA(At, 1, 1); PG8_STAGE(PG8_SB(1, 0), b3, voffB); PG8_STAGE(PG8_SB(1, 1), b3 + hstep, voffB); PG8_STAGE(PG8_SA(1, 0), a3, voffA);
            PG8_WAIT_V(8); PG8_WAIT_L(0); PG8_BAR; PG8_MMA(1, 0, At, B0); PG8_MMA(1, 1, At, B1); PG8_BAR; PG8_SCHED;
            } else {
            PG8_LDB(B0, 0, 0); PG8_SCHED; PG8_LDA(At, 0, 0); PG8_STAGE(PG8_SA(1, 1), a1 + hstep, voffA);
            PG8_WAIT_L(8); PG8_BAR; PG8_WAIT_L(0); PG8_MMA(0, 0, At, B0); PG8_BAR; PG8_SCHED;
            PG8_LDB(B1, 0, 1); PG8_STAGE(PG8_SB(0, 0), b2, voffB);
            PG8_BAR; PG8_WAIT_L(0); PG8_MMA(0, 1, At, B1); PG8_BAR;
            PG8_LDA(At, 0, 1); PG8_STAGE(PG8_SA(0, 0), a2, voffA);
            PG8_BAR; PG8_WAIT_L(0); PG8_MMA(1, 0, At, B0); PG8_BAR; PG8_SCHED;
            PG8_STAGE(PG8_SB(0, 1), b2 + hstep, voffB);
            PG8_WAIT_V(6); PG8_BAR; PG8_MMA(1, 1, At, B1); PG8_BAR;
            PG8_LDB(B0, 1, 0); PG8_SCHED; PG8_LDA(At, 1, 0); PG8_STAGE(PG8_SA(0, 1), a2 + hstep, voffA);
            PG8_WAIT_L(8); PG8_BAR; PG8_WAIT_L(0); PG8_MMA(0, 0, At, B0); PG8_BAR; PG8_SCHED;
            PG8_LDB(B1, 1, 1); PG8_STAGE(PG8_SB(1, 0), b3, voffB);
            PG8_BAR; PG8_WAIT_L(0); PG8_MMA(0, 1, At, B1); PG8_BAR;
            PG8_LDA(At, 1, 1); PG8_STAGE(PG8_SA(1, 0), a3, voffA);
            PG8_BAR; PG8_WAIT_L(0); PG8_MMA(1, 0, At, B0); PG8_BAR; PG8_SCHED;
            PG8_STAGE(PG8_SB(1, 1), b3 + hstep, voffB);
            PG8_WAIT_V(6); PG8_BAR; PG8_MMA(1, 1, At, B1); PG8_BAR;
            }
        }
        if constexpr (ALIGN_EPI) { if (wr == 0) PG8_BAR; }
        if constexpr (!Epi::AFTER_DRAIN) { E(acc, cur, wr, wc, fr, fq); S.done(cur); }
        if (!has_next) break;
#pragma unroll
        for (int a = 0; a < 2; ++a)
#pragma unroll
            for (int b = 0; b < 2; ++b)
#pragma unroll
                for (int m = 0; m < 4; ++m)
#pragma unroll
                    for (int n = 0; n < 2; ++n) acc[a][b][m][n] = (f32x4){0.f, 0.f, 0.f, 0.f};
        cur = nxt; cA = nA; cB = nB; ++ui;
        if constexpr (ALIGN_EPI) { if (wr == 1) PG8_BAR; }
    }
    PG8_WAIT_V(0);
    if constexpr (!ALIGN_EPI) { if (wr == 0) PG8_BAR; }
    PG8_BAR;
    if constexpr (Epi::AFTER_DRAIN) { E.fused(acc, cur, wr, wc, fr, fq, lds, wid, lane); S.done(cur); }
#undef PG8_SA
#undef PG8_SB
#undef PG8_STAGE
#undef PG8_LDA
#undef PG8_LDB
#undef PG8_MMA
#undef PG8_WAIT_V
#undef PG8_WAIT_L
#undef PG8_BAR
#undef PG8_SCHED
}
}
#define GAS __attribute__((address_space(1)))
#define LAS __attribute__((address_space(3)))
typedef unsigned short bf16;
typedef unsigned v4u __attribute__((ext_vector_type(4)));
typedef float f32x4 __attribute__((ext_vector_type(4)));
typedef short bf16x8 __attribute__((ext_vector_type(8)));
typedef GAS unsigned gu32;
typedef GAS unsigned long long gu64;
#define RLX_AGENT __ATOMIC_RELAXED, __HIP_MEMORY_SCOPE_AGENT
#define LDS_WAIT() asm volatile("s_waitcnt lgkmcnt(0)" ::: "memory")
#define VM_WAIT() asm volatile("s_waitcnt vmcnt(0)" ::: "memory")
__device__ __forceinline__ unsigned long long rt() { return __builtin_amdgcn_s_memrealtime(); }
__device__ __forceinline__ unsigned f2bf(float f) { unsigned u = __builtin_bit_cast(unsigned, f); return (u + 0x7fffu + ((u >> 16) & 1u)) >> 16; }
__device__ __forceinline__ unsigned pk2(float lo, float hi) { return f2bf(lo) | (f2bf(hi) << 16); }

#define XB_TMO      128
#define XB_XCNT(j)  (256  + 64 * (j))
#define XB_XSUB(j)  (1280 + 64 * (j))
#define XB_XGEN(j)  (2304 + 64 * (j))
#define XB_TOP      3328
#define XB_TOPGEN   3392
#define XCD_BAR_WORDS 3456
#define XB_SPIN_CAP (1u << 18)

__device__ __forceinline__ unsigned xb_ld(unsigned* p)              { return __hip_atomic_load(p, __ATOMIC_RELAXED, __HIP_MEMORY_SCOPE_AGENT); }
__device__ __forceinline__ unsigned xb_add(unsigned* p, unsigned v) { return __hip_atomic_fetch_add(p, v, __ATOMIC_RELAXED, __HIP_MEMORY_SCOPE_AGENT); }
__device__ __forceinline__ unsigned xb_xcc_id() { return (unsigned)__builtin_amdgcn_s_getreg((3 << 11) | 20) & 0xFu; }
#define XB_SPIN(cond, bar) do { unsigned _sp = 0; while (cond) { __builtin_amdgcn_s_sleep(1); \
    if ((++_sp & 255u) == 0u) { if (xb_ld(&(bar)[XB_TMO])) break; if (_sp > XB_SPIN_CAP) { atomicAdd(&(bar)[XB_TMO], 1u); break; } } } } while (0)

struct XcdBarrier {
    unsigned* bar; unsigned x;
    volatile LAS unsigned* st;
};

__device__ __forceinline__ XcdBarrier xcd_barrier_post(unsigned* bar, volatile LAS unsigned* st) {
    XcdBarrier b; b.bar = bar; b.x = xb_xcc_id(); b.st = st;
    if (threadIdx.x == 0) (void)xb_add(&bar[XB_XCNT(b.x)], 1u);
    return b;
}
__device__ __forceinline__ void xcd_barrier_complete(unsigned* bar, unsigned x, unsigned& nloc, unsigned& nx) {
    const unsigned G = gridDim.x * gridDim.y * gridDim.z;
    unsigned sum, cnt, mine, sp = 0u;
    for (;;) {
        sum = 0u; cnt = 0u; mine = 0u;
#pragma unroll
        for (unsigned j = 0; j < 16; ++j) { const unsigned c = xb_ld(&bar[XB_XCNT(j)]); sum += c; cnt += (c > 0u) ? 1u : 0u; mine = (j == x) ? c : mine; }
        if (sum == G) break;
        __builtin_amdgcn_s_sleep(1);
        if ((++sp & 255u) == 0u) { if (xb_ld(&bar[XB_TMO])) break; if (sp > XB_SPIN_CAP) { atomicAdd(&bar[XB_TMO], 1u); break; } }
    }
    nloc = mine > 0u ? mine : 1u; nx = cnt > 0u ? cnt : 1u;
}

__device__ __forceinline__ void xcd_barrier(const XcdBarrier& b) {
    asm volatile("s_waitcnt vmcnt(0)" ::: "memory");
    __syncthreads();
    if (threadIdx.x == 0) {
        unsigned* bar = b.bar;
        __builtin_amdgcn_s_waitcnt(0);
        unsigned nloc = b.st[0], nx = b.st[1];
        if (nloc == 0u) { xcd_barrier_complete(bar, b.x, nloc, nx); b.st[0] = nloc; b.st[1] = nx; }
        const unsigned old = xb_add(&bar[XB_XSUB(b.x)], 1u);
        const unsigned gen = old / nloc;
        if (old + 1u == (gen + 1u) * nloc) {
            __builtin_amdgcn_fence(__ATOMIC_RELEASE, "agent");
            asm volatile("s_waitcnt vmcnt(0)" ::: "memory");
            const unsigned og = xb_add(&bar[XB_TOP], 1u);
            const unsigned tg = og / nx;
            if (og + 1u == (tg + 1u) * nx) xb_add(&bar[XB_TOPGEN], 1u);
            else XB_SPIN(xb_ld(&bar[XB_TOPGEN]) == tg, bar);
            __builtin_amdgcn_fence(__ATOMIC_ACQUIRE, "agent");
            xb_add(&bar[XB_XGEN(b.x)], 1u);
            asm volatile("s_waitcnt vmcnt(0)" ::: "memory");
        } else {
            XB_SPIN(xb_ld(&bar[XB_XGEN(b.x)]) == gen, bar);
            __builtin_amdgcn_fence(__ATOMIC_ACQUIRE, "agent");
            asm volatile("s_waitcnt vmcnt(0)" ::: "memory");
        }
    }
    __syncthreads();
}
typedef _Float16 h16;
typedef _Float16 h16x8 __attribute__((ext_vector_type(8)));
typedef _Float16 h16x2 __attribute__((ext_vector_type(2)));
typedef float f32x16 __attribute__((ext_vector_type(16)));
typedef unsigned u32x4 __attribute__((ext_vector_type(4)));
constexpr int NB = 2, SEQ = 8192, M = NB * SEQ, D = 1024, DIN = 5376, DRW = 1792, DQKV = 1536, DG = 2048, DFF = 4096, DH = 512, DLO = 1536;
constexpr float ALPHA = 1.189207115002721f;
constexpr float LN_EPS = 1e-5f, ADA_EPS = 1e-6f, GN_EPS = 64e-5f;
constexpr size_t MiB = 1u << 20, KiB = 1u << 10;
constexpr size_t WS_CTL = 0, CTL_ZERO_BYTES = 1 * MiB;
constexpr size_t WS_ADAP = 1 * MiB, WS_ADA = 1 * MiB + 896 * KiB, WS_BON = 2 * MiB;
constexpr size_t WS_WIN = 3 * MiB, WS_WLORA = 13 * MiB + 512 * KiB, WS_WBA = 14 * MiB + 256 * KiB, WS_WBB = 15 * MiB + 256 * KiB, WS_WOUT = 16 * MiB + 256 * KiB,
                 WS_W1 = 18 * MiB + 256 * KiB, WS_W2 = 26 * MiB + 256 * KiB;
constexpr size_t WS_H16 = 36 * MiB, WS_ZRW = 68 * MiB, WS_QKV = 124 * MiB, WS_LIN = 172 * MiB, WS_LOUT = 180 * MiB, WS_MRG = 68 * MiB, WS_HID = 68 * MiB, WS_END = 228 * MiB;
constexpr int CW_ATTQ = 64, CW_BAR = 4096;
constexpr int RING_BYTES = 131072, MISC_OFF = RING_BYTES + 64, LDS_BYTES = RING_BYTES + 512;
constexpr int NSCAN = 32, NATT = 16 * 32, TC = 32;

struct KArgs { const float* in[27]; float* out; unsigned char* ws; };
struct P {
    const float *x, *c, *w_ada, *b_ada, *w_in, *mu, *w0, *w2, *a0, *a2, *g2, *kk, *ka, *rk, *gn_g, *gn_b, *wba, *wbb, *wout, *ln1g, *ln1b, *w1, *b1, *wf2, *b2, *ln2g, *ln2b;
    float* out; unsigned char* ws;
    unsigned* ctl; float *adap, *ada, *bon;
    h16 *win_t, *wlora_t, *wba_t, *wbb_t, *wout_t, *w1_t, *w2_t, *h, *zrw, *qkv, *lin, *lout, *mrg, *hid, *ya, *ob, *gates;
};

__device__ __forceinline__ unsigned pkh(float a, float b) { h16x2 v = {(h16)a, (h16)b}; return __builtin_bit_cast(unsigned, v); }
__device__ __forceinline__ void store8h(h16* p, const f32x4& v0, const f32x4& v1) { u32x4 w; w.x = pkh(v0.x, v0.y); w.y = pkh(v0.z, v0.w); w.z = pkh(v1.x, v1.y); w.w = pkh(v1.z, v1.w); *(u32x4*)p = w; }
__device__ __forceinline__ void load8h(const h16* p, f32x4& v0, f32x4& v1) { const h16x8 t = *(const h16x8*)p; v0 = (f32x4){(float)t[0], (float)t[1], (float)t[2], (float)t[3]}; v1 = (f32x4){(float)t[4], (float)t[5], (float)t[6], (float)t[7]}; }
__device__ __forceinline__ float sigmoidf_(float x) { return 1.0f / (1.0f + __expf(-x)); }
__device__ __forceinline__ float wave_sum(float v) {
#pragma unroll
    for (int o = 1; o < 64; o <<= 1) v += __shfl_xor(v, o);
    return v;
}
template <int CTRL> __device__ __forceinline__ float dppmov(float x) { return __builtin_bit_cast(float, __builtin_amdgcn_update_dpp(0, __builtin_bit_cast(int, x), CTRL, 0xf, 0xf, true)); }
__device__ __forceinline__ float red16(float v) { v += dppmov<0xB1>(v); v += dppmov<0x4E>(v); v += dppmov<0x124>(v); v += dppmov<0x128>(v); return v; }

template <class F> struct EpiGen {
    static constexpr bool PERM = true, AFTER_DRAIN = false;
    F f;
    __device__ __forceinline__ void operator()(const f32x4 (&acc)[2][2][4][2], const pg8::Unit& u, int wr, int wc, int fr, int fq) const {
        const int row0 = u.pm * 256 + wr * 64 + fr, col0 = u.pn * 256 + wc * 32 + 8 * fq;
#pragma unroll
        for (int ai = 0; ai < 2; ++ai)
#pragma unroll
            for (int m = 0; m < 4; ++m)
#pragma unroll
                for (int bj = 0; bj < 2; ++bj) f(row0 + ai * 128 + m * 16, col0 + bj * 128, acc[ai][bj][m][0], acc[ai][bj][m][1]);
    }
};
struct F1 {
    h16 *zrw, *qkv, *gates;
    __device__ __forceinline__ void operator()(int row, int col, f32x4 v0, f32x4 v1) const {
        if (col < DRW) store8h(zrw + (size_t)row * DRW + col, v0, v1);
        else if (col < DRW + DQKV) { const int c = col - DRW; if (c < 512) { v0 = v0 * 0.125f; v1 = v1 * 0.125f; } store8h(qkv + (size_t)row * DQKV + c, v0, v1); }
        else { const int c = col - DRW - DQKV;
#pragma unroll
            for (int i = 0; i < 4; ++i) { v0[i] = sigmoidf_(v0[i]); v1[i] = sigmoidf_(v1[i]); }
            store8h(gates + (size_t)row * DG + c, v0, v1); }
    }
};
struct F3 {
    h16* lout;
    __device__ __forceinline__ void operator()(int row, int col, f32x4 v0, f32x4 v1) const { store8h(lout + (size_t)row * DLO + col, v0, v1); }
};
struct F5X { h16* mrg; const h16* gates;
    __device__ __forceinline__ void operator()(int row, int col, f32x4 v0, f32x4 v1) const {
        f32x4 g0, g1; load8h(gates + (size_t)row * DG + col, g0, g1); store8h(mrg + (size_t)row * D + col, v0 * g0, v1 * g1); } };
struct F5Y { h16* mrg; const h16* gates;
    __device__ __forceinline__ void operator()(int row, int col, f32x4 v0, f32x4 v1) const {
        f32x4 g0, g1, m0, m1; load8h(gates + (size_t)row * DG + 1024 + col, g0, g1); load8h(mrg + (size_t)row * D + col, m0, m1); store8h(mrg + (size_t)row * D + col, m0 + v0 * g0, m1 + v1 * g1); } };
struct F6 { const float* x; float* out; const float* ada;
    __device__ __forceinline__ void operator()(int row, int col, f32x4 v0, f32x4 v1) const {
        const float* g = ada + (row >> 13) * 6144 + 2048 + col; const size_t o = (size_t)row * D + col;
        const f32x4 x0 = *(const f32x4*)(x + o), x1 = *(const f32x4*)(x + o + 4), g0 = *(const f32x4*)g, g1 = *(const f32x4*)(g + 4);
        *(f32x4*)(out + o) = x0 * ALPHA + g0 * v0; *(f32x4*)(out + o + 4) = x1 * ALPHA + g1 * v1; } };
struct F8 { h16* hid; const float* b1;
    __device__ __forceinline__ void operator()(int row, int col, f32x4 v0, f32x4 v1) const {
        const f32x4 c0 = *(const f32x4*)(b1 + col), c1 = *(const f32x4*)(b1 + col + 4);
#pragma unroll
        for (int i = 0; i < 4; ++i) { float a = fmaxf(v0[i] + c0[i], 0.f); v0[i] = a * a; a = fmaxf(v1[i] + c1[i], 0.f); v1[i] = a * a; }
        store8h(hid + (size_t)row * DFF + col, v0, v1); } };
struct F9 { float* out; const float* ada; const float* b2;
    __device__ __forceinline__ void operator()(int row, int col, f32x4 v0, f32x4 v1) const {
        const float* g = ada + (row >> 13) * 6144 + 5120 + col; const size_t o = (size_t)row * D + col;
        const f32x4 x0 = *(const f32x4*)(out + o), x1 = *(const f32x4*)(out + o + 4), g0 = *(const f32x4*)g, g1 = *(const f32x4*)(g + 4), c0 = *(const f32x4*)(b2 + col), c1 = *(const f32x4*)(b2 + col + 4);
        *(f32x4*)(out + o) = x0 * ALPHA + g0 * (v0 + c0); *(f32x4*)(out + o + 4) = x1 * ALPHA + g1 * (v1 + c1); } };

template <class F> __device__ __forceinline__ void run_gemm(LAS unsigned char* lds, const h16* A, const h16* Bt, int N, int K, const F& f) {
    asm volatile("" : "+s"(N), "+s"(K));
    pg8::Gemm g{(const pg8::bf16_t*)A, (const pg8::bf16_t*)Bt, M, N, K}; pg8::StaticOrder S; S.init(M, N, (int)gridDim.x, (int)blockIdx.x);
    EpiGen<F> E{f};
    pg8::gemm_phase<EpiGen<F>, pg8::StaticOrder, true, true>(lds, g, S, E);
}

__device__ __forceinline__ void p0_transpose_item(const float* W, int K, int N, h16* WT, LAS float* scr, int item, int lane) {
    const int nblk = N / 32, kb = item / nblk, nb = item % nblk, k0 = 64 * kb, n0 = 32 * nb;
#pragma unroll 8
    for (int i = 0; i < 32; ++i) { const int kk = 2 * i + (lane >> 5); scr[kk * 33 + (lane & 31)] = W[(size_t)(k0 + kk) * N + n0 + (lane & 31)]; }
    LDS_WAIT(); asm volatile("" ::: "memory");
    const int c = lane & 7;
#pragma unroll
    for (int j = 0; j < 4; ++j) { const int n = (lane >> 3) + 8 * j; const LAS float* s = scr + (8 * c) * 33 + n;
        u32x4 o; o.x = pkh(s[0 * 33], s[1 * 33]); o.y = pkh(s[2 * 33], s[3 * 33]); o.z = pkh(s[4 * 33], s[5 * 33]); o.w = pkh(s[6 * 33], s[7 * 33]);
        *(u32x4*)(WT + (size_t)(n0 + n) * K + k0 + 8 * c) = o; }
    LDS_WAIT(); asm volatile("" ::: "memory");
}
__device__ __forceinline__ void phase0(const P& p, LAS unsigned char* lds, int tid, int lane, int wave) {
    LAS float* scr = (LAS float*)(lds + wave * 16384);
    const int G = gridDim.x, gw = blockIdx.x * 8 + wave, NGW = G * 8;
    constexpr int I_IN = (D / 64) * (DIN / 32), I_BA = (DH / 64) * (D / 32), I_OUT = (D / 64) * (D / 32), I_1 = (D / 64) * (DFF / 32), I_2 = (DFF / 64) * (D / 32);
    constexpr int NITEMS = I_IN + 2 * I_BA + I_OUT + I_1 + I_2;
    for (int it = gw; it < NITEMS; it += NGW) {
        int r = it;
        if (r < I_IN) { p0_transpose_item(p.w_in, D, DIN, p.win_t, scr, r, lane); continue; } r -= I_IN;
        if (r < I_BA) { p0_transpose_item(p.wba, DH, D, p.wba_t, scr, r, lane); continue; } r -= I_BA;
        if (r < I_BA) { p0_transpose_item(p.wbb, DH, D, p.wbb_t, scr, r, lane); continue; } r -= I_BA;
        if (r < I_OUT) { p0_transpose_item(p.wout, D, D, p.wout_t, scr, r, lane); continue; } r -= I_OUT;
        if (r < I_1) { p0_transpose_item(p.w1, D, DFF, p.w1_t, scr, r, lane); continue; } r -= I_1;
        p0_transpose_item(p.wf2, DFF, D, p.w2_t, scr, r, lane);
    }
    for (int idx = blockIdx.x * 512 + tid; idx < DLO * 256; idx += G * 512) {
        const int n = idx >> 8, k = idx & 255; float v = 0.f;
        if (n < 512) { if (k < 64) v = p.w2[k * 512 + n]; }
        else if (n < 1024) { if (k >= 64 && k < 128) v = p.a2[(k - 64) * 512 + n - 512]; }
        else { if (k >= 128) v = p.g2[(k - 128) * 512 + n - 1024]; }
        p.wlora_t[idx] = (h16)v;
    }
    for (int u = blockIdx.x; u < 192; u += G) {
        const int slice = u / 12, n = (u % 12) * 512 + tid; float a0 = 0.f, a1 = 0.f;
#pragma unroll 8
        for (int kk = 0; kk < 64; ++kk) { const int k = slice * 64 + kk; const float c0 = p.c[k], c1 = p.c[1024 + k], w = p.w_ada[(size_t)k * 6144 + n];
            a0 += c0 * sigmoidf_(c0) * w; a1 += c1 * sigmoidf_(c1) * w; }
        p.adap[(slice * 2 + 0) * 6144 + n] = a0; p.adap[(slice * 2 + 1) * 6144 + n] = a1;
    }
}
__device__ __forceinline__ void phase0b(const P& p, LAS unsigned char* lds, int tid, int lane, int wave) {
    LAS float* mod = (LAS float*)lds;
    for (int i = tid; i < 4096; i += 512) { const int b = i >> 11, j = i & 2047; float s = p.b_ada[j];
#pragma unroll
        for (int sl = 0; sl < 16; ++sl) s += p.adap[(sl * 2 + b) * 6144 + j];
        mod[i] = s; }
    if (blockIdx.x == 0) for (int i = tid; i < 2 * 6144; i += 512) { const int b = i / 6144, j = i % 6144; float s = p.b_ada[j];
#pragma unroll
        for (int sl = 0; sl < 16; ++sl) s += p.adap[(sl * 2 + b) * 6144 + j];
        p.ada[i] = s; }
    __syncthreads();
    const int gw = blockIdx.x * 8 + wave, NGW = gridDim.x * 8;
    for (int m = gw; m < M; m += NGW) {
        const f32x4* xr = (const f32x4*)(p.x + (size_t)m * D) + lane; const int b = m >> 13;
        f32x4 v[4]; float s = 0.f;
#pragma unroll
        for (int j = 0; j < 4; ++j) { v[j] = xr[64 * j]; s += (v[j].x + v[j].y) + (v[j].z + v[j].w); }
        const float mean = wave_sum(s) * (1.f / D); float s2 = 0.f;
#pragma unroll
        for (int j = 0; j < 4; ++j) { v[j] = v[j] - mean; s2 += (v[j].x * v[j].x + v[j].y * v[j].y) + (v[j].z * v[j].z + v[j].w * v[j].w); }
        const float rstd = 1.f / sqrtf(wave_sum(s2) * (1.f / D) + ADA_EPS);
        uint2* o8 = (uint2*)(p.h + (size_t)m * D) + lane;
#pragma unroll
        for (int j = 0; j < 4; ++j) { const int col = 4 * (lane + 64 * j); const f32x4 sh = *(const LAS f32x4*)(mod + b * 2048 + col), sc = *(const LAS f32x4*)(mod + b * 2048 + 1024 + col);
            const f32x4 r = v[j] * rstd * (sc + 1.0f) + sh; uint2 w; w.x = pkh(r.x, r.y); w.y = pkh(r.z, r.w); o8[64 * j] = w; }
    }
}
__device__ __forceinline__ void phase2(const P& p, int tid) {
    for (int idx = blockIdx.x * 512 + tid; idx < M * 32; idx += gridDim.x * 512) {
        const int t = idx >> 5, j8 = (idx & 31) * 8, col = 1536 + j8;
        f32x4 c0, c1, q0 = {0.f, 0.f, 0.f, 0.f}, q1 = {0.f, 0.f, 0.f, 0.f};
        load8h(p.zrw + (size_t)t * DRW + col, c0, c1); if (t & (SEQ - 1)) load8h(p.zrw + (size_t)(t - 1) * DRW + col, q0, q1);
        const f32x4 m0 = *(const f32x4*)(p.mu + col), m1 = *(const f32x4*)(p.mu + col + 4);
        c0 = c0 + m0 * (q0 - c0); c1 = c1 + m1 * (q1 - c1);
#pragma unroll
        for (int i = 0; i < 4; ++i) { if (j8 < 64) { c0[i] = tanhf(c0[i]); c1[i] = tanhf(c1[i]); } else if (j8 >= 128) { c0[i] = sigmoidf_(c0[i]); c1[i] = sigmoidf_(c1[i]); } }
        store8h(p.lin + (size_t)t * 256 + j8, c0, c1);
    }
}
__device__ __forceinline__ void scan_unit(const P& p, LAS float* sm, int unit, int tid, int lane, int wave) {
    const int bh = unit >> 1, half = unit & 1, b = bh >> 3, h = bh & 7, row_l = tid >> 4, pp = tid & 15;
    LAS float *sW = sm, *sA = sm + 2048, *sB = sm + 4096, *sK = sm + 6144, *sR = sm + 8192, *sS = sm + 10240, *sV = sm + 10304, *sY = sm + 11328;
    const int col = h * 64 + lane;
    const float mu_r = p.mu[col], mu_k = p.mu[512 + col], mu_v = p.mu[1024 + col], ckk = p.kk[col], cka = p.ka[col], crk = p.rk[col], cw0 = p.w0[col], ca0 = p.a0[col];
    float S0 = 0.f, S1 = 0.f, S2 = 0.f, S3 = 0.f;
    for (int c = 0; c < SEQ / TC; ++c) {
#pragma unroll
        for (int i = 0; i < TC / 8; ++i) {
            const int tt = wave * (TC / 8) + i, t = c * TC + tt; const size_t gm = (size_t)b * SEQ + t;
            const h16* zr = p.zrw + gm * DRW; const h16* lo = p.lout + gm * DLO;
            float r = (float)zr[col], k = (float)zr[512 + col], v = (float)zr[1024 + col], rp = 0.f, kp = 0.f, vp = 0.f;
            if (t > 0) { rp = (float)zr[col - DRW]; kp = (float)zr[512 + col - DRW]; vp = (float)zr[1024 + col - DRW]; }
            r += mu_r * (rp - r); k += mu_k * (kp - k); v += mu_v * (vp - v);
            const float xw = -(cw0 + (float)lo[col]), spw = fmaxf(xw, 0.f) + __logf(1.f + __expf(-fabsf(xw))), ar = sigmoidf_(ca0 + (float)lo[512 + col]);
            const float w = __expf(-__expf(-spw - 0.5f)), kkv = k * ckk, nrm = sqrtf(wave_sum(kkv * kkv)), kkn = kkv / fmaxf(nrm, 1e-12f);
            const float av = -kkn, bv = kkn * ar, k2 = k * (1.0f + (ar - 1.0f) * cka);
            const float br = wave_sum(bv * r), kr = wave_sum(k2 * r), bon = wave_sum(r * k2 * crk);
            sW[tt * 64 + lane] = w; sA[tt * 64 + lane] = av; sB[tt * 64 + lane] = bv; sK[tt * 64 + lane] = k2; sR[tt * 64 + lane] = w * r;
            if (lane == 0) { sS[tt * 2] = br; sS[tt * 2 + 1] = kr; if (half == 0) p.bon[gm * 8 + h] = bon; }
            if ((lane >> 5) == half) sV[tt * 32 + (lane & 31)] = v;
        }
        __syncthreads();
#pragma unroll 4
        for (int tt = 0; tt < TC; ++tt) {
            const f32x4 w4 = *(const LAS f32x4*)(sW + tt * 64 + pp * 4), a4 = *(const LAS f32x4*)(sA + tt * 64 + pp * 4), b4 = *(const LAS f32x4*)(sB + tt * 64 + pp * 4),
                        k4 = *(const LAS f32x4*)(sK + tt * 64 + pp * 4), r4 = *(const LAS f32x4*)(sR + tt * 64 + pp * 4);
            const float vi = sV[tt * 32 + row_l], br = sS[tt * 2], kr = sS[tt * 2 + 1];
            float pa = (S0 * a4.x + S1 * a4.y) + (S2 * a4.z + S3 * a4.w), pr = (S0 * r4.x + S1 * r4.y) + (S2 * r4.z + S3 * r4.w);
            pa = red16(pa); pr = red16(pr);
            const float y = pr + pa * br + vi * kr;
            S0 = S0 * w4.x + pa * b4.x + vi * k4.x; S1 = S1 * w4.y + pa * b4.y + vi * k4.y; S2 = S2 * w4.z + pa * b4.z + vi * k4.z; S3 = S3 * w4.w + pa * b4.w + vi * k4.w;
            if (pp == 0) sY[tt * 32 + row_l] = y;
        }
        __syncthreads();
        for (int i = tid; i < TC * 32; i += 512) { const int tt = i >> 5, rr = i & 31; p.ya[((size_t)b * SEQ + c * TC + tt) * DH + h * 64 + half * 32 + rr] = (h16)sY[i]; }
    }
    __syncthreads();
}
__device__ __forceinline__ int crow(int r, int hi) { return (r & 3) + 8 * (r >> 2) + 4 * hi; }
__device__ __forceinline__ void attn_unit(const P& p, LAS unsigned char* sm, int unit, int tid, int lane, int wave) {
    const int bh = unit >> 5, qb = unit & 31, b = bh >> 3, h = bh & 7, q0 = qb * 256, qw0 = q0 + wave * 32, r32 = lane & 31, hi = lane >> 5, qabs = qw0 + r32;
    const h16* base = p.qkv + (size_t)b * SEQ * DQKV + h * 64;
    h16x8 qf[4];
#pragma unroll
    for (int d0 = 0; d0 < 4; ++d0) qf[d0] = *(const h16x8*)(base + (size_t)(qw0 + r32) * DQKV + d0 * 16 + hi * 8);
    f32x16 o0, o1;
#pragma unroll
    for (int r = 0; r < 16; ++r) { o0[r] = 0.f; o1[r] = 0.f; }
    float carry = 0.f; int done = 0;
    const int lkey = tid >> 3, lc = tid & 7, ks_ = lkey >> 4, rem = lkey & 15, hk = (rem >> 2) & 1, e_ = ((rem >> 3) << 2) | (rem & 3);
    LAS unsigned short* vt = (LAS unsigned short*)(sm + 8192 + (((ks_ * 2 + hk) * 64 + lc * 8) * 8 + e_) * 2);
    volatile LAS unsigned* nd = (volatile LAS unsigned*)(sm + RING_BYTES + 16);
    if (tid == 0) { nd[0] = 0u; nd[1] = 0u; }
    int it = 0;
    for (int jt = (q0 + 255) >> 6; jt >= 0; --jt, ++it) {
        const int k0 = jt * 64;
        { const h16* src = base + (size_t)(k0 + lkey) * DQKV + lc * 8;
          const u32x4 kv = *(const u32x4*)(src + 512), vv = *(const u32x4*)(src + 1024);
          *(LAS u32x4*)(sm + lc * 1024 + lkey * 16) = kv;
          vt[0] = (unsigned short)(vv.x & 0xffffu); vt[8] = (unsigned short)(vv.x >> 16); vt[16] = (unsigned short)(vv.y & 0xffffu); vt[24] = (unsigned short)(vv.y >> 16);
          vt[32] = (unsigned short)(vv.z & 0xffffu); vt[40] = (unsigned short)(vv.z >> 16); vt[48] = (unsigned short)(vv.w & 0xffffu); vt[56] = (unsigned short)(vv.w >> 16); }
        __syncthreads();
        if (tid == 0) nd[(it + 1) & 1] = 0u;
        if (!done && k0 <= qw0 + 31) {
            f32x16 p0, p1;
#pragma unroll
            for (int r = 0; r < 16; ++r) { p0[r] = 0.f; p1[r] = 0.f; }
#pragma unroll
            for (int d0 = 0; d0 < 4; ++d0) { const h16x8 a0 = *(const LAS h16x8*)(sm + (d0 * 2 + hi) * 1024 + r32 * 16), a1 = *(const LAS h16x8*)(sm + (d0 * 2 + hi) * 1024 + 512 + r32 * 16);
                p0 = __builtin_amdgcn_mfma_f32_32x32x16_f16(a0, qf[d0], p0, 0, 0, 0); p1 = __builtin_amdgcn_mfma_f32_32x32x16_f16(a1, qf[d0], p1, 0, 0, 0); }
            float L0[16], L1[16];
#pragma unroll
            for (int r = 0; r < 16; ++r) { const int key = k0 + crow(r, hi);
                { const float z = p0[r], sp = fmaxf(z, 0.f) + __logf(1.f + __expf(-fabsf(z))); L0[r] = (key < qabs) ? -sp : 0.f; p0[r] = z - sp; }
                { const float z = p1[r], sp = fmaxf(z, 0.f) + __logf(1.f + __expf(-fabsf(z))); L1[r] = (key + 32 < qabs) ? -sp : 0.f; p1[r] = z - sp; } }
            float Gs[8], PG[8], sgo[8];
#pragma unroll
            for (int j = 0; j < 4; ++j) { Gs[j] = (L0[4 * j] + L0[4 * j + 1]) + (L0[4 * j + 2] + L0[4 * j + 3]); Gs[4 + j] = (L1[4 * j] + L1[4 * j + 1]) + (L1[4 * j + 2] + L1[4 * j + 3]); }
#pragma unroll
            for (int j = 0; j < 8; ++j) PG[j] = __shfl_xor(Gs[j], 32);
            float run = 0.f;
#pragma unroll
            for (int j = 7; j >= 0; --j) { const float ev = hi ? PG[j] : Gs[j], od = hi ? Gs[j] : PG[j]; const float so = run; run += od; const float se = run; run += ev; sgo[j] = hi ? so : se; }
            h16x8 pa[4];
#pragma unroll
            for (int j = 0; j < 4; ++j) {
                float acc = carry + sgo[j], acc1 = carry + sgo[4 + j];
#pragma unroll
                for (int i = 3; i >= 0; --i) { const int r = 4 * j + i, key = k0 + crow(r, hi);
                    const float a0 = (key < qabs) ? __expf(p0[r] + acc) : 0.f; acc += L0[r];
                    const float a1 = (key + 32 < qabs) ? __expf(p1[r] + acc1) : 0.f; acc1 += L1[r];
                    pa[j >> 1][(j & 1) * 4 + i] = (h16)a0; pa[2 + (j >> 1)][(j & 1) * 4 + i] = (h16)a1; }
            }
            carry += run;
#pragma unroll
            for (int ks = 0; ks < 4; ++ks) { const h16x8 v0 = *(const LAS h16x8*)(sm + 8192 + ((ks * 2 + hi) * 64 + r32) * 16), v1 = *(const LAS h16x8*)(sm + 8192 + ((ks * 2 + hi) * 64 + 32 + r32) * 16);
                o0 = __builtin_amdgcn_mfma_f32_32x32x16_f16(pa[ks], v0, o0, 0, 0, 0); o1 = __builtin_amdgcn_mfma_f32_32x32x16_f16(pa[ks], v1, o1, 0, 0, 0); }
            done = __all(carry < -104.0f) ? 1 : 0;
        }
        if (lane == 0 && !done) nd[it & 1] = 1u;
        __syncthreads();
        if (nd[it & 1] == 0u) break;
    }
    h16* ob = p.ob + ((size_t)b * SEQ + qw0) * DH + h * 64;
#pragma unroll
    for (int r = 0; r < 16; ++r) { const int q = crow(r, hi); ob[(size_t)q * DH + r32] = (h16)o0[r]; ob[(size_t)q * DH + 32 + r32] = (h16)o1[r]; }
}
__device__ __forceinline__ void phase4b(const P& p, int lane, int wave) {
    const int gw = blockIdx.x * 8 + wave, NGW = gridDim.x * 8;
    for (int task = gw; task < M * 8; task += NGW) {
        const int t = task >> 3, h = task & 7, col = h * 64 + lane;
        const float y = (float)p.ya[(size_t)t * DH + col], mean = wave_sum(y) * (1.f / 64.f), d = y - mean, var = wave_sum(d * d) * (1.f / 64.f);
        const float gn = d * (1.0f / sqrtf(var + GN_EPS)) * p.gn_g[col] + p.gn_b[col];
        float v = (float)p.zrw[(size_t)t * DRW + 1024 + col], vp = 0.f; if (t & (SEQ - 1)) vp = (float)p.zrw[(size_t)(t - 1) * DRW + 1024 + col];
        v += p.mu[1024 + col] * (vp - v);
        const float g = (float)p.lout[(size_t)t * DLO + 1024 + col], bon = p.bon[(size_t)t * 8 + h];
        p.ya[(size_t)t * DH + col] = (h16)((gn + bon * v) * g);
    }
}
template <bool FINAL> __device__ __forceinline__ void phase_ln(const P& p, int lane, int wave) {
    const int gw = blockIdx.x * 8 + wave, NGW = gridDim.x * 8;
    const float* lg = FINAL ? p.ln2g : p.ln1g; const float* lb = FINAL ? p.ln2b : p.ln1b;
    for (int m = gw; m < M; m += NGW) {
        f32x4* xr = (f32x4*)(p.out + (size_t)m * D) + lane; const int b = m >> 13;
        f32x4 v[4]; float s = 0.f;
#pragma unroll
        for (int j = 0; j < 4; ++j) { v[j] = xr[64 * j]; s += (v[j].x + v[j].y) + (v[j].z + v[j].w); }
        float mean = wave_sum(s) * (1.f / D), s2 = 0.f;
#pragma unroll
        for (int j = 0; j < 4; ++j) { v[j] = v[j] - mean; s2 += (v[j].x * v[j].x + v[j].y * v[j].y) + (v[j].z * v[j].z + v[j].w * v[j].w); }
        float rstd = 1.f / sqrtf(wave_sum(s2) * (1.f / D) + LN_EPS);
        s = 0.f;
#pragma unroll
        for (int j = 0; j < 4; ++j) { const int col = 4 * (lane + 64 * j); v[j] = v[j] * rstd * *(const f32x4*)(lg + col) + *(const f32x4*)(lb + col); xr[64 * j] = v[j]; s += (v[j].x + v[j].y) + (v[j].z + v[j].w); }
        if (!FINAL) {
            mean = wave_sum(s) * (1.f / D); s2 = 0.f;
#pragma unroll
            for (int j = 0; j < 4; ++j) { v[j] = v[j] - mean; s2 += (v[j].x * v[j].x + v[j].y * v[j].y) + (v[j].z * v[j].z + v[j].w * v[j].w); }
            rstd = 1.f / sqrtf(wave_sum(s2) * (1.f / D) + ADA_EPS);
            uint2* o8 = (uint2*)(p.h + (size_t)m * D) + lane; const float* ad = p.ada + b * 6144;
#pragma unroll
            for (int j = 0; j < 4; ++j) { const int col = 4 * (lane + 64 * j); const f32x4 sh = *(const f32x4*)(ad + 3072 + col), sc = *(const f32x4*)(ad + 4096 + col);
                const f32x4 r = v[j] * rstd * (sc + 1.0f) + sh; uint2 w; w.x = pkh(r.x, r.y); w.y = pkh(r.z, r.w); o8[64 * j] = w; }
        }
    }
}

__global__ void __launch_bounds__(512, 2) mk_fwd(KArgs a) {
    extern __shared__ __attribute__((aligned(16))) unsigned char lds_raw[];
    LAS unsigned char* lds = (LAS unsigned char*)lds_raw;
    volatile LAS unsigned* MISC = (volatile LAS unsigned*)(lds + MISC_OFF);
    int tid = threadIdx.x, lane = tid & 63, wave = __builtin_amdgcn_readfirstlane(tid >> 6);
#define FRESH() do { tid = threadIdx.x; asm volatile("" : "+v"(tid)); lane = tid & 63; wave = __builtin_amdgcn_readfirstlane(tid >> 6); } while (0)
    P p;
    p.x = a.in[0]; p.c = a.in[1]; p.w_ada = a.in[2]; p.b_ada = a.in[3]; p.w_in = a.in[4]; p.mu = a.in[5]; p.w0 = a.in[6]; p.w2 = a.in[7]; p.a0 = a.in[8]; p.a2 = a.in[9]; p.g2 = a.in[10];
    p.kk = a.in[11]; p.ka = a.in[12]; p.rk = a.in[13]; p.gn_g = a.in[14]; p.gn_b = a.in[15]; p.wba = a.in[16]; p.wbb = a.in[17]; p.wout = a.in[18]; p.ln1g = a.in[19]; p.ln1b = a.in[20];
    p.w1 = a.in[21]; p.b1 = a.in[22]; p.wf2 = a.in[23]; p.b2 = a.in[24]; p.ln2g = a.in[25]; p.ln2b = a.in[26];
    p.out = a.out; p.ws = a.ws; unsigned char* ws = a.ws;
    p.ctl = (unsigned*)(ws + WS_CTL); p.adap = (float*)(ws + WS_ADAP); p.ada = (float*)(ws + WS_ADA); p.bon = (float*)(ws + WS_BON);
    p.win_t = (h16*)(ws + WS_WIN); p.wlora_t = (h16*)(ws + WS_WLORA); p.wba_t = (h16*)(ws + WS_WBA); p.wbb_t = (h16*)(ws + WS_WBB); p.wout_t = (h16*)(ws + WS_WOUT); p.w1_t = (h16*)(ws + WS_W1); p.w2_t = (h16*)(ws + WS_W2);
    p.h = (h16*)(ws + WS_H16); p.zrw = (h16*)(ws + WS_ZRW); p.qkv = (h16*)(ws + WS_QKV); p.lin = (h16*)(ws + WS_LIN); p.lout = (h16*)(ws + WS_LOUT); p.mrg = (h16*)(ws + WS_MRG); p.hid = (h16*)(ws + WS_HID);
    p.ya = (h16*)(ws + WS_H16); p.ob = (h16*)(ws + WS_H16 + 16 * MiB); p.gates = (h16*)a.out;
    for (int u = tid; u < (LDS_BYTES - RING_BYTES) / 4; u += 512) ((LAS unsigned*)(lds + RING_BYTES))[u] = 0u;
    __syncthreads();
    XcdBarrier bar = xcd_barrier_post(p.ctl + CW_BAR, MISC + 8);
#define GRID_BAR() xcd_barrier(bar)

    FRESH();
    phase0(p, lds, tid, lane, wave);
    cg::this_grid().sync();
    FRESH();
    phase0b(p, lds, tid, lane, wave);
    GRID_BAR();
    FRESH();
    run_gemm(lds, p.h, p.win_t, DIN, D, F1{p.zrw, p.qkv, p.gates});
    GRID_BAR();
    FRESH();
    phase2(p, tid);
    GRID_BAR();
    FRESH();
    run_gemm(lds, p.lin, p.wlora_t, DLO, 256, F3{p.lout});
    GRID_BAR();
    {
        FRESH();
        if (blockIdx.x < NSCAN) scan_unit(p, (LAS float*)lds, (int)blockIdx.x, tid, lane, wave);
        for (;;) {
            if (tid == 0) MISC[0] = atomicAdd(p.ctl + CW_ATTQ, 1u);
            __syncthreads();
            const int u = (int)MISC[0];
            __syncthreads();
            if (u >= NATT) break;
            FRESH();
            attn_unit(p, lds, u, tid, lane, wave);
        }
    }
    GRID_BAR();
    FRESH();
    phase4b(p, lane, wave);
    GRID_BAR();
    FRESH();
    run_gemm(lds, p.ya, p.wba_t, D, DH, F5X{p.mrg, p.gates});
    FRESH();
    run_gemm(lds, p.ob, p.wbb_t, D, DH, F5Y{p.mrg, p.gates});
    GRID_BAR();
    FRESH();
    run_gemm(lds, p.mrg, p.wout_t, D, D, F6{p.x, p.out, p.ada});
    GRID_BAR();
    FRESH();
    phase_ln<false>(p, lane, wave);
    GRID_BAR();
    FRESH();
    run_gemm(lds, p.h, p.w1_t, DFF, D, F8{p.hid, p.b1});
    GRID_BAR();
    FRESH();
    run_gemm(lds, p.hid, p.w2_t, D, DFF, F9{p.out, p.ada, p.b2});
    GRID_BAR();
    FRESH();
    phase_ln<true>(p, lane, wave);
}

extern "C" void kernel_launch(void* const* d_in, const int* in_sizes, int n_in, void* d_out, int out_size, void* d_ws, size_t ws_size, hipStream_t stream) {
    static int grid = 0;
    if (grid == 0) {
        if (n_in != 27 || out_size != M * D || ws_size < WS_END) { fprintf(stderr, "kernel_launch: unexpected shapes (n_in %d, out %d, ws %zu)\n", n_in, out_size, ws_size); grid = -1; return; }
        int dev = 0, cus = 0, per_cu = 0;
        hipGetDevice(&dev); hipDeviceGetAttribute(&cus, hipDeviceAttributeMultiprocessorCount, dev);
        if (hipFuncSetAttribute((const void*)mk_fwd, hipFuncAttributeMaxDynamicSharedMemorySize, LDS_BYTES) != hipSuccess) { fprintf(stderr, "kernel_launch: hipFuncSetAttribute failed\n"); grid = -1; return; }
        hipOccupancyMaxActiveBlocksPerMultiprocessor(&per_cu, (const void*)mk_fwd, 512, LDS_BYTES);
        (void)hipGetLastError();
        if (per_cu < 1) fprintf(stderr, "kernel_launch: occupancy query says %d blocks per CU\n", per_cu);
        grid = cus;
    }
    if (grid < 0) return;
    hipMemsetAsync((char*)d_ws + WS_CTL, 0, CTL_ZERO_BYTES, stream);
    KArgs a{};
    for (int i = 0; i < 27; ++i) a.in[i] = (const float*)d_in[i];
    a.out = (float*)d_out; a.ws = (unsigned char*)d_ws;
    void* args[] = {&a};
    hipError_t e = hipLaunchCooperativeKernel((const void*)mk_fwd, dim3(grid), dim3(512), args, LDS_BYTES, stream);
    if (e != hipSuccess) fprintf(stderr, "cooperative launch failed: %s (grid %d)\n", hipGetErrorString(e), grid);
}
```

```cpp
#include <hip/hip_runtime.h>
#include <hip/hip_cooperative_groups.h>
#include <cstdio>
#include <cstdint>
namespace cg = cooperative_groups;
namespace pg8 {
#define PG8_LAS __attribute__((address_space(3)))
typedef unsigned short bf16_t;
typedef _Float16 bf16x8 __attribute__((ext_vector_type(8)));
typedef float f32x4 __attribute__((ext_vector_type(4)));
typedef unsigned u32x4 __attribute__((ext_vector_type(4)));
constexpr int BM = 256, BK = 64, HALF = 128, HTB = HALF * BK * 2  , STAGE_BYTES = 8 * HTB, NXCD = 8, WGM = 8;

__host__ __device__ __forceinline__ int lds_byte(int r, int c) { const int st = (r >> 4) * 2 + (c >> 5), rr = r & 15, cc = c & 31, ob = rr * 64 + cc * 2; return st * 1024 + (ob ^ (((ob >> 9) & 1) << 5)); }
__host__ __device__ __forceinline__ void stage_rc(int b, int& R, int& C) { const int st = b / 1024, sb = b % 1024, swz = sb ^ (((sb >> 9) & 1) << 5); R = (st >> 1) * 16 + swz / 64; C = (st & 1) * 32 + (swz % 64) / 2; }
__host__ __device__ __forceinline__ int perm32(int rho) { const int n = rho >> 4, i = rho & 15; return 8 * (i >> 2) + 4 * n + (i & 3); }

struct Unit { int pm, pn; };
struct Gemm { const bf16_t* A; const bf16_t* Bt; int M, N, K; };

struct StaticOrder {
    int nM, nN, nwg, G, c;
    __host__ __device__ void init(int M, int N, int G_, int c_) { nM = M / BM; nN = N / BM; nwg = nM * nN; G = G_; c = c_; }
    __host__ __device__ bool next(int i, Unit& u) const {
        const long L = (long)i * G + c; if (L >= nwg) return false;
        int wgid = (int)L; { const int q = nwg / NXCD, r = nwg % NXCD, xcd = wgid % NXCD, off = wgid / NXCD; wgid = (xcd < r ? xcd * (q + 1) : r * (q + 1) + (xcd - r) * q) + off; }
        const int nig = WGM * nN, gid = wgid / nig, fm = gid * WGM, gsz = (nM - fm) < WGM ? (nM - fm) : WGM;
        u.pm = fm + ((wgid % nig) % gsz); u.pn = (wgid % nig) / gsz; return true;
    }
    __device__ __forceinline__ void a_ready(const Unit&) const {}
    __device__ __forceinline__ void done(const Unit&) const {}
};
template <class Epi, class Sched, bool ALIGN_EPI = false, bool SP2 = false>
__device__ __forceinline__ void gemm_phase(PG8_LAS unsigned char* lds, const Gemm g, const Sched& S, const Epi& E) {
    int tid_ = threadIdx.x; asm volatile("" : "+v"(tid_)); const int tid = tid_, wid = __builtin_amdgcn_readfirstlane(tid >> 6), lane = tid & 63, wr = wid >> 2, wc = wid & 3, fr = lane & 15, fq = lane >> 4;
    const int K = g.K, nt = K / BK;
    unsigned voffA[2], voffB[2];
#pragma unroll
    for (int i = 0; i < 2; ++i) { int R, C; stage_rc(tid * 16 + i * 8192, R, C); const int Rb = Epi::PERM ? ((R & ~31) + perm32(R & 31)) : R;
        voffA[i] = (unsigned)(R * K + C) * 2u; voffB[i] = (unsigned)(Rb * K + C) * 2u; }
    const size_t kstep = (size_t)(BK * 2);
    const size_t hstep = (size_t)HALF * K * 2;
    const size_t tstep = 2 * hstep;
    const unsigned ldsw = (unsigned)wid * 1024u;
    const int aoff = lds_byte(wr * 64 + fr, fq * 8), boff = lds_byte(wc * 32 + fr, fq * 8);
#define PG8_SA(b, h) (((b) * 2 + (h)) * HTB)
#define PG8_SB(b, h) ((4 + (b) * 2 + (h)) * HTB)
#define PG8_STAGE(bufoff, gbase, voff) do { _Pragma("unroll") for (int _i = 0; _i < 2; ++_i) \
        __builtin_amdgcn_global_load_lds((const unsigned*)((const char*)(gbase) + (voff)[_i]), (PG8_LAS unsigned*)(lds + (bufoff) + ldsw + _i * 8192), 16, 0, 0); } while (0)
#define PG8_LDA(dst, b, h) do { _Pragma("unroll") for (int m = 0; m < 4; ++m) _Pragma("unroll") for (int k = 0; k < 2; ++k) dst[m][k] = *(const PG8_LAS bf16x8*)(lds + PG8_SA(b, h) + aoff + m * 2048 + k * 1024); } while (0)
#define PG8_LDB(dst, b, h) do { _Pragma("unroll") for (int n = 0; n < 2; ++n) _Pragma("unroll") for (int k = 0; k < 2; ++k) dst[n][k] = *(const PG8_LAS bf16x8*)(lds + PG8_SB(b, h) + boff + n * 2048 + k * 1024); } while (0)
#define PG8_MMA(ai, bj, At, Bt) do { __builtin_amdgcn_s_setprio(1); _Pragma("unroll") for (int m = 0; m < 4; ++m) _Pragma("unroll") for (int n = 0; n < 2; ++n) _Pragma("unroll") for (int k = 0; k < 2; ++k) \
        acc[ai][bj][m][n] = __builtin_amdgcn_mfma_f32_16x16x32_f16(Bt[n][k], At[m][k], acc[ai][bj][m][n], 0, 0, 0); __builtin_amdgcn_s_setprio(0); } while (0)
#define PG8_WAIT_V(n) asm volatile("s_waitcnt vmcnt(" #n ")" ::: "memory")
#define PG8_WAIT_L(n) asm volatile("s_waitcnt lgkmcnt(" #n ")" ::: "memory")
#define PG8_BAR __builtin_amdgcn_s_barrier()
#define PG8_SCHED __builtin_amdgcn_sched_barrier(0)
    Unit cur, nxt; int ui = 0;
    if (!S.next(0, cur)) return;
    f32x4 acc[2][2][4][2];
#pragma unroll
    for (int a = 0; a < 2; ++a)
#pragma unroll
        for (int b = 0; b < 2; ++b)
#pragma unroll
            for (int m = 0; m < 4; ++m)
#pragma unroll
                for (int n = 0; n < 2; ++n) acc[a][b][m][n] = (f32x4){0.f, 0.f, 0.f, 0.f};
    bf16x8 At[4][2], B0[2][2], B1[2][2];
    const char* cA = (const char*)g.A + (size_t)cur.pm * tstep; const char* cB = (const char*)g.Bt + (size_t)cur.pn * tstep;
    S.a_ready(cur);
    if constexpr (SP2) {
        PG8_STAGE(PG8_SB(0, 0), cB, voffB); PG8_STAGE(PG8_SB(0, 1), cB + hstep, voffB); PG8_STAGE(PG8_SA(0, 0), cA, voffA); PG8_STAGE(PG8_SA(0, 1), cA + hstep, voffA);
        if (wr == 1) PG8_BAR;
        PG8_WAIT_V(2); PG8_BAR;
        PG8_STAGE(PG8_SB(1, 0), cB + kstep, voffB); PG8_STAGE(PG8_SA(1, 0), cA + kstep, voffA); PG8_STAGE(PG8_SB(1, 1), cB + hstep + kstep, voffB);
        PG8_WAIT_V(6); PG8_BAR;
    } else {
        PG8_STAGE(PG8_SB(0, 0), cB, voffB); PG8_STAGE(PG8_SA(0, 0), cA, voffA); PG8_STAGE(PG8_SB(0, 1), cB + hstep, voffB); PG8_STAGE(PG8_SA(0, 1), cA + hstep, voffA);
        if (wr == 1) PG8_BAR;
        PG8_WAIT_V(4); PG8_BAR;
        PG8_STAGE(PG8_SB(1, 0), cB + kstep, voffB); PG8_STAGE(PG8_SA(1, 0), cA + kstep, voffA); PG8_STAGE(PG8_SB(1, 1), cB + hstep + kstep, voffB);
        PG8_WAIT_V(6); PG8_BAR;
    }
    for (;;) {
        const bool has_next = S.next(ui + 1, nxt);
        const char* nA = has_next ? (const char*)g.A + (size_t)nxt.pm * tstep : cA; const char* nB = has_next ? (const char*)g.Bt + (size_t)nxt.pn * tstep : cB;
        for (int t = 0; t < nt; t += 2) {
            const bool last = (t == nt - 2);
            const char* a1 = cA + (size_t)(t + 1) * kstep;
            const char* a2 = last ? nA : cA + (size_t)(t + 2) * kstep; const char* b2 = last ? nB : cB + (size_t)(t + 2) * kstep;
            const char* a3 = a2 + kstep; const char* b3 = b2 + kstep;
            if (last && has_next) S.a_ready(nxt);
            if constexpr (SP2) {
            PG8_LDB(B0, 0, 0); PG8_LDB(B1, 0, 1); PG8_SCHED; PG8_LDA(At, 0, 0); PG8_STAGE(PG8_SA(1, 1), a1 + hstep, voffA);
            PG8_WAIT_V(8); PG8_WAIT_L(0); PG8_BAR; PG8_MMA(0, 0, At, B0); PG8_MMA(0, 1, At, B1); PG8_BAR; PG8_SCHED;
            PG8_LDA(At, 0, 1); PG8_STAGE(PG8_SB(0, 0), b2, voffB); PG8_STAGE(PG8_SB(0, 1), b2 + hstep, voffB); PG8_STAGE(PG8_SA(0, 0), a2, voffA);
            PG8_WAIT_V(8); PG8_WAIT_L(0); PG8_BAR; PG8_MMA(1, 0, At, B0); PG8_MMA(1, 1, At, B1); PG8_BAR; PG8_SCHED;
            PG8_LDB(B0, 1, 0); PG8_LDB(B1, 1, 1); PG8_SCHED; PG8_LDA(At, 1, 0); PG8_STAGE(PG8_SA(0, 1), a2 + hstep, voffA);
            PG8_WAIT_V(8); PG8_WAIT_L(0); PG8_BAR; PG8_MMA(0, 0, At, B0); PG8_MMA(0, 1, At, B1); PG8_BAR; PG8_SCHED;
            PG8_LDA(At, 1, 1); PG8_STAGE(PG8_SB(1, 0), b3, voffB); PG8_STAGE(PG8_SB(1, 1), b3 + hstep, voffB); PG8_STAGE(PG8_SA(1, 0), a3, voffA);
            PG8_WAIT_V(8); PG8_WAIT_L(0); PG8_BAR; PG8_MMA(1, 0, At, B0); PG8_MMA(1, 1, At, B1); PG8_BAR; PG8_SCHED;
            } else {
            PG8_LDB(B0, 0, 0); PG8_SCHED; PG8_LDA(At, 0, 0); PG8_STAGE(PG8_SA(1, 1), a1 + hstep, voffA);
            PG8_WAIT_L(8); PG8_BAR; PG8_WAIT_L(0); PG8_MMA(0, 0, At, B0); PG8_BAR; PG8_SCHED;
            PG8_LDB(B1, 0, 1); PG8_STAGE(PG8_SB(0, 0), b2, voffB);
            PG8_BAR; PG8_WAIT_L(0); PG8_MMA(0, 1, At, B1); PG8_BAR;
            PG8_LDA(At, 0, 1); PG8_STAGE(PG8_SA(0, 0), a2, voffA);
            PG8_BAR; PG8_WAIT_L(0); PG8_MMA(1, 0, At, B0); PG8_BAR; PG8_SCHED;
            PG8_STAGE(PG8_SB(0, 1), b2 + hstep, voffB);
            PG8_WAIT_V(6); PG8_BAR; PG8_MMA(1, 1, At, B1); PG8_BAR;
            PG8_LDB(B0, 1, 0); PG8_SCHED; PG8_LDA(At, 1, 0); PG8_STAGE(PG8_SA(0, 1), a2 + hstep, voffA);
            PG8_WAIT_L(8); PG8_BAR; PG8_WAIT_L(0); PG8_MMA(0, 0, At, B0); PG8_BAR; PG8_SCHED;
            PG8_LDB(B1, 1, 1); PG8_STAGE(PG8_SB(1, 0), b3, voffB);
            PG8_BAR; PG8_WAIT_L(0); PG8_MMA(0, 1, At, B1); PG8_BAR;
            PG8_LDA(At, 1, 1); PG8_STAGE(PG8_SA(1, 0), a3, voffA);
            PG8_BAR; PG8_WAIT_L(0); PG8_MMA(1, 0, At, B0); PG8_BAR; PG8_SCHED;
            PG8_STAGE(PG8_SB(1, 1), b3 + hstep, voffB);
            PG8_WAIT_V(6); PG8_BAR; PG8_MMA(1, 1, At, B1); PG8_BAR;
            }
        }
        if constexpr (ALIGN_EPI) { if (wr == 0) PG8_BAR; }
        if constexpr (!Epi::AFTER_DRAIN) { E(acc, cur, wr, wc, fr, fq); S.done(cur); }
        if (!has_next) break;
#pragma unroll
        for (int a = 0; a < 2; ++a)
#pragma unroll
            for (int b = 0; b < 2; ++b)
#pragma unroll
                for (int m = 0; m < 4; ++m)
#pragma unroll
                    for (int n = 0; n < 2; ++n) acc[a][b][m][n] = (f32x4){0.f, 0.f, 0.f, 0.f};
        cur = nxt; cA = nA; cB = nB; ++ui;
        if constexpr (ALIGN_EPI) { if (wr == 1) PG8_BAR; }
    }
    PG8_WAIT_V(0);
    if constexpr (!ALIGN_EPI) { if (wr == 0) PG8_BAR; }
    PG8_BAR;
    if constexpr (Epi::AFTER_DRAIN) { E.fused(acc, cur, wr, wc, fr, fq, lds, wid, lane); S.done(cur); }
#undef PG8_SA
#undef PG8_SB
#undef PG8_STAGE
#undef PG8_LDA
#undef PG8_LDB
#undef PG8_MMA
#undef PG8_WAIT_V
#undef PG8_WAIT_L
#undef PG8_BAR
#undef PG8_SCHED
}
}
#define GAS __attribute__((address_space(1)))
#define LAS __attribute__((address_space(3)))
typedef unsigned short bf16;
typedef unsigned v4u __attribute__((ext_vector_type(4)));
typedef float f32x4 __attribute__((ext_vector_type(4)));
typedef short bf16x8 __attribute__((ext_vector_type(8)));
typedef GAS unsigned gu32;
typedef GAS unsigned long long gu64;
#define RLX_AGENT __ATOMIC_RELAXED, __HIP_MEMORY_SCOPE_AGENT
#define LDS_WAIT() asm volatile("s_waitcnt lgkmcnt(0)" ::: "memory")
#define VM_WAIT() asm volatile("s_waitcnt vmcnt(0)" ::: "memory")
__device__ __forceinline__ unsigned long long rt() { return __builtin_amdgcn_s_memrealtime(); }
__device__ __forceinline__ unsigned f2bf(float f) { unsigned u = __builtin_bit_cast(unsigned, f); return (u + 0x7fffu + ((u >> 16) & 1u)) >> 16; }
__device__ __forceinline__ unsigned pk2(float lo, float hi) { return f2bf(lo) | (f2bf(hi) << 16); }

#define XB_TMO      128
#define XB_XCNT(j)  (256  + 64 * (j))
#define XB_XSUB(j)  (1280 + 64 * (j))
#define XB_XGEN(j)  (2304 + 64 * (j))
#define XB_TOP      3328
#define XB_TOPGEN   3392
#define XCD_BAR_WORDS 3456
#define XB_SPIN_CAP (1u << 18)

__device__ __forceinline__ unsigned xb_ld(unsigned* p)              { return __hip_atomic_load(p, __ATOMIC_RELAXED, __HIP_MEMORY_SCOPE_AGENT); }
__device__ __forceinline__ unsigned xb_add(unsigned* p, unsigned v) { return __hip_atomic_fetch_add(p, v, __ATOMIC_RELAXED, __HIP_MEMORY_SCOPE_AGENT); }
__device__ __forceinline__ unsigned xb_xcc_id() { return (unsigned)__builtin_amdgcn_s_getreg((3 << 11) | 20) & 0xFu; }
#define XB_SPIN(cond, bar) do { unsigned _sp = 0; while (cond) { __builtin_amdgcn_s_sleep(1); \
    if ((++_sp & 255u) == 0u) { if (xb_ld(&(bar)[XB_TMO])) break; if (_sp > XB_SPIN_CAP) { atomicAdd(&(bar)[XB_TMO], 1u); break; } } } } while (0)

struct XcdBarrier {
    unsigned* bar; unsigned x;
    volatile LAS unsigned* st;
};

__device__ __forceinline__ XcdBarrier xcd_barrier_post(unsigned* bar, volatile LAS unsigned* st) {
    XcdBarrier b; b.bar = bar; b.x = xb_xcc_id(); b.st = st;
    if (threadIdx.x == 0) (void)xb_add(&bar[XB_XCNT(b.x)], 1u);
    return b;
}
__device__ __forceinline__ void xcd_barrier_complete(unsigned* bar, unsigned x, unsigned& nloc, unsigned& nx) {
    const unsigned G = gridDim.x * gridDim.y * gridDim.z;
    unsigned sum, cnt, mine, sp = 0u;
    for (;;) {
        sum = 0u; cnt = 0u; mine = 0u;
#pragma unroll
        for (unsigned j = 0; j < 16; ++j) { const unsigned c = xb_ld(&bar[XB_XCNT(j)]); sum += c; cnt += (c > 0u) ? 1u : 0u; mine = (j == x) ? c : mine; }
        if (sum == G) break;
        __builtin_amdgcn_s_sleep(1);
        if ((++sp & 255u) == 0u) { if (xb_ld(&bar[XB_TMO])) break; if (sp > XB_SPIN_CAP) { atomicAdd(&bar[XB_TMO], 1u); break; } }
    }
    nloc = mine > 0u ? mine : 1u; nx = cnt > 0u ? cnt : 1u;
}

__device__ __forceinline__ void xcd_barrier(const XcdBarrier& b) {
    asm volatile("s_waitcnt vmcnt(0)" ::: "memory");
    __syncthreads();
    if (threadIdx.x == 0) {
        unsigned* bar = b.bar;
        __builtin_amdgcn_s_waitcnt(0);
        unsigned nloc = b.st[0], nx = b.st[1];
        if (nloc == 0u) { xcd_barrier_complete(bar, b.x, nloc, nx); b.st[0] = nloc; b.st[1] = nx; }
        const unsigned old = xb_add(&bar[XB_XSUB(b.x)], 1u);
        const unsigned gen = old / nloc;
        if (old + 1u == (gen + 1u) * nloc) {
            __builtin_amdgcn_fence(__ATOMIC_RELEASE, "agent");
            asm volatile("s_waitcnt vmcnt(0)" ::: "memory");
            const unsigned og = xb_add(&bar[XB_TOP], 1u);
            const unsigned tg = og / nx;
            if (og + 1u == (tg + 1u) * nx) xb_add(&bar[XB_TOPGEN], 1u);
            else XB_SPIN(xb_ld(&bar[XB_TOPGEN]) == tg, bar);
            __builtin_amdgcn_fence(__ATOMIC_ACQUIRE, "agent");
            xb_add(&bar[XB_XGEN(b.x)], 1u);
            asm volatile("s_waitcnt vmcnt(0)" ::: "memory");
        } else {
            XB_SPIN(xb_ld(&bar[XB_XGEN(b.x)]) == gen, bar);
            __builtin_amdgcn_fence(__ATOMIC_ACQUIRE, "agent");
            asm volatile("s_waitcnt vmcnt(0)" ::: "memory");
        }
    }
    __syncthreads();
}
typedef _Float16 h16;
typedef _Float16 h16x8 __attribute__((ext_vector_type(8)));
typedef _Float16 h16x2 __attribute__((ext_vector_type(2)));
typedef float f32x16 __attribute__((ext_vector_type(16)));
typedef unsigned u32x4 __attribute__((ext_vector_type(4)));
typedef unsigned u32x2 __attribute__((ext_vector_type(2)));
constexpr int NB = 2, SEQ = 8192, M = NB * SEQ, D = 1024, DIN = 5376, DRW = 1792, DQKV = 1536, DG = 2048, DFF = 4096, DH = 512, DLO = 1536;
constexpr float ALPHA = 1.189207115002721f;
constexpr float LN_EPS = 1e-5f, ADA_EPS = 1e-6f, GN_EPS = 64e-5f;
constexpr size_t MiB = 1u << 20, KiB = 1u << 10;
constexpr size_t WS_CTL = 0, CTL_ZERO_BYTES = 1 * MiB;
constexpr size_t WS_ADAP = 1 * MiB, WS_ADA = 1 * MiB + 896 * KiB, WS_BON = 2 * MiB;
constexpr size_t WS_WIN = 3 * MiB, WS_WLORA = 13 * MiB + 512 * KiB, WS_WBA = 14 * MiB + 256 * KiB, WS_WBB = 15 * MiB + 256 * KiB, WS_WOUT = 16 * MiB + 256 * KiB,
                 WS_W1 = 18 * MiB + 256 * KiB, WS_W2 = 26 * MiB + 256 * KiB;
constexpr size_t WS_H16 = 36 * MiB, WS_ZRW = 68 * MiB, WS_QKV = 124 * MiB, WS_LOUT = 172 * MiB, WS_LIN = 220 * MiB, WS_PB = 124 * MiB, WS_RB = 156 * MiB, WS_QB = 220 * MiB, WS_MRG = 68 * MiB, WS_HID = 68 * MiB, WS_END = 252 * MiB;
constexpr int CW_ATTQ = 64, CW_BAR = 4096;
constexpr int RING_BYTES = 131072, MISC_OFF = RING_BYTES + 64, LDS_BYTES = RING_BYTES + 512;
constexpr int NATT = 16 * 32, NPRE = 16 * 256, NCHAINB = 16;

struct KArgs { const float* in[27]; float* out; unsigned char* ws; };
struct P {
    const float *x, *c, *w_ada, *b_ada, *w_in, *mu, *w0, *w2, *a0, *a2, *g2, *kk, *ka, *rk, *gn_g, *gn_b, *wba, *wbb, *wout, *ln1g, *ln1b, *w1, *b1, *wf2, *b2, *ln2g, *ln2b;
    float* out; unsigned char* ws;
    unsigned* ctl; float *adap, *ada, *bon;
    h16 *pbuf, *rbuf; unsigned* qbuf; h16 *win_t, *wlora_t, *wba_t, *wbb_t, *wout_t, *w1_t, *w2_t, *h, *zrw, *qkv, *lin, *lout, *mrg, *hid, *ya, *ob, *gates;
};

__device__ __forceinline__ unsigned pkh(float a, float b) { h16x2 v = {(h16)a, (h16)b}; return __builtin_bit_cast(unsigned, v); }
__device__ __forceinline__ void store8h(h16* p, const f32x4& v0, const f32x4& v1) { u32x4 w; w.x = pkh(v0.x, v0.y); w.y = pkh(v0.z, v0.w); w.z = pkh(v1.x, v1.y); w.w = pkh(v1.z, v1.w); *(u32x4*)p = w; }
__device__ __forceinline__ void load8h(const h16* p, f32x4& v0, f32x4& v1) { const h16x8 t = *(const h16x8*)p; v0 = (f32x4){(float)t[0], (float)t[1], (float)t[2], (float)t[3]}; v1 = (f32x4){(float)t[4], (float)t[5], (float)t[6], (float)t[7]}; }
__device__ __forceinline__ float sigmoidf_(float x) { return 1.0f / (1.0f + __expf(-x)); }
__device__ __forceinline__ float wave_sum(float v) {
#pragma unroll
    for (int o = 1; o < 64; o <<= 1) v += __shfl_xor(v, o);
    return v;
}
template <int CTRL> __device__ __forceinline__ float dppmov(float x) { return __builtin_bit_cast(float, __builtin_amdgcn_update_dpp(0, __builtin_bit_cast(int, x), CTRL, 0xf, 0xf, true)); }
__device__ __forceinline__ float red16(float v) { v += dppmov<0xB1>(v); v += dppmov<0x4E>(v); v += dppmov<0x124>(v); v += dppmov<0x128>(v); return v; }

template <class F> struct EpiGen {
    static constexpr bool PERM = true, AFTER_DRAIN = false;
    F f;
    __device__ __forceinline__ void operator()(const f32x4 (&acc)[2][2][4][2], const pg8::Unit& u, int wr, int wc, int fr, int fq) const {
        const int row0 = u.pm * 256 + wr * 64 + fr, col0 = u.pn * 256 + wc * 32 + 8 * fq;
#pragma unroll
        for (int ai = 0; ai < 2; ++ai)
#pragma unroll
            for (int m = 0; m < 4; ++m)
#pragma unroll
                for (int bj = 0; bj < 2; ++bj) f(row0 + ai * 128 + m * 16, col0 + bj * 128, acc[ai][bj][m][0], acc[ai][bj][m][1]);
    }
};
struct F1 {
    h16 *zrw, *qkv, *gates;
    __device__ __forceinline__ void operator()(int row, int col, f32x4 v0, f32x4 v1) const {
        if (col < DRW) store8h(zrw + (size_t)row * DRW + col, v0, v1);
        else if (col < DRW + DQKV) { const int c = col - DRW; if (c < 512) { v0 = v0 * 0.125f; v1 = v1 * 0.125f; } store8h(qkv + (size_t)row * DQKV + c, v0, v1); }
        else { const int c = col - DRW - DQKV;
#pragma unroll
            for (int i = 0; i < 4; ++i) { v0[i] = sigmoidf_(v0[i]); v1[i] = sigmoidf_(v1[i]); }
            store8h(gates + (size_t)row * DG + c, v0, v1); }
    }
};
struct F3 {
    h16* lout;
    __device__ __forceinline__ void operator()(int row, int col, f32x4 v0, f32x4 v1) const { store8h(lout + (size_t)row * DLO + col, v0, v1); }
};
struct F5Y { h16* gates;
    __device__ __forceinline__ void operator()(int row, int col, f32x4 v0, f32x4 v1) const {
        f32x4 g0, g1; h16* gp = gates + (size_t)row * DG + 1024 + col; load8h(gp, g0, g1); store8h(gp, v0 * g0, v1 * g1); } };
struct F5X { h16* mrg; const h16* gates;
    __device__ __forceinline__ void operator()(int row, int col, f32x4 v0, f32x4 v1) const {
        f32x4 g0, g1, m0, m1; load8h(gates + (size_t)row * DG + col, g0, g1); load8h(gates + (size_t)row * DG + 1024 + col, m0, m1); store8h(mrg + (size_t)row * D + col, m0 + v0 * g0, m1 + v1 * g1); } };
struct F6 { const float* x; float* out; const float* ada;
    __device__ __forceinline__ void operator()(int row, int col, f32x4 v0, f32x4 v1) const {
        const float* g = ada + (row >> 13) * 6144 + 2048 + col; const size_t o = (size_t)row * D + col;
        const f32x4 x0 = *(const f32x4*)(x + o), x1 = *(const f32x4*)(x + o + 4), g0 = *(const f32x4*)g, g1 = *(const f32x4*)(g + 4);
        *(f32x4*)(out + o) = x0 * ALPHA + g0 * v0; *(f32x4*)(out + o + 4) = x1 * ALPHA + g1 * v1; } };
struct F8 { h16* hid; const float* b1;
    __device__ __forceinline__ void operator()(int row, int col, f32x4 v0, f32x4 v1) const {
        const f32x4 c0 = *(const f32x4*)(b1 + col), c1 = *(const f32x4*)(b1 + col + 4);
#pragma unroll
        for (int i = 0; i < 4; ++i) { float a = fmaxf(v0[i] + c0[i], 0.f); v0[i] = a * a; a = fmaxf(v1[i] + c1[i], 0.f); v1[i] = a * a; }
        store8h(hid + (size_t)row * DFF + col, v0, v1); } };
struct F9 { float* out; const float* ada; const float* b2;
    __device__ __forceinline__ void operator()(int row, int col, f32x4 v0, f32x4 v1) const {
        const float* g = ada + (row >> 13) * 6144 + 5120 + col; const size_t o = (size_t)row * D + col;
        const f32x4 x0 = *(const f32x4*)(out + o), x1 = *(const f32x4*)(out + o + 4), g0 = *(const f32x4*)g, g1 = *(const f32x4*)(g + 4), c0 = *(const f32x4*)(b2 + col), c1 = *(const f32x4*)(b2 + col + 4);
        *(f32x4*)(out + o) = x0 * ALPHA + g0 * (v0 + c0); *(f32x4*)(out + o + 4) = x1 * ALPHA + g1 * (v1 + c1); } };

template <class F> __device__ __forceinline__ void run_gemm(LAS unsigned char* lds, const h16* A, const h16* Bt, int N, int K, const F& f, int gsz = -1, int gidx = -1) {
    asm volatile("" : "+s"(N), "+s"(K));
    if (gsz < 0) { gsz = (int)gridDim.x; gidx = (int)blockIdx.x; }
    pg8::Gemm g{(const pg8::bf16_t*)A, (const pg8::bf16_t*)Bt, M, N, K}; pg8::StaticOrder S; S.init(M, N, gsz, gidx);
    EpiGen<F> E{f};
    pg8::gemm_phase<EpiGen<F>, pg8::StaticOrder, true, true>(lds, g, S, E);
}

__device__ __forceinline__ void p0_transpose_item(const float* W, int K, int N, h16* WT, LAS float* scr, int item, int lane) {
    const int nblk = N / 32, kb = item / nblk, nb = item % nblk, k0 = 64 * kb, n0 = 32 * nb;
#pragma unroll 8
    for (int i = 0; i < 32; ++i) { const int kk = 2 * i + (lane >> 5); scr[kk * 33 + (lane & 31)] = W[(size_t)(k0 + kk) * N + n0 + (lane & 31)]; }
    LDS_WAIT(); asm volatile("" ::: "memory");
    const int c = lane & 7;
#pragma unroll
    for (int j = 0; j < 4; ++j) { const int n = (lane >> 3) + 8 * j; const LAS float* s = scr + (8 * c) * 33 + n;
        u32x4 o; o.x = pkh(s[0 * 33], s[1 * 33]); o.y = pkh(s[2 * 33], s[3 * 33]); o.z = pkh(s[4 * 33], s[5 * 33]); o.w = pkh(s[6 * 33], s[7 * 33]);
        *(u32x4*)(WT + (size_t)(n0 + n) * K + k0 + 8 * c) = o; }
    LDS_WAIT(); asm volatile("" ::: "memory");
}
__device__ __forceinline__ void phase0(const P& p, LAS unsigned char* lds, int tid, int lane, int wave) {
    LAS float* scr = (LAS float*)(lds + wave * 16384);
    const int G = gridDim.x, gw = blockIdx.x * 8 + wave, NGW = G * 8;
    constexpr int I_IN = (D / 64) * (DIN / 32), I_BA = (DH / 64) * (D / 32), I_OUT = (D / 64) * (D / 32), I_1 = (D / 64) * (DFF / 32), I_2 = (DFF / 64) * (D / 32);
    constexpr int NITEMS = I_IN + 2 * I_BA + I_OUT + I_1 + I_2;
    for (int it = gw; it < NITEMS; it += NGW) {
        int r = it;
        if (r < I_IN) { p0_transpose_item(p.w_in, D, DIN, p.win_t, scr, r, lane); continue; } r -= I_IN;
        if (r < I_BA) { p0_transpose_item(p.wba, DH, D, p.wba_t, scr, r, lane); continue; } r -= I_BA;
        if (r < I_BA) { p0_transpose_item(p.wbb, DH, D, p.wbb_t, scr, r, lane); continue; } r -= I_BA;
        if (r < I_OUT) { p0_transpose_item(p.wout, D, D, p.wout_t, scr, r, lane); continue; } r -= I_OUT;
        if (r < I_1) { p0_transpose_item(p.w1, D, DFF, p.w1_t, scr, r, lane); continue; } r -= I_1;
        p0_transpose_item(p.wf2, DFF, D, p.w2_t, scr, r, lane);
    }
    for (int idx = blockIdx.x * 512 + tid; idx < DLO * 256; idx += G * 512) {
        const int n = idx >> 8, k = idx & 255; float v = 0.f;
        if (n < 512) { if (k < 64) v = p.w2[k * 512 + n]; }
        else if (n < 1024) { if (k >= 64 && k < 128) v = p.a2[(k - 64) * 512 + n - 512]; }
        else { if (k >= 128) v = p.g2[(k - 128) * 512 + n - 1024]; }
        p.wlora_t[idx] = (h16)v;
    }
    for (int u = blockIdx.x; u < 192; u += G) {
        const int slice = u / 12, n = (u % 12) * 512 + tid; float a0 = 0.f, a1 = 0.f;
#pragma unroll 8
        for (int kk = 0; kk < 64; ++kk) { const int k = slice * 64 + kk; const float c0 = p.c[k], c1 = p.c[1024 + k], w = p.w_ada[(size_t)k * 6144 + n];
            a0 += c0 * sigmoidf_(c0) * w; a1 += c1 * sigmoidf_(c1) * w; }
        p.adap[(slice * 2 + 0) * 6144 + n] = a0; p.adap[(slice * 2 + 1) * 6144 + n] = a1;
    }
}
__device__ __forceinline__ void phase0b(const P& p, LAS unsigned char* lds, int tid, int lane, int wave) {
    LAS float* mod = (LAS float*)lds;
    for (int i = tid; i < 4096; i += 512) { const int b = i >> 11, j = i & 2047; float s = p.b_ada[j];
#pragma unroll
        for (int sl = 0; sl < 16; ++sl) s += p.adap[(sl * 2 + b) * 6144 + j];
        mod[i] = s; }
    if (blockIdx.x == 0) for (int i = tid; i < 2 * 6144; i += 512) { const int b = i / 6144, j = i % 6144; float s = p.b_ada[j];
#pragma unroll
        for (int sl = 0; sl < 16; ++sl) s += p.adap[(sl * 2 + b) * 6144 + j];
        p.ada[i] = s; }
    __syncthreads();
    const int gw = blockIdx.x * 8 + wave, NGW = gridDim.x * 8;
    for (int m = gw; m < M; m += NGW) {
        const f32x4* xr = (const f32x4*)(p.x + (size_t)m * D) + lane; const int b = m >> 13;
        f32x4 v[4]; float s = 0.f;
#pragma unroll
        for (int j = 0; j < 4; ++j) { v[j] = xr[64 * j]; s += (v[j].x + v[j].y) + (v[j].z + v[j].w); }
        const float mean = wave_sum(s) * (1.f / D); float s2 = 0.f;
#pragma unroll
        for (int j = 0; j < 4; ++j) { v[j] = v[j] - mean; s2 += (v[j].x * v[j].x + v[j].y * v[j].y) + (v[j].z * v[j].z + v[j].w * v[j].w); }
        const float rstd = 1.f / sqrtf(wave_sum(s2) * (1.f / D) + ADA_EPS);
        uint2* o8 = (uint2*)(p.h + (size_t)m * D) + lane;
#pragma unroll
        for (int j = 0; j < 4; ++j) { const int col = 4 * (lane + 64 * j); const f32x4 sh = *(const LAS f32x4*)(mod + b * 2048 + col), sc = *(const LAS f32x4*)(mod + b * 2048 + 1024 + col);
            const f32x4 r = v[j] * rstd * (sc + 1.0f) + sh; uint2 w; w.x = pkh(r.x, r.y); w.y = pkh(r.z, r.w); o8[64 * j] = w; }
    }
}
__device__ __forceinline__ void phase2(const P& p, int tid) {
    for (int idx = blockIdx.x * 512 + tid; idx < M * 32; idx += gridDim.x * 512) {
        const int t = idx >> 5, j8 = (idx & 31) * 8, col = 1536 + j8;
        f32x4 c0, c1, q0 = {0.f, 0.f, 0.f, 0.f}, q1 = {0.f, 0.f, 0.f, 0.f};
        load8h(p.zrw + (size_t)t * DRW + col, c0, c1); if (t & (SEQ - 1)) load8h(p.zrw + (size_t)(t - 1) * DRW + col, q0, q1);
        const f32x4 m0 = *(const f32x4*)(p.mu + col), m1 = *(const f32x4*)(p.mu + col + 4);
        c0 = c0 + m0 * (q0 - c0); c1 = c1 + m1 * (q1 - c1);
#pragma unroll
        for (int i = 0; i < 4; ++i) { if (j8 < 64) { c0[i] = tanhf(c0[i]); c1[i] = tanhf(c1[i]); } else if (j8 >= 128) { c0[i] = sigmoidf_(c0[i]); c1[i] = sigmoidf_(c1[i]); } }
        store8h(p.lin + (size_t)t * 256 + j8, c0, c1);
    }
}
constexpr int P64 = 72, P32 = 40;
constexpr int L_AM = 0, L_BM = 4608, L_KM = 9216, L_RM = 13824, L_AMT = 18432, L_BMT = 23552, L_KMT = 28672, L_VT = 33792, L_NR0 = 38912, L_NR1 = 41472, L_NT0 = 44032, L_NT1 = 46592,
              L_TR0 = 49152, L_TR1 = 51712, L_AAK = 54272, L_ARB = 56832, L_ARK = 59392, L_W1T = 61952, L_UT = 67072, L_TAT = 72192, L_CUM = 77312, L_GM = 85504, L_GL = 85760;
__device__ __forceinline__ int crow(int r, int hi) { return (r & 3) + 8 * (r >> 2) + 4 * hi; }
template <int KS> __device__ __forceinline__ f32x16 mm_tile(LAS unsigned char* A, int arow, int apitch, LAS unsigned char* B, int brow, int bpitch, f32x16 acc, int hi) {
#pragma unroll
    for (int s = 0; s < KS; ++s) { const h16x8 a = *(const LAS h16x8*)(A + (arow * apitch + 16 * s + 8 * hi) * 2), b = *(const LAS h16x8*)(B + (brow * bpitch + 16 * s + 8 * hi) * 2);
        acc = __builtin_amdgcn_mfma_f32_32x32x16_f16(a, b, acc, 0, 0, 0); }
    return acc;
}
__device__ __forceinline__ void wr_row(LAS unsigned char* arr, const f32x16& v, int n, int hi) {
#pragma unroll
    for (int r = 0; r < 16; ++r) ((LAS h16*)arr)[crow(r, hi) * P32 + n] = (h16)v[r];
}
__device__ __forceinline__ void wr_tr(LAS unsigned char* arr, const f32x16& v, int nrow, int hi) {
#pragma unroll
    for (int jj = 0; jj < 4; ++jj) { u32x2 w; w.x = pkh(v[4 * jj], v[4 * jj + 1]); w.y = pkh(v[4 * jj + 2], v[4 * jj + 3]); *(LAS u32x2*)(arr + (nrow * P32 + 8 * jj + 4 * hi) * 2) = w; }
}
__device__ __forceinline__ f32x16 zero16() { f32x16 z;
#pragma unroll
    for (int r = 0; r < 16; ++r) z[r] = 0.f;
    return z; }
__device__ __forceinline__ void pre_unit(const P& p, LAS unsigned char* sm, int unit, int tid, int lane, int wave) {
    const int bh = unit >> 8, c = unit & 255, b = bh >> 3, h = bh & 7, r32 = lane & 31, hi = lane >> 5, col = h * 64 + lane;
    LAS float* CUM = (LAS float*)(sm + L_CUM); LAS float* GM = (LAS float*)(sm + L_GM); LAS float* GL = (LAS float*)(sm + L_GL);
    const float mu_r = p.mu[col], mu_k = p.mu[512 + col], mu_v = p.mu[1024 + col], ckk = p.kk[col], cka = p.ka[col], crk = p.rk[col], cw0 = p.w0[col], ca0 = p.a0[col];
    float av[4], bv[4], kv[4], rv[4], vv[4], lwv[4];
#pragma unroll
    for (int i = 0; i < 4; ++i) {
        const int tt = wave * 4 + i, t = c * 32 + tt; const size_t gm = (size_t)b * SEQ + t;
        const h16* zr = p.zrw + gm * DRW; const h16* lo = p.lout + gm * DLO;
        float r = (float)zr[col], k = (float)zr[512 + col], v = (float)zr[1024 + col], rp = 0.f, kp = 0.f, vp = 0.f;
        if (t > 0) { rp = (float)zr[col - DRW]; kp = (float)zr[512 + col - DRW]; vp = (float)zr[1024 + col - DRW]; }
        r += mu_r * (rp - r); k += mu_k * (kp - k); v += mu_v * (vp - v);
        const float xw = -(cw0 + (float)lo[col]), spw = fmaxf(xw, 0.f) + __logf(1.f + __expf(-fabsf(xw))), ar = sigmoidf_(ca0 + (float)lo[512 + col]);
        const float lw = -__expf(-spw - 0.5f);
        const float kkv = k * ckk, nrm = sqrtf(wave_sum(kkv * kkv)), kkn = kkv / fmaxf(nrm, 1e-12f);
        const float k2 = k * (1.0f + (ar - 1.0f) * cka), bon = wave_sum(r * k2 * crk);
        if (lane == 0) p.bon[gm * 8 + h] = bon;
        av[i] = -kkn; bv[i] = kkn * ar; kv[i] = k2; rv[i] = r; vv[i] = v; lwv[i] = lw;
        CUM[tt * 64 + lane] = lw;
    }
    __syncthreads();
    if (tid < 64) { float s = 0.f, mid = 0.f;
#pragma unroll 8
        for (int t = 0; t < 32; ++t) { s += CUM[t * 64 + tid]; CUM[t * 64 + tid] = s; if (t == 15) mid = s; }
        GM[tid] = __expf(mid); GL[tid] = __expf(s); }
    __syncthreads();
    {   const float mid = CUM[15 * 64 + lane];
#pragma unroll
        for (int i = 0; i < 4; ++i) { const int tt = wave * 4 + i; const float cum = CUM[tt * 64 + lane], cp = cum - lwv[i];
            const float e1 = __expf(mid - cum);
            const h16 am = (h16)(av[i] * __expf(cp - mid)), bm = (h16)(bv[i] * e1), km = (h16)(kv[i] * e1), rm = (h16)(rv[i] * __expf(cum - mid));
            ((LAS h16*)(sm + L_AM))[tt * P64 + lane] = am; ((LAS h16*)(sm + L_BM))[tt * P64 + lane] = bm; ((LAS h16*)(sm + L_KM))[tt * P64 + lane] = km; ((LAS h16*)(sm + L_RM))[tt * P64 + lane] = rm;
            ((LAS h16*)(sm + L_AMT))[lane * P32 + tt] = am; ((LAS h16*)(sm + L_BMT))[lane * P32 + tt] = bm; ((LAS h16*)(sm + L_KMT))[lane * P32 + tt] = km; ((LAS h16*)(sm + L_VT))[lane * P32 + tt] = (h16)vv[i]; }
    }
    __syncthreads();
    if (wave < 4) {
        f32x16 acc = mm_tile<4>(sm + (wave < 2 ? L_AM : L_RM), r32, P64, sm + ((wave & 1) ? L_KM : L_BM), r32, P64, zero16(), hi);
#pragma unroll
        for (int r = 0; r < 16; ++r) { const int t = crow(r, hi); const bool keep = (wave < 2) ? (r32 < t) : (r32 <= t); acc[r] = keep ? acc[r] : 0.f; }
        if (wave == 0) {
            wr_row(sm + L_NR0, acc, r32, hi); wr_tr(sm + L_NT0, acc, r32, hi);
            f32x16 tacc = acc;
#pragma unroll
            for (int r = 0; r < 16; ++r) if (crow(r, hi) == r32) tacc[r] += 1.0f;
            wr_row(sm + L_TR0, tacc, r32, hi);
#pragma unroll
            for (int i = 0; i < 4; ++i) {
                LAS unsigned char* nr = sm + ((i & 1) ? L_NR1 : L_NR0); LAS unsigned char* nt = sm + ((i & 1) ? L_NT1 : L_NT0);
                LAS unsigned char* nr2 = sm + ((i & 1) ? L_NR0 : L_NR1); LAS unsigned char* nt2 = sm + ((i & 1) ? L_NT0 : L_NT1);
                LAS unsigned char* tr = sm + ((i & 1) ? L_TR1 : L_TR0); LAS unsigned char* tr2 = sm + ((i & 1) ? L_TR0 : L_TR1);
                const f32x16 nacc = mm_tile<2>(nr, r32, P32, nt, r32, P32, zero16(), hi);
                wr_row(nr2, nacc, r32, hi); wr_tr(nt2, nacc, r32, hi);
                tacc = mm_tile<2>(tr, r32, P32, nt2, r32, P32, tacc, hi);
                wr_row(tr2, tacc, r32, hi);
            }
        } else if (wave == 1) {
            wr_row(sm + L_AAK, acc, r32, hi);
#pragma unroll
            for (int vt = 0; vt < 2; ++vt) { const f32x16 w1 = mm_tile<2>(sm + L_AAK, r32, P32, sm + L_VT, 32 * vt + r32, P32, zero16(), hi); wr_tr(sm + L_W1T, w1, 32 * vt + r32, hi); }
        } else if (wave == 2) wr_row(sm + L_ARB, acc, r32, hi);
        else wr_row(sm + L_ARK, acc, r32, hi);
    }
    __syncthreads();
    if (wave < 2) { const f32x16 u = mm_tile<2>(sm + L_TR0, r32, P32, sm + L_W1T, 32 * wave + r32, P32, zero16(), hi); wr_tr(sm + L_UT, u, 32 * wave + r32, hi); }
    else if (wave < 4) { const f32x16 ta = mm_tile<2>(sm + L_TR0, r32, P32, sm + L_AMT, 32 * (wave - 2) + r32, P32, zero16(), hi); wr_tr(sm + L_TAT, ta, 32 * (wave - 2) + r32, hi); }
    __syncthreads();
    if (wave < 4) {
        const int kt = wave >> 1, mt = wave & 1, k = 32 * mt + r32;
        const f32x16 x = mm_tile<2>(sm + L_TAT, 32 * kt + r32, P32, sm + L_BMT, k, P32, zero16(), hi);
        const float gl = GL[k], f1 = gl / GM[k]; float pv[16];
#pragma unroll
        for (int r = 0; r < 16; ++r) { const int k2 = 32 * kt + crow(r, hi); pv[r] = f1 * x[r] * GM[k2] + (k2 == k ? gl : 0.f); }
        u32x4 w0, w1; w0.x = pkh(pv[0], pv[1]); w0.y = pkh(pv[2], pv[3]); w0.z = pkh(pv[4], pv[5]); w0.w = pkh(pv[6], pv[7]); w1.x = pkh(pv[8], pv[9]); w1.y = pkh(pv[10], pv[11]); w1.z = pkh(pv[12], pv[13]); w1.w = pkh(pv[14], pv[15]);
        u32x4* dst = (u32x4*)p.pbuf + (size_t)unit * 512 + (mt * 4 + 2 * kt) * 64 + lane;
        dst[0] = w0; dst[64] = w1;
    } else if (wave < 6) {
        const int kt = wave - 4;
        const f32x16 x = mm_tile<2>(sm + L_TAT, 32 * kt + r32, P32, sm + L_ARB, r32, P32, zero16(), hi);
        float pv[16];
#pragma unroll
        for (int r = 0; r < 16; ++r) { const int k2 = 32 * kt + crow(r, hi); pv[r] = (x[r] + (float)((LAS h16*)(sm + L_RM))[r32 * P64 + k2]) * GM[k2]; }
        u32x4 w0, w1; w0.x = pkh(pv[0], pv[1]); w0.y = pkh(pv[2], pv[3]); w0.z = pkh(pv[4], pv[5]); w0.w = pkh(pv[6], pv[7]); w1.x = pkh(pv[8], pv[9]); w1.y = pkh(pv[10], pv[11]); w1.z = pkh(pv[12], pv[13]); w1.w = pkh(pv[14], pv[15]);
        u32x4* dst = (u32x4*)p.rbuf + (size_t)unit * 256 + (2 * kt) * 64 + lane;
        dst[0] = w0; dst[64] = w1;
    } else {
        const int vt = wave - 6;
        f32x16 y = mm_tile<2>(sm + L_ARB, r32, P32, sm + L_UT, 32 * vt + r32, P32, zero16(), hi);
        y = mm_tile<2>(sm + L_ARK, r32, P32, sm + L_VT, 32 * vt + r32, P32, y, hi);
        h16* dst = p.ya + ((size_t)b * SEQ + c * 32) * DH + h * 64 + 32 * vt + r32;
#pragma unroll
        for (int r = 0; r < 16; ++r) dst[(size_t)crow(r, hi) * DH] = (h16)y[r];
    }
    if (wave >= 4) {
        const int mt = (wave - 4) >> 1, vt = (wave - 4) & 1;
        f32x16 q = mm_tile<2>(sm + L_BMT, 32 * mt + r32, P32, sm + L_UT, 32 * vt + r32, P32, zero16(), hi);
        q = mm_tile<2>(sm + L_KMT, 32 * mt + r32, P32, sm + L_VT, 32 * vt + r32, P32, q, hi);
        unsigned* dst = p.qbuf + (size_t)unit * 2048 + ((vt * 2 + mt) * 8) * 64 + lane;
#pragma unroll
        for (int r2 = 0; r2 < 8; ++r2) { const int k0 = 32 * mt + crow(2 * r2, hi), k1 = 32 * mt + crow(2 * r2 + 1, hi);
            dst[r2 * 64] = pkh(q[2 * r2] * (GL[k0] / GM[k0]), q[2 * r2 + 1] * (GL[k1] / GM[k1])); }
    }
    __syncthreads();
}
struct ChainPQ { h16x8 pa[8]; unsigned q[16]; };
__device__ __forceinline__ void chain_load_pq(ChainPQ& d, const u32x4* Pb, const unsigned* Qb, int c) {
#pragma unroll
    for (int i = 0; i < 8; ++i) d.pa[i] = __builtin_bit_cast(h16x8, Pb[(size_t)c * 512 + i * 64]);
#pragma unroll
    for (int i = 0; i < 16; ++i) d.q[i] = Qb[(size_t)c * 2048 + i * 64];
}
__device__ __forceinline__ float h_lo(unsigned w) { return (float)__builtin_bit_cast(h16x2, w)[0]; }
__device__ __forceinline__ float h_hi(unsigned w) { return (float)__builtin_bit_cast(h16x2, w)[1]; }
__device__ __forceinline__ void chain_step(const P& p, const ChainPQ& cur, f32x16& c0, f32x16& c1, const u32x4* Rb, h16* ya, int c, int hi) {
    h16x8 ra[4]; float yl[16];
#pragma unroll
    for (int s = 0; s < 4; ++s) ra[s] = __builtin_bit_cast(h16x8, Rb[(size_t)c * 256 + s * 64]);
    h16* yr = ya + (size_t)c * 32 * DH;
#pragma unroll
    for (int r = 0; r < 16; ++r) yl[r] = (float)yr[(size_t)crow(r, hi) * DH];
    h16x8 bs[4];
#pragma unroll
    for (int e = 0; e < 8; ++e) { bs[0][e] = (h16)c0[e]; bs[1][e] = (h16)c0[8 + e]; bs[2][e] = (h16)c1[e]; bs[3][e] = (h16)c1[8 + e]; }
    f32x16 n0, n1;
#pragma unroll
    for (int r2 = 0; r2 < 8; ++r2) { n0[2 * r2] = h_lo(cur.q[r2]); n0[2 * r2 + 1] = h_hi(cur.q[r2]); n1[2 * r2] = h_lo(cur.q[8 + r2]); n1[2 * r2 + 1] = h_hi(cur.q[8 + r2]); }
#pragma unroll
    for (int s = 0; s < 4; ++s) { n0 = __builtin_amdgcn_mfma_f32_32x32x16_f16(cur.pa[s], bs[s], n0, 0, 0, 0); n1 = __builtin_amdgcn_mfma_f32_32x32x16_f16(cur.pa[4 + s], bs[s], n1, 0, 0, 0); }
    f32x16 y;
#pragma unroll
    for (int r = 0; r < 16; ++r) y[r] = yl[r];
#pragma unroll
    for (int s = 0; s < 4; ++s) y = __builtin_amdgcn_mfma_f32_32x32x16_f16(ra[s], bs[s], y, 0, 0, 0);
#pragma unroll
    for (int r = 0; r < 16; ++r) yr[(size_t)crow(r, hi) * DH] = (h16)y[r];
    c0 = n0; c1 = n1;
}
__device__ __forceinline__ void chain_wave(const P& p, int bh, int vt, int lane) {
    const int b = bh >> 3, h = bh & 7, r32 = lane & 31, hi = lane >> 5;
    const u32x4* Pb = (const u32x4*)p.pbuf + (size_t)bh * 256 * 512 + lane;
    const u32x4* Rb = (const u32x4*)p.rbuf + (size_t)bh * 256 * 256 + lane;
    const unsigned* Qb = p.qbuf + (size_t)bh * 256 * 2048 + vt * 1024 + lane;
    h16* ya = p.ya + (size_t)b * SEQ * DH + h * 64 + vt * 32 + r32;
    f32x16 c0 = zero16(), c1 = zero16();
    ChainPQ A, B;
    chain_load_pq(A, Pb, Qb, 0);
    for (int c = 0; c < 256; c += 2) {
        chain_load_pq(B, Pb, Qb, c + 1);
        chain_step(p, A, c0, c1, Rb, ya, c, hi);
        if (c + 2 < 256) chain_load_pq(A, Pb, Qb, c + 2);
        chain_step(p, B, c0, c1, Rb, ya, c + 1, hi);
    }
}
__device__ __forceinline__ void attn_unit(const P& p, LAS unsigned char* sm, int unit, int tid, int lane, int wave) {
    const int bh = unit >> 5, qb = unit & 31, b = bh >> 3, h = bh & 7, q0 = qb * 256, qw0 = q0 + wave * 32, r32 = lane & 31, hi = lane >> 5, qabs = qw0 + r32;
    const h16* base = p.qkv + (size_t)b * SEQ * DQKV + h * 64;
    h16x8 qf[4];
#pragma unroll
    for (int d0 = 0; d0 < 4; ++d0) qf[d0] = *(const h16x8*)(base + (size_t)(qw0 + r32) * DQKV + d0 * 16 + hi * 8);
    f32x16 o0, o1;
#pragma unroll
    for (int r = 0; r < 16; ++r) { o0[r] = 0.f; o1[r] = 0.f; }
    float carry = 0.f; int done = 0;
    const int lkey = tid >> 3, lc = tid & 7, ks_ = lkey >> 4, rem = lkey & 15, hk = (rem >> 2) & 1, e_ = ((rem >> 3) << 2) | (rem & 3);
    LAS unsigned short* vt = (LAS unsigned short*)(sm + 8192 + (((ks_ * 2 + hk) * 64 + lc * 8) * 8 + e_) * 2);
    volatile LAS unsigned* nd = (volatile LAS unsigned*)(sm + RING_BYTES + 16);
    if (tid == 0) { nd[0] = 0u; nd[1] = 0u; }
    int it = 0;
    for (int jt = (q0 + 255) >> 6; jt >= 0; --jt, ++it) {
        const int k0 = jt * 64;
        { const h16* src = base + (size_t)(k0 + lkey) * DQKV + lc * 8;
          const u32x4 kv = *(const u32x4*)(src + 512), vv = *(const u32x4*)(src + 1024);
          *(LAS u32x4*)(sm + lc * 1024 + lkey * 16) = kv;
          vt[0] = (unsigned short)(vv.x & 0xffffu); vt[8] = (unsigned short)(vv.x >> 16); vt[16] = (unsigned short)(vv.y & 0xffffu); vt[24] = (unsigned short)(vv.y >> 16);
          vt[32] = (unsigned short)(vv.z & 0xffffu); vt[40] = (unsigned short)(vv.z >> 16); vt[48] = (unsigned short)(vv.w & 0xffffu); vt[56] = (unsigned short)(vv.w >> 16); }
        __syncthreads();
        if (tid == 0) nd[(it + 1) & 1] = 0u;
        if (!done && k0 <= qw0 + 31) {
            f32x16 p0, p1;
#pragma unroll
            for (int r = 0; r < 16; ++r) { p0[r] = 0.f; p1[r] = 0.f; }
#pragma unroll
            for (int d0 = 0; d0 < 4; ++d0) { const h16x8 a0 = *(const LAS h16x8*)(sm + (d0 * 2 + hi) * 1024 + r32 * 16), a1 = *(const LAS h16x8*)(sm + (d0 * 2 + hi) * 1024 + 512 + r32 * 16);
                p0 = __builtin_amdgcn_mfma_f32_32x32x16_f16(a0, qf[d0], p0, 0, 0, 0); p1 = __builtin_amdgcn_mfma_f32_32x32x16_f16(a1, qf[d0], p1, 0, 0, 0); }
            float L0[16], L1[16];
#pragma unroll
            for (int r = 0; r < 16; ++r) { const int key = k0 + crow(r, hi);
                { const float z = p0[r], sp = fmaxf(z, 0.f) + __logf(1.f + __expf(-fabsf(z))); L0[r] = (key < qabs) ? -sp : 0.f; p0[r] = z - sp; }
                { const float z = p1[r], sp = fmaxf(z, 0.f) + __logf(1.f + __expf(-fabsf(z))); L1[r] = (key + 32 < qabs) ? -sp : 0.f; p1[r] = z - sp; } }
            float Gs[8], PG[8], sgo[8];
#pragma unroll
            for (int j = 0; j < 4; ++j) { Gs[j] = (L0[4 * j] + L0[4 * j + 1]) + (L0[4 * j + 2] + L0[4 * j + 3]); Gs[4 + j] = (L1[4 * j] + L1[4 * j + 1]) + (L1[4 * j + 2] + L1[4 * j + 3]); }
#pragma unroll
            for (int j = 0; j < 8; ++j) PG[j] = __shfl_xor(Gs[j], 32);
            float run = 0.f;
#pragma unroll
            for (int j = 7; j >= 0; --j) { const float ev = hi ? PG[j] : Gs[j], od = hi ? Gs[j] : PG[j]; const float so = run; run += od; const float se = run; run += ev; sgo[j] = hi ? so : se; }
            h16x8 pa[4];
#pragma unroll
            for (int j = 0; j < 4; ++j) {
                float acc = carry + sgo[j], acc1 = carry + sgo[4 + j];
#pragma unroll
                for (int i = 3; i >= 0; --i) { const int r = 4 * j + i, key = k0 + crow(r, hi);
                    const float a0 = (key < qabs) ? __expf(p0[r] + acc) : 0.f; acc += L0[r];
                    const float a1 = (key + 32 < qabs) ? __expf(p1[r] + acc1) : 0.f; acc1 += L1[r];
                    pa[j >> 1][(j & 1) * 4 + i] = (h16)a0; pa[2 + (j >> 1)][(j & 1) * 4 + i] = (h16)a1; }
            }
            carry += run;
#pragma unroll
            for (int ks = 0; ks < 4; ++ks) { const h16x8 v0 = *(const LAS h16x8*)(sm + 8192 + ((ks * 2 + hi) * 64 + r32) * 16), v1 = *(const LAS h16x8*)(sm + 8192 + ((ks * 2 + hi) * 64 + 32 + r32) * 16);
                o0 = __builtin_amdgcn_mfma_f32_32x32x16_f16(pa[ks], v0, o0, 0, 0, 0); o1 = __builtin_amdgcn_mfma_f32_32x32x16_f16(pa[ks], v1, o1, 0, 0, 0); }
            done = __all(carry < -104.0f) ? 1 : 0;
        }
        if (lane == 0 && !done) nd[it & 1] = 1u;
        __syncthreads();
        if (nd[it & 1] == 0u) break;
    }
    h16* ob = p.ob + ((size_t)b * SEQ + qw0) * DH + h * 64;
#pragma unroll
    for (int r = 0; r < 16; ++r) { const int q = crow(r, hi); ob[(size_t)q * DH + r32] = (h16)o0[r]; ob[(size_t)q * DH + 32 + r32] = (h16)o1[r]; }
}
__device__ __forceinline__ void phase4b(const P& p, int lane, int wave) {
    const int gw = blockIdx.x * 8 + wave, NGW = gridDim.x * 8;
    for (int task = gw; task < M * 8; task += NGW) {
        const int t = task >> 3, h = task & 7, col = h * 64 + lane;
        const float y = (float)p.ya[(size_t)t * DH + col], mean = wave_sum(y) * (1.f / 64.f), d = y - mean, var = wave_sum(d * d) * (1.f / 64.f);
        const float gn = d * (1.0f / sqrtf(var + GN_EPS)) * p.gn_g[col] + p.gn_b[col];
        float v = (float)p.zrw[(size_t)t * DRW + 1024 + col], vp = 0.f; if (t & (SEQ - 1)) vp = (float)p.zrw[(size_t)(t - 1) * DRW + 1024 + col];
        v += p.mu[1024 + col] * (vp - v);
        const float g = (float)p.lout[(size_t)t * DLO + 1024 + col], bon = p.bon[(size_t)t * 8 + h];
        p.ya[(size_t)t * DH + col] = (h16)((gn + bon * v) * g);
    }
}
template <bool FINAL> __device__ __forceinline__ void phase_ln(const P& p, int lane, int wave) {
    const int gw = blockIdx.x * 8 + wave, NGW = gridDim.x * 8;
    const float* lg = FINAL ? p.ln2g : p.ln1g; const float* lb = FINAL ? p.ln2b : p.ln1b;
    for (int m = gw; m < M; m += NGW) {
        f32x4* xr = (f32x4*)(p.out + (size_t)m * D) + lane; const int b = m >> 13;
        f32x4 v[4]; float s = 0.f;
#pragma unroll
        for (int j = 0; j < 4; ++j) { v[j] = xr[64 * j]; s += (v[j].x + v[j].y) + (v[j].z + v[j].w); }
        float mean = wave_sum(s) * (1.f / D), s2 = 0.f;
#pragma unroll
        for (int j = 0; j < 4; ++j) { v[j] = v[j] - mean; s2 += (v[j].x * v[j].x + v[j].y * v[j].y) + (v[j].z * v[j].z + v[j].w * v[j].w); }
        float rstd = 1.f / sqrtf(wave_sum(s2) * (1.f / D) + LN_EPS);
        s = 0.f;
#pragma unroll
        for (int j = 0; j < 4; ++j) { const int col = 4 * (lane + 64 * j); v[j] = v[j] * rstd * *(const f32x4*)(lg + col) + *(const f32x4*)(lb + col); xr[64 * j] = v[j]; s += (v[j].x + v[j].y) + (v[j].z + v[j].w); }
        if (!FINAL) {
            mean = wave_sum(s) * (1.f / D); s2 = 0.f;
#pragma unroll
            for (int j = 0; j < 4; ++j) { v[j] = v[j] - mean; s2 += (v[j].x * v[j].x + v[j].y * v[j].y) + (v[j].z * v[j].z + v[j].w * v[j].w); }
            rstd = 1.f / sqrtf(wave_sum(s2) * (1.f / D) + ADA_EPS);
            uint2* o8 = (uint2*)(p.h + (size_t)m * D) + lane; const float* ad = p.ada + b * 6144;
#pragma unroll
            for (int j = 0; j < 4; ++j) { const int col = 4 * (lane + 64 * j); const f32x4 sh = *(const f32x4*)(ad + 3072 + col), sc = *(const f32x4*)(ad + 4096 + col);
                const f32x4 r = v[j] * rstd * (sc + 1.0f) + sh; uint2 w; w.x = pkh(r.x, r.y); w.y = pkh(r.z, r.w); o8[64 * j] = w; }
        }
    }
}

__global__ void __launch_bounds__(512, 2) mk_fwd(KArgs a) {
    extern __shared__ __attribute__((aligned(16))) unsigned char lds_raw[];
    LAS unsigned char* lds = (LAS unsigned char*)lds_raw;
    volatile LAS unsigned* MISC = (volatile LAS unsigned*)(lds + MISC_OFF);
    int tid = threadIdx.x, lane = tid & 63, wave = __builtin_amdgcn_readfirstlane(tid >> 6);
#define FRESH() do { tid = threadIdx.x; asm volatile("" : "+v"(tid)); lane = tid & 63; wave = __builtin_amdgcn_readfirstlane(tid >> 6); } while (0)
    P p;
    p.x = a.in[0]; p.c = a.in[1]; p.w_ada = a.in[2]; p.b_ada = a.in[3]; p.w_in = a.in[4]; p.mu = a.in[5]; p.w0 = a.in[6]; p.w2 = a.in[7]; p.a0 = a.in[8]; p.a2 = a.in[9]; p.g2 = a.in[10];
    p.kk = a.in[11]; p.ka = a.in[12]; p.rk = a.in[13]; p.gn_g = a.in[14]; p.gn_b = a.in[15]; p.wba = a.in[16]; p.wbb = a.in[17]; p.wout = a.in[18]; p.ln1g = a.in[19]; p.ln1b = a.in[20];
    p.w1 = a.in[21]; p.b1 = a.in[22]; p.wf2 = a.in[23]; p.b2 = a.in[24]; p.ln2g = a.in[25]; p.ln2b = a.in[26];
    p.out = a.out; p.ws = a.ws; unsigned char* ws = a.ws;
    p.ctl = (unsigned*)(ws + WS_CTL); p.adap = (float*)(ws + WS_ADAP); p.ada = (float*)(ws + WS_ADA); p.bon = (float*)(ws + WS_BON);
    p.win_t = (h16*)(ws + WS_WIN); p.wlora_t = (h16*)(ws + WS_WLORA); p.wba_t = (h16*)(ws + WS_WBA); p.wbb_t = (h16*)(ws + WS_WBB); p.wout_t = (h16*)(ws + WS_WOUT); p.w1_t = (h16*)(ws + WS_W1); p.w2_t = (h16*)(ws + WS_W2);
    p.h = (h16*)(ws + WS_H16); p.zrw = (h16*)(ws + WS_ZRW); p.qkv = (h16*)(ws + WS_QKV); p.lin = (h16*)(ws + WS_LIN); p.lout = (h16*)(ws + WS_LOUT); p.mrg = (h16*)(ws + WS_MRG); p.hid = (h16*)(ws + WS_HID);
    p.pbuf = (h16*)(ws + WS_PB); p.rbuf = (h16*)(ws + WS_RB); p.qbuf = (unsigned*)(ws + WS_QB); p.ya = (h16*)(ws + WS_H16); p.ob = (h16*)(ws + WS_H16 + 16 * MiB); p.gates = (h16*)a.out;
    for (int u = tid; u < (LDS_BYTES - RING_BYTES) / 4; u += 512) ((LAS unsigned*)(lds + RING_BYTES))[u] = 0u;
    __syncthreads();
    XcdBarrier bar = xcd_barrier_post(p.ctl + CW_BAR, MISC + 8);
#define GRID_BAR() xcd_barrier(bar)

    FRESH();
    phase0(p, lds, tid, lane, wave);
    cg::this_grid().sync();
    FRESH();
    phase0b(p, lds, tid, lane, wave);
    GRID_BAR();
    FRESH();
    run_gemm(lds, p.h, p.win_t, DIN, D, F1{p.zrw, p.qkv, p.gates});
    GRID_BAR();
    FRESH();
    phase2(p, tid);
    GRID_BAR();
    FRESH();
    run_gemm(lds, p.lin, p.wlora_t, DLO, 256, F3{p.lout});
    GRID_BAR();
    {
        for (;;) {
            if (tid == 0) MISC[0] = atomicAdd(p.ctl + CW_ATTQ, 1u);
            __syncthreads();
            const int u = (int)MISC[0];
            __syncthreads();
            if (u >= NATT) break;
            FRESH();
            attn_unit(p, lds, u, tid, lane, wave);
        }
    }
    GRID_BAR();
    FRESH();
    for (int u = (int)blockIdx.x; u < NPRE; u += (int)gridDim.x) pre_unit(p, lds, u, tid, lane, wave);
    GRID_BAR();
    FRESH();
    if ((int)blockIdx.x < NCHAINB) { if (wave < 2) chain_wave(p, (int)blockIdx.x, wave, lane); }
    else run_gemm(lds, p.ob, p.wbb_t, D, DH, F5Y{p.gates}, (int)gridDim.x - NCHAINB, (int)blockIdx.x - NCHAINB);
    GRID_BAR();
    FRESH();
    phase4b(p, lane, wave);
    GRID_BAR();
    FRESH();
    run_gemm(lds, p.ya, p.wba_t, D, DH, F5X{p.mrg, p.gates});
    GRID_BAR();
    FRESH();
    run_gemm(lds, p.mrg, p.wout_t, D, D, F6{p.x, p.out, p.ada});
    GRID_BAR();
    FRESH();
    phase_ln<false>(p, lane, wave);
    GRID_BAR();
    FRESH();
    run_gemm(lds, p.h, p.w1_t, DFF, D, F8{p.hid, p.b1});
    GRID_BAR();
    FRESH();
    run_gemm(lds, p.hid, p.w2_t, D, DFF, F9{p.out, p.ada, p.b2});
    GRID_BAR();
    FRESH();
    phase_ln<true>(p, lane, wave);
}

extern "C" void kernel_launch(void* const* d_in, const int* in_sizes, int n_in, void* d_out, int out_size, void* d_ws, size_t ws_size, hipStream_t stream) {
    static int grid = 0;
    if (grid == 0) {
        if (n_in != 27 || out_size != M * D || ws_size < WS_END) { fprintf(stderr, "kernel_launch: unexpected shapes (n_in %d, out %d, ws %zu)\n", n_in, out_size, ws_size); grid = -1; return; }
        int dev = 0, cus = 0, per_cu = 0;
        hipGetDevice(&dev); hipDeviceGetAttribute(&cus, hipDeviceAttributeMultiprocessorCount, dev);
        if (hipFuncSetAttribute((const void*)mk_fwd, hipFuncAttributeMaxDynamicSharedMemorySize, LDS_BYTES) != hipSuccess) { fprintf(stderr, "kernel_launch: hipFuncSetAttribute failed\n"); grid = -1; return; }
        hipOccupancyMaxActiveBlocksPerMultiprocessor(&per_cu, (const void*)mk_fwd, 512, LDS_BYTES);
        (void)hipGetLastError();
        if (per_cu < 1) fprintf(stderr, "kernel_launch: occupancy query says %d blocks per CU\n", per_cu);
        grid = cus;
    }
    if (grid < 0) return;
    hipMemsetAsync((char*)d_ws + WS_CTL, 0, CTL_ZERO_BYTES, stream);
    KArgs a{};
    for (int i = 0; i < 27; ++i) a.in[i] = (const float*)d_in[i];
    a.out = (float*)d_out; a.ws = (unsigned char*)d_ws;
    void* args[] = {&a};
    hipError_t e = hipLaunchCooperativeKernel((const void*)mk_fwd, dim3(grid), dim3(512), args, LDS_BYTES, stream);
    if (e != hipSuccess) fprintf(stderr, "cooperative launch failed: %s (grid %d)\n", hipGetErrorString(e), grid);
}
```

```cpp
#include <hip/hip_runtime.h>
#include <hip/hip_cooperative_groups.h>
#include <cstdio>
#include <cstdint>
namespace cg = cooperative_groups;
namespace pg8 {
#define PG8_LAS __attribute__((address_space(3)))
typedef unsigned short bf16_t;
typedef _Float16 bf16x8 __attribute__((ext_vector_type(8)));
typedef float f32x4 __attribute__((ext_vector_type(4)));
typedef unsigned u32x4 __attribute__((ext_vector_type(4)));
constexpr int BM = 256, BK = 64, HALF = 128, HTB = HALF * BK * 2  , STAGE_BYTES = 8 * HTB, NXCD = 8, WGM = 8;

__host__ __device__ __forceinline__ int lds_byte(int r, int c) { const int st = (r >> 4) * 2 + (c >> 5), rr = r & 15, cc = c & 31, ob = rr * 64 + cc * 2; return st * 1024 + (ob ^ (((ob >> 9) & 1) << 5)); }
__host__ __device__ __forceinline__ void stage_rc(int b, int& R, int& C) { const int st = b / 1024, sb = b % 1024, swz = sb ^ (((sb >> 9) & 1) << 5); R = (st >> 1) * 16 + swz / 64; C = (st & 1) * 32 + (swz % 64) / 2; }
__host__ __device__ __forceinline__ int perm32(int rho) { const int n = rho >> 4, i = rho & 15; return 8 * (i >> 2) + 4 * n + (i & 3); }

struct Unit { int pm, pn; };
struct Gemm { const bf16_t* A; const bf16_t* Bt; int M, N, K; };

struct StaticOrder {
    int nM, nN, nwg, G, c;
    __host__ __device__ void init(int M, int N, int G_, int c_) { nM = M / BM; nN = N / BM; nwg = nM * nN; G = G_; c = c_; }
    __host__ __device__ bool next(int i, Unit& u) const {
        const long L = (long)i * G + c; if (L >= nwg) return false;
        int wgid = (int)L; { const int q = nwg / NXCD, r = nwg % NXCD, xcd = wgid % NXCD, off = wgid / NXCD; wgid = (xcd < r ? xcd * (q + 1) : r * (q + 1) + (xcd - r) * q) + off; }
        const int nig = WGM * nN, gid = wgid / nig, fm = gid * WGM, gsz = (nM - fm) < WGM ? (nM - fm) : WGM;
        u.pm = fm + ((wgid % nig) % gsz); u.pn = (wgid % nig) / gsz; return true;
    }
    __device__ __forceinline__ void a_ready(const Unit&) const {}
    __device__ __forceinline__ void done(const Unit&) const {}
};
template <class Epi, class Sched, bool ALIGN_EPI = false, bool SP2 = false>
__device__ __forceinline__ void gemm_phase(PG8_LAS unsigned char* lds, const Gemm g, const Sched& S, const Epi& E) {
    int tid_ = threadIdx.x; asm volatile("" : "+v"(tid_)); const int tid = tid_, wid = __builtin_amdgcn_readfirstlane(tid >> 6), lane = tid & 63, wr = wid >> 2, wc = wid & 3, fr = lane & 15, fq = lane >> 4;
    const int K = g.K, nt = K / BK;
    unsigned voffA[2], voffB[2];
#pragma unroll
    for (int i = 0; i < 2; ++i) { int R, C; stage_rc(tid * 16 + i * 8192, R, C); const int Rb = Epi::PERM ? ((R & ~31) + perm32(R & 31)) : R;
        voffA[i] = (unsigned)(R * K + C) * 2u; voffB[i] = (unsigned)(Rb * K + C) * 2u; }
    const size_t kstep = (size_t)(BK * 2);
    const size_t hstep = (size_t)HALF * K * 2;
    const size_t tstep = 2 * hstep;
    const unsigned ldsw = (unsigned)wid * 1024u;
    const int aoff = lds_byte(wr * 64 + fr, fq * 8), boff = lds_byte(wc * 32 + fr, fq * 8);
#define PG8_SA(b, h) (((b) * 2 + (h)) * HTB)
#define PG8_SB(b, h) ((4 + (b) * 2 + (h)) * HTB)
#define PG8_STAGE(bufoff, gbase, voff) do { _Pragma("unroll") for (int _i = 0; _i < 2; ++_i) \
        __builtin_amdgcn_global_load_lds((const unsigned*)((const char*)(gbase) + (voff)[_i]), (PG8_LAS unsigned*)(lds + (bufoff) + ldsw + _i * 8192), 16, 0, 0); } while (0)
#define PG8_LDA(dst, b, h) do { _Pragma("unroll") for (int m = 0; m < 4; ++m) _Pragma("unroll") for (int k = 0; k < 2; ++k) dst[m][k] = *(const PG8_LAS bf16x8*)(lds + PG8_SA(b, h) + aoff + m * 2048 + k * 1024); } while (0)
#define PG8_LDB(dst, b, h) do { _Pragma("unroll") for (int n = 0; n < 2; ++n) _Pragma("unroll") for (int k = 0; k < 2; ++k) dst[n][k] = *(const PG8_LAS bf16x8*)(lds + PG8_SB(b, h) + boff + n * 2048 + k * 1024); } while (0)
#define PG8_MMA(ai, bj, At, Bt) do { __builtin_amdgcn_s_setprio(1); _Pragma("unroll") for (int m = 0; m < 4; ++m) _Pragma("unroll") for (int n = 0; n < 2; ++n) _Pragma("unroll") for (int k = 0; k < 2; ++k) \
        acc[ai][bj][m][n] = __builtin_amdgcn_mfma_f32_16x16x32_f16(Bt[n][k], At[m][k], acc[ai][bj][m][n], 0, 0, 0); __builtin_amdgcn_s_setprio(0); } while (0)
#define PG8_WAIT_V(n) asm volatile("s_waitcnt vmcnt(" #n ")" ::: "memory")
#define PG8_WAIT_L(n) asm volatile("s_waitcnt lgkmcnt(" #n ")" ::: "memory")
#define PG8_BAR __builtin_amdgcn_s_barrier()
#define PG8_SCHED __builtin_amdgcn_sched_barrier(0)
    Unit cur, nxt; int ui = 0;
    if (!S.next(0, cur)) return;
    f32x4 acc[2][2][4][2];
#pragma unroll
    for (int a = 0; a < 2; ++a)
#pragma unroll
        for (int b = 0; b < 2; ++b)
#pragma unroll
            for (int m = 0; m < 4; ++m)
#pragma unroll
                for (int n = 0; n < 2; ++n) acc[a][b][m][n] = (f32x4){0.f, 0.f, 0.f, 0.f};
    bf16x8 At[4][2], B0[2][2], B1[2][2];
    const char* cA = (const char*)g.A + (size_t)cur.pm * tstep; const char* cB = (const char*)g.Bt + (size_t)cur.pn * tstep;
    S.a_ready(cur);
    if constexpr (SP2) {
        PG8_STAGE(PG8_SB(0, 0), cB, voffB); PG8_STAGE(PG8_SB(0, 1), cB + hstep, voffB); PG8_STAGE(PG8_SA(0, 0), cA, voffA); PG8_STAGE(PG8_SA(0, 1), cA + hstep, voffA);
        if (wr == 1) PG8_BAR;
        PG8_WAIT_V(2); PG8_BAR;
        PG8_STAGE(PG8_SB(1, 0), cB + kstep, voffB); PG8_STAGE(PG8_SA(1, 0), cA + kstep, voffA); PG8_STAGE(PG8_SB(1, 1), cB + hstep + kstep, voffB);
        PG8_WAIT_V(6); PG8_BAR;
    } else {
        PG8_STAGE(PG8_SB(0, 0), cB, voffB); PG8_STAGE(PG8_SA(0, 0), cA, voffA); PG8_STAGE(PG8_SB(0, 1), cB + hstep, voffB); PG8_STAGE(PG8_SA(0, 1), cA + hstep, voffA);
        if (wr == 1) PG8_BAR;
        PG8_WAIT_V(4); PG8_BAR;
        PG8_STAGE(PG8_SB(1, 0), cB + kstep, voffB); PG8_STAGE(PG8_SA(1, 0), cA + kstep, voffA); PG8_STAGE(PG8_SB(1, 1), cB + hstep + kstep, voffB);
        PG8_WAIT_V(6); PG8_BAR;
    }
    for (;;) {
        const bool has_next = S.next(ui + 1, nxt);
        const char* nA = has_next ? (const char*)g.A + (size_t)nxt.pm * tstep : cA; const char* nB = has_next ? (const char*)g.Bt + (size_t)nxt.pn * tstep : cB;
        for (int t = 0; t < nt; t += 2) {
            const bool last = (t == nt - 2);
            const char* a1 = cA + (size_t)(t + 1) * kstep;
            const char* a2 = last ? nA : cA + (size_t)(t + 2) * kstep; const char* b2 = last ? nB : cB + (size_t)(t + 2) * kstep;
            const char* a3 = a2 + kstep; const char* b3 = b2 + kstep;
            if (last && has_next) S.a_ready(nxt);
            if constexpr (SP2) {
            PG8_LDB(B0, 0, 0); PG8_LDB(B1, 0, 1); PG8_SCHED; PG8_LDA(At, 0, 0); PG8_STAGE(PG8_SA(1, 1), a1 + hstep, voffA);
            PG8_WAIT_V(8); PG8_WAIT_L(0); PG8_BAR; PG8_MMA(0, 0, At, B0); PG8_MMA(0, 1, At, B1); PG8_BAR; PG8_SCHED;
            PG8_LDA(At, 0, 1); PG8_STAGE(PG8_SB(0, 0), b2, voffB); PG8_STAGE(PG8_SB(0, 1), b2 + hstep, voffB); PG8_STAGE(PG8_SA(0, 0), a2, voffA);
            PG8_WAIT_V(8); PG8_WAIT_L(0); PG8_BAR; PG8_MMA(1, 0, At, B0); PG8_MMA(1, 1, At, B1); PG8_BAR; PG8_SCHED;
            PG8_LDB(B0, 1, 0); PG8_LDB(B1, 1, 1); PG8_SCHED; PG8_LDA(At, 1, 0); PG8_STAGE(PG8_SA(0, 1), a2 + hstep, voffA);
            PG8_WAIT_V(8); PG8_WAIT_L(0); PG8_BAR; PG8_MMA(0, 0, At, B0); PG8_MMA(0, 1, At, B1); PG8_BAR; PG8_SCHED;
            PG8_LDA(At, 1, 1); PG8_STAGE(PG8_SB(1, 0), b3, voffB); PG8_STAGE(PG8_SB(1, 1), b3 + hstep, voffB); PG8_STAGE(PG8_SA(1, 0), a3, voffA);
            PG8_WAIT_V(8); PG8_WAIT_L(0); PG8_BAR; PG8_MMA(1, 0, At, B0); PG8_MMA(1, 1, At, B1); PG8_BAR; PG8_SCHED;
            } else {
            PG8_LDB(B0, 0, 0); PG8_SCHED; PG8_LDA(At, 0, 0); PG8_STAGE(PG8_SA(1, 1), a1 + hstep, voffA);
            PG8_WAIT_L(8); PG8_BAR; PG8_WAIT_L(0); PG8_MMA(0, 0, At, B0); PG8_BAR; PG8_SCHED;
            PG8_LDB(B1, 0, 1); PG8_STAGE(PG8_SB(0, 0), b2, voffB);
            PG8_BAR; PG8_WAIT_L(0); PG8_MMA(0, 1, At, B1); PG8_BAR;
            PG8_LDA(At, 0, 1); PG8_STAGE(PG8_SA(0, 0), a2, voffA);
            PG8_BAR; PG8_WAIT_L(0); PG8_MMA(1, 0, At, B0); PG8_BAR; PG8_SCHED;
            PG8_STAGE(PG8_SB(0, 1), b2 + hstep, voffB);
            PG8_WAIT_V(6); PG8_BAR; PG8_MMA(1, 1, At, B1); PG8_BAR;
            PG8_LDB(B0, 1, 0); PG8_SCHED; PG8_LDA(At, 1, 0); PG8_STAGE(PG8_SA(0, 1), a2 + hstep, voffA);
            PG8_WAIT_L(8); PG8_BAR; PG8_WAIT_L(0); PG8_MMA(0, 0, At, B0); PG8_BAR; PG8_SCHED;
            PG8_LDB(B1, 1, 1); PG8_STAGE(PG8_SB(1, 0), b3, voffB);
            PG8_BAR; PG8_WAIT_L(0); PG8_MMA(0, 1, At, B1); PG8_BAR;
            PG8_LDA(At, 1, 1); PG8_STAGE(PG8_SA(1, 0), a3, voffA);
            PG8_BAR; PG8_WAIT_L(0); PG8_MMA(1, 0, At, B0); PG8_BAR; PG8_SCHED;
            PG8_STAGE(PG8_SB(1, 1), b3 + hstep, voffB);
            PG8_WAIT_V(6); PG8_BAR; PG8_MMA(1, 1, At, B1); PG8_BAR;
            }
        }
        if constexpr (ALIGN_EPI) { if (wr == 0) PG8_BAR; }
        if constexpr (!Epi::AFTER_DRAIN) { E(acc, cur, wr, wc, fr, fq); S.done(cur); }
        if (!has_next) break;
#pragma unroll
        for (int a = 0; a < 2; ++a)
#pragma unroll
            for (int b = 0; b < 2; ++b)
#pragma unroll
                for (int m = 0; m < 4; ++m)
#pragma unroll
                    for (int n = 0; n < 2; ++n) acc[a][b][m][n] = (f32x4){0.f, 0.f, 0.f, 0.f};
        cur = nxt; cA = nA; cB = nB; ++ui;
        if constexpr (ALIGN_EPI) { if (wr == 1) PG8_BAR; }
    }
    PG8_WAIT_V(0);
    if constexpr (!ALIGN_EPI) { if (wr == 0) PG8_BAR; }
    PG8_BAR;
    if constexpr (Epi::AFTER_DRAIN) { E.fused(acc, cur, wr, wc, fr, fq, lds, wid, lane); S.done(cur); }
#undef PG8_SA
#undef PG8_SB
#undef PG8_STAGE
#undef PG8_LDA
#undef PG8_LDB
#undef PG8_MMA
#undef PG8_WAIT_V
#undef PG8_WAIT_L
#undef PG8_BAR
#undef PG8_SCHED
}
}
#define GAS __attribute__((address_space(1)))
#define LAS __attribute__((address_space(3)))
typedef unsigned short bf16;
typedef unsigned v4u __attribute__((ext_vector_type(4)));
typedef float f32x4 __attribute__((ext_vector_type(4)));
typedef short bf16x8 __attribute__((ext_vector_type(8)));
typedef GAS unsigned gu32;
typedef GAS unsigned long long gu64;
#define RLX_AGENT __ATOMIC_RELAXED, __HIP_MEMORY_SCOPE_AGENT
#define LDS_WAIT() asm volatile("s_waitcnt lgkmcnt(0)" ::: "memory")
#define VM_WAIT() asm volatile("s_waitcnt vmcnt(0)" ::: "memory")
__device__ __forceinline__ unsigned long long rt() { return __builtin_amdgcn_s_memrealtime(); }
__device__ __forceinline__ unsigned f2bf(float f) { unsigned u = __builtin_bit_cast(unsigned, f); return (u + 0x7fffu + ((u >> 16) & 1u)) >> 16; }
__device__ __forceinline__ unsigned pk2(float lo, float hi) { return f2bf(lo) | (f2bf(hi) << 16); }

#define XB_TMO      128
#define XB_XCNT(j)  (256  + 64 * (j))
#define XB_XSUB(j)  (1280 + 64 * (j))
#define XB_XGEN(j)  (2304 + 64 * (j))
#define XB_TOP      3328
#define XB_TOPGEN   3392
#define XCD_BAR_WORDS 3456
#define XB_SPIN_CAP (1u << 18)

__device__ __forceinline__ unsigned xb_ld(unsigned* p)              { return __hip_atomic_load(p, __ATOMIC_RELAXED, __HIP_MEMORY_SCOPE_AGENT); }
__device__ __forceinline__ unsigned xb_add(unsigned* p, unsigned v) { return __hip_atomic_fetch_add(p, v, __ATOMIC_RELAXED, __HIP_MEMORY_SCOPE_AGENT); }
__device__ __forceinline__ unsigned xb_xcc_id() { return (unsigned)__builtin_amdgcn_s_getreg((3 << 11) | 20) & 0xFu; }
#define XB_SPIN(cond, bar) do { unsigned _sp = 0; while (cond) { __builtin_amdgcn_s_sleep(1); \
    if ((++_sp & 255u) == 0u) { if (xb_ld(&(bar)[XB_TMO])) break; if (_sp > XB_SPIN_CAP) { atomicAdd(&(bar)[XB_TMO], 1u); break; } } } } while (0)

struct XcdBarrier {
    unsigned* bar; unsigned x;
    volatile LAS unsigned* st;
};

__device__ __forceinline__ XcdBarrier xcd_barrier_post(unsigned* bar, volatile LAS unsigned* st) {
    XcdBarrier b; b.bar = bar; b.x = xb_xcc_id(); b.st = st;
    if (threadIdx.x == 0) (void)xb_add(&bar[XB_XCNT(b.x)], 1u);
    return b;
}
__device__ __forceinline__ void xcd_barrier_complete(unsigned* bar, unsigned x, unsigned& nloc, unsigned& nx) {
    const unsigned G = gridDim.x * gridDim.y * gridDim.z;
    unsigned sum, cnt, mine, sp = 0u;
    for (;;) {
        sum = 0u; cnt = 0u; mine = 0u;
#pragma unroll
        for (unsigned j = 0; j < 16; ++j) { const unsigned c = xb_ld(&bar[XB_XCNT(j)]); sum += c; cnt += (c > 0u) ? 1u : 0u; mine = (j == x) ? c : mine; }
        if (sum == G) break;
        __builtin_amdgcn_s_sleep(1);
        if ((++sp & 255u) == 0u) { if (xb_ld(&bar[XB_TMO])) break; if (sp > XB_SPIN_CAP) { atomicAdd(&bar[XB_TMO], 1u); break; } }
    }
    nloc = mine > 0u ? mine : 1u; nx = cnt > 0u ? cnt : 1u;
}

__device__ __forceinline__ void xcd_barrier(const XcdBarrier& b) {
    asm volatile("s_waitcnt vmcnt(0)" ::: "memory");
    __syncthreads();
    if (threadIdx.x == 0) {
        unsigned* bar = b.bar;
        __builtin_amdgcn_s_waitcnt(0);
        unsigned nloc = b.st[0], nx = b.st[1];
        if (nloc == 0u) { xcd_barrier_complete(bar, b.x, nloc, nx); b.st[0] = nloc; b.st[1] = nx; }
        const unsigned old = xb_add(&bar[XB_XSUB(b.x)], 1u);
        const unsigned gen = old / nloc;
        if (old + 1u == (gen + 1u) * nloc) {
            __builtin_amdgcn_fence(__ATOMIC_RELEASE, "agent");
            asm volatile("s_waitcnt vmcnt(0)" ::: "memory");
            const unsigned og = xb_add(&bar[XB_TOP], 1u);
            const unsigned tg = og / nx;
            if (og + 1u == (tg + 1u) * nx) xb_add(&bar[XB_TOPGEN], 1u);
            else XB_SPIN(xb_ld(&bar[XB_TOPGEN]) == tg, bar);
            __builtin_amdgcn_fence(__ATOMIC_ACQUIRE, "agent");
            xb_add(&bar[XB_XGEN(b.x)], 1u);
            asm volatile("s_waitcnt vmcnt(0)" ::: "memory");
        } else {
            XB_SPIN(xb_ld(&bar[XB_XGEN(b.x)]) == gen, bar);
            __builtin_amdgcn_fence(__ATOMIC_ACQUIRE, "agent");
            asm volatile("s_waitcnt vmcnt(0)" ::: "memory");
        }
    }
    __syncthreads();
}
typedef _Float16 h16;
typedef _Float16 h16x8 __attribute__((ext_vector_type(8)));
typedef _Float16 h16x2 __attribute__((ext_vector_type(2)));
typedef float f32x16 __attribute__((ext_vector_type(16)));
typedef unsigned u32x4 __attribute__((ext_vector_type(4)));
typedef unsigned u32x2 __attribute__((ext_vector_type(2)));
constexpr int NB = 2, SEQ = 8192, M = NB * SEQ, D = 1024, DIN = 5376, DRW = 1792, DQKV = 1536, DG = 2048, DFF = 4096, DH = 512, DLO = 1536;
constexpr float ALPHA = 1.189207115002721f;
constexpr float LN_EPS = 1e-5f, ADA_EPS = 1e-6f, GN_EPS = 64e-5f;
constexpr size_t MiB = 1u << 20, KiB = 1u << 10;
constexpr size_t WS_CTL = 0, CTL_ZERO_BYTES = 1 * MiB;
constexpr size_t WS_ADAP = 1 * MiB, WS_ADA = 1 * MiB + 896 * KiB, WS_BON = 2 * MiB;
constexpr size_t WS_WIN = 3 * MiB, WS_WLORA = 13 * MiB + 512 * KiB, WS_WBA = 14 * MiB + 256 * KiB, WS_WBB = 15 * MiB + 256 * KiB, WS_WOUT = 16 * MiB + 256 * KiB,
                 WS_W1 = 18 * MiB + 256 * KiB, WS_W2 = 26 * MiB + 256 * KiB;
constexpr size_t WS_H16 = 36 * MiB, WS_ZRW = 68 * MiB, WS_QKV = 124 * MiB, WS_LOUT = 172 * MiB, WS_LIN = 220 * MiB, WS_PB = 124 * MiB, WS_RB = 156 * MiB, WS_QB = 220 * MiB, WS_MRG = 68 * MiB, WS_HID = 68 * MiB, WS_END = 252 * MiB;
constexpr int CW_ATTQ = 64, CW_BAR = 4096;
constexpr int RING_BYTES = 131072, MISC_OFF = RING_BYTES + 64, LDS_BYTES = RING_BYTES + 512;
constexpr int NATT = 16 * 32, NPRE = 16 * 256, NCHAINB = 16;

struct KArgs { const float* in[27]; float* out; unsigned char* ws; };
struct P {
    const float *x, *c, *w_ada, *b_ada, *w_in, *mu, *w0, *w2, *a0, *a2, *g2, *kk, *ka, *rk, *gn_g, *gn_b, *wba, *wbb, *wout, *ln1g, *ln1b, *w1, *b1, *wf2, *b2, *ln2g, *ln2b;
    float* out; unsigned char* ws;
    unsigned* ctl; float *adap, *ada, *bon;
    h16 *pbuf, *rbuf; unsigned* qbuf; h16 *win_t, *wlora_t, *wba_t, *wbb_t, *wout_t, *w1_t, *w2_t, *h, *zrw, *qkv, *lin, *lout, *mrg, *hid, *ya, *ob, *gates;
};

__device__ __forceinline__ unsigned pkh(float a, float b) { h16x2 v = {(h16)a, (h16)b}; return __builtin_bit_cast(unsigned, v); }
__device__ __forceinline__ void store8h(h16* p, const f32x4& v0, const f32x4& v1) { u32x4 w; w.x = pkh(v0.x, v0.y); w.y = pkh(v0.z, v0.w); w.z = pkh(v1.x, v1.y); w.w = pkh(v1.z, v1.w); *(u32x4*)p = w; }
__device__ __forceinline__ void load8h(const h16* p, f32x4& v0, f32x4& v1) { const h16x8 t = *(const h16x8*)p; v0 = (f32x4){(float)t[0], (float)t[1], (float)t[2], (float)t[3]}; v1 = (f32x4){(float)t[4], (float)t[5], (float)t[6], (float)t[7]}; }
__device__ __forceinline__ float sigmoidf_(float x) { return 1.0f / (1.0f + __expf(-x)); }
__device__ __forceinline__ float wave_sum(float v) {
#pragma unroll
    for (int o = 1; o < 64; o <<= 1) v += __shfl_xor(v, o);
    return v;
}
template <int CTRL> __device__ __forceinline__ float dppmov(float x) { return __builtin_bit_cast(float, __builtin_amdgcn_update_dpp(0, __builtin_bit_cast(int, x), CTRL, 0xf, 0xf, true)); }
__device__ __forceinline__ float red16(float v) { v += dppmov<0xB1>(v); v += dppmov<0x4E>(v); v += dppmov<0x124>(v); v += dppmov<0x128>(v); return v; }

template <class F> struct EpiGen {
    static constexpr bool PERM = true, AFTER_DRAIN = false;
    F f;
    __device__ __forceinline__ void operator()(const f32x4 (&acc)[2][2][4][2], const pg8::Unit& u, int wr, int wc, int fr, int fq) const {
        const int row0 = u.pm * 256 + wr * 64 + fr, col0 = u.pn * 256 + wc * 32 + 8 * fq;
#pragma unroll
        for (int ai = 0; ai < 2; ++ai)
#pragma unroll
            for (int m = 0; m < 4; ++m)
#pragma unroll
                for (int bj = 0; bj < 2; ++bj) f(row0 + ai * 128 + m * 16, col0 + bj * 128, acc[ai][bj][m][0], acc[ai][bj][m][1]);
    }
};
struct F1 {
    h16 *zrw, *qkv, *gates;
    __device__ __forceinline__ void operator()(int row, int col, f32x4 v0, f32x4 v1) const {
        if (col < DRW) store8h(zrw + (size_t)row * DRW + col, v0, v1);
        else if (col < DRW + DQKV) { const int c = col - DRW; if (c < 512) { v0 = v0 * 0.125f; v1 = v1 * 0.125f; } store8h(qkv + (size_t)row * DQKV + c, v0, v1); }
        else { const int c = col - DRW - DQKV;
#pragma unroll
            for (int i = 0; i < 4; ++i) { v0[i] = sigmoidf_(v0[i]); v1[i] = sigmoidf_(v1[i]); }
            store8h(gates + (size_t)row * DG + c, v0, v1); }
    }
};
struct F3 {
    h16* lout;
    __device__ __forceinline__ void operator()(int row, int col, f32x4 v0, f32x4 v1) const { store8h(lout + (size_t)row * DLO + col, v0, v1); }
};
struct F5Y { h16* gates;
    __device__ __forceinline__ void operator()(int row, int col, f32x4 v0, f32x4 v1) const {
        f32x4 g0, g1; h16* gp = gates + (size_t)row * DG + 1024 + col; load8h(gp, g0, g1); store8h(gp, v0 * g0, v1 * g1); } };
struct F5X { h16* mrg; const h16* gates;
    __device__ __forceinline__ void operator()(int row, int col, f32x4 v0, f32x4 v1) const {
        f32x4 g0, g1, m0, m1; load8h(gates + (size_t)row * DG + col, g0, g1); load8h(gates + (size_t)row * DG + 1024 + col, m0, m1); store8h(mrg + (size_t)row * D + col, m0 + v0 * g0, m1 + v1 * g1); } };
struct F6 { const float* x; float* out; const float* ada;
    __device__ __forceinline__ void operator()(int row, int col, f32x4 v0, f32x4 v1) const {
        const float* g = ada + (row >> 13) * 6144 + 2048 + col; const size_t o = (size_t)row * D + col;
        const f32x4 x0 = *(const f32x4*)(x + o), x1 = *(const f32x4*)(x + o + 4), g0 = *(const f32x4*)g, g1 = *(const f32x4*)(g + 4);
        *(f32x4*)(out + o) = x0 * ALPHA + g0 * v0; *(f32x4*)(out + o + 4) = x1 * ALPHA + g1 * v1; } };
struct F8 { h16* hid; const float* b1;
    __device__ __forceinline__ void operator()(int row, int col, f32x4 v0, f32x4 v1) const {
        const f32x4 c0 = *(const f32x4*)(b1 + col), c1 = *(const f32x4*)(b1 + col + 4);
#pragma unroll
        for (int i = 0; i < 4; ++i) { float a = fmaxf(v0[i] + c0[i], 0.f); v0[i] = a * a; a = fmaxf(v1[i] + c1[i], 0.f); v1[i] = a * a; }
        store8h(hid + (size_t)row * DFF + col, v0, v1); } };
struct F9 { float* out; const float* ada; const float* b2;
    __device__ __forceinline__ void operator()(int row, int col, f32x4 v0, f32x4 v1) const {
        const float* g = ada + (row >> 13) * 6144 + 5120 + col; const size_t o = (size_t)row * D + col;
        const f32x4 x0 = *(const f32x4*)(out + o), x1 = *(const f32x4*)(out + o + 4), g0 = *(const f32x4*)g, g1 = *(const f32x4*)(g + 4), c0 = *(const f32x4*)(b2 + col), c1 = *(const f32x4*)(b2 + col + 4);
        *(f32x4*)(out + o) = x0 * ALPHA + g0 * (v0 + c0); *(f32x4*)(out + o + 4) = x1 * ALPHA + g1 * (v1 + c1); } };

template <class F> __device__ __forceinline__ void run_gemm(LAS unsigned char* lds, const h16* A, const h16* Bt, int N, int K, const F& f, int gsz = -1, int gidx = -1) {
    asm volatile("" : "+s"(N), "+s"(K));
    if (gsz < 0) { gsz = (int)gridDim.x; gidx = (int)blockIdx.x; }
    pg8::Gemm g{(const pg8::bf16_t*)A, (const pg8::bf16_t*)Bt, M, N, K}; pg8::StaticOrder S; S.init(M, N, gsz, gidx);
    EpiGen<F> E{f};
    pg8::gemm_phase<EpiGen<F>, pg8::StaticOrder, true, true>(lds, g, S, E);
}

__device__ __forceinline__ void p0_transpose_item(const float* W, int K, int N, h16* WT, LAS float* scr, int item, int lane) {
    const int nblk = N / 32, kb = item / nblk, nb = item % nblk, k0 = 64 * kb, n0 = 32 * nb;
#pragma unroll 8
    for (int i = 0; i < 32; ++i) { const int kk = 2 * i + (lane >> 5); scr[kk * 33 + (lane & 31)] = W[(size_t)(k0 + kk) * N + n0 + (lane & 31)]; }
    LDS_WAIT(); asm volatile("" ::: "memory");
    const int c = lane & 7;
#pragma unroll
    for (int j = 0; j < 4; ++j) { const int n = (lane >> 3) + 8 * j; const LAS float* s = scr + (8 * c) * 33 + n;
        u32x4 o; o.x = pkh(s[0 * 33], s[1 * 33]); o.y = pkh(s[2 * 33], s[3 * 33]); o.z = pkh(s[4 * 33], s[5 * 33]); o.w = pkh(s[6 * 33], s[7 * 33]);
        *(u32x4*)(WT + (size_t)(n0 + n) * K + k0 + 8 * c) = o; }
    LDS_WAIT(); asm volatile("" ::: "memory");
}
__device__ __forceinline__ void phase0(const P& p, LAS unsigned char* lds, int tid, int lane, int wave) {
    LAS float* scr = (LAS float*)(lds + wave * 16384);
    const int G = gridDim.x, gw = blockIdx.x * 8 + wave, NGW = G * 8;
    constexpr int I_IN = (D / 64) * (DIN / 32), I_BA = (DH / 64) * (D / 32), I_OUT = (D / 64) * (D / 32), I_1 = (D / 64) * (DFF / 32), I_2 = (DFF / 64) * (D / 32);
    constexpr int NITEMS = I_IN + 2 * I_BA + I_OUT + I_1 + I_2;
    for (int it = gw; it < NITEMS; it += NGW) {
        int r = it;
        if (r < I_IN) { p0_transpose_item(p.w_in, D, DIN, p.win_t, scr, r, lane); continue; } r -= I_IN;
        if (r < I_BA) { p0_transpose_item(p.wba, DH, D, p.wba_t, scr, r, lane); continue; } r -= I_BA;
        if (r < I_BA) { p0_transpose_item(p.wbb, DH, D, p.wbb_t, scr, r, lane); continue; } r -= I_BA;
        if (r < I_OUT) { p0_transpose_item(p.wout, D, D, p.wout_t, scr, r, lane); continue; } r -= I_OUT;
        if (r < I_1) { p0_transpose_item(p.w1, D, DFF, p.w1_t, scr, r, lane); continue; } r -= I_1;
        p0_transpose_item(p.wf2, DFF, D, p.w2_t, scr, r, lane);
    }
    for (int idx = blockIdx.x * 512 + tid; idx < DLO * 256; idx += G * 512) {
        const int n = idx >> 8, k = idx & 255; float v = 0.f;
        if (n < 512) { if (k < 64) v = p.w2[k * 512 + n]; }
        else if (n < 1024) { if (k >= 64 && k < 128) v = p.a2[(k - 64) * 512 + n - 512]; }
        else { if (k >= 128) v = p.g2[(k - 128) * 512 + n - 1024]; }
        p.wlora_t[idx] = (h16)v;
    }
    for (int u = blockIdx.x; u < 192; u += G) {
        const int slice = u / 12, n = (u % 12) * 512 + tid; float a0 = 0.f, a1 = 0.f;
#pragma unroll 8
        for (int kk = 0; kk < 64; ++kk) { const int k = slice * 64 + kk; const float c0 = p.c[k], c1 = p.c[1024 + k], w = p.w_ada[(size_t)k * 6144 + n];
            a0 += c0 * sigmoidf_(c0) * w; a1 += c1 * sigmoidf_(c1) * w; }
        p.adap[(slice * 2 + 0) * 6144 + n] = a0; p.adap[(slice * 2 + 1) * 6144 + n] = a1;
    }
}
__device__ __forceinline__ void phase0b(const P& p, LAS unsigned char* lds, int tid, int lane, int wave) {
    LAS float* mod = (LAS float*)lds;
    for (int i = tid; i < 4096; i += 512) { const int b = i >> 11, j = i & 2047; float s = p.b_ada[j];
#pragma unroll
        for (int sl = 0; sl < 16; ++sl) s += p.adap[(sl * 2 + b) * 6144 + j];
        mod[i] = s; }
    if (blockIdx.x == 0) for (int i = tid; i < 2 * 6144; i += 512) { const int b = i / 6144, j = i % 6144; float s = p.b_ada[j];
#pragma unroll
        for (int sl = 0; sl < 16; ++sl) s += p.adap[(sl * 2 + b) * 6144 + j];
        p.ada[i] = s; }
    __syncthreads();
    const int gw = blockIdx.x * 8 + wave, NGW = gridDim.x * 8;
    for (int m = gw; m < M; m += NGW) {
        const f32x4* xr = (const f32x4*)(p.x + (size_t)m * D) + lane; const int b = m >> 13;
        f32x4 v[4]; float s = 0.f;
#pragma unroll
        for (int j = 0; j < 4; ++j) { v[j] = xr[64 * j]; s += (v[j].x + v[j].y) + (v[j].z + v[j].w); }
        const float mean = wave_sum(s) * (1.f / D); float s2 = 0.f;
#pragma unroll
        for (int j = 0; j < 4; ++j) { v[j] = v[j] - mean; s2 += (v[j].x * v[j].x + v[j].y * v[j].y) + (v[j].z * v[j].z + v[j].w * v[j].w); }
        const float rstd = 1.f / sqrtf(wave_sum(s2) * (1.f / D) + ADA_EPS);
        uint2* o8 = (uint2*)(p.h + (size_t)m * D) + lane;
#pragma unroll
        for (int j = 0; j < 4; ++j) { const int col = 4 * (lane + 64 * j); const f32x4 sh = *(const LAS f32x4*)(mod + b * 2048 + col), sc = *(const LAS f32x4*)(mod + b * 2048 + 1024 + col);
            const f32x4 r = v[j] * rstd * (sc + 1.0f) + sh; uint2 w; w.x = pkh(r.x, r.y); w.y = pkh(r.z, r.w); o8[64 * j] = w; }
    }
}
__device__ __forceinline__ void phase2(const P& p, int tid) {
    for (int idx = blockIdx.x * 512 + tid; idx < M * 32; idx += gridDim.x * 512) {
        const int t = idx >> 5, j8 = (idx & 31) * 8, col = 1536 + j8;
        f32x4 c0, c1, q0 = {0.f, 0.f, 0.f, 0.f}, q1 = {0.f, 0.f, 0.f, 0.f};
        load8h(p.zrw + (size_t)t * DRW + col, c0, c1); if (t & (SEQ - 1)) load8h(p.zrw + (size_t)(t - 1) * DRW + col, q0, q1);
        const f32x4 m0 = *(const f32x4*)(p.mu + col), m1 = *(const f32x4*)(p.mu + col + 4);
        c0 = c0 + m0 * (q0 - c0); c1 = c1 + m1 * (q1 - c1);
#pragma unroll
        for (int i = 0; i < 4; ++i) { if (j8 < 64) { c0[i] = tanhf(c0[i]); c1[i] = tanhf(c1[i]); } else if (j8 >= 128) { c0[i] = sigmoidf_(c0[i]); c1[i] = sigmoidf_(c1[i]); } }
        store8h(p.lin + (size_t)t * 256 + j8, c0, c1);
    }
}
constexpr int P64 = 72, P32 = 40;
constexpr int L_AM = 0, L_BM = 4608, L_KM = 9216, L_RM = 13824, L_AMT = 18432, L_BMT = 23552, L_KMT = 28672, L_VT = 33792, L_NR0 = 38912, L_NR1 = 41472, L_NT0 = 44032, L_NT1 = 46592,
              L_TR0 = 49152, L_TR1 = 51712, L_AAK = 54272, L_ARB = 56832, L_ARK = 59392, L_W1T = 61952, L_UT = 67072, L_TAT = 72192, L_CUM = 77312, L_GM = 85504, L_GL = 85760;
__device__ __forceinline__ int crow(int r, int hi) { return (r & 3) + 8 * (r >> 2) + 4 * hi; }
template <int KS> __device__ __forceinline__ f32x16 mm_tile(LAS unsigned char* A, int arow, int apitch, LAS unsigned char* B, int brow, int bpitch, f32x16 acc, int hi) {
#pragma unroll
    for (int s = 0; s < KS; ++s) { const h16x8 a = *(const LAS h16x8*)(A + (arow * apitch + 16 * s + 8 * hi) * 2), b = *(const LAS h16x8*)(B + (brow * bpitch + 16 * s + 8 * hi) * 2);
        acc = __builtin_amdgcn_mfma_f32_32x32x16_f16(a, b, acc, 0, 0, 0); }
    return acc;
}
__device__ __forceinline__ void wr_row(LAS unsigned char* arr, const f32x16& v, int n, int hi) {
#pragma unroll
    for (int r = 0; r < 16; ++r) ((LAS h16*)arr)[crow(r, hi) * P32 + n] = (h16)v[r];
}
__device__ __forceinline__ void wr_tr(LAS unsigned char* arr, const f32x16& v, int nrow, int hi) {
#pragma unroll
    for (int jj = 0; jj < 4; ++jj) { u32x2 w; w.x = pkh(v[4 * jj], v[4 * jj + 1]); w.y = pkh(v[4 * jj + 2], v[4 * jj + 3]); *(LAS u32x2*)(arr + (nrow * P32 + 8 * jj + 4 * hi) * 2) = w; }
}
__device__ __forceinline__ f32x16 zero16() { f32x16 z;
#pragma unroll
    for (int r = 0; r < 16; ++r) z[r] = 0.f;
    return z; }
__device__ __forceinline__ void pre_unit(const P& p, LAS unsigned char* sm, int unit, int tid, int lane, int wave) {
    const int bh = unit >> 8, c = unit & 255, b = bh >> 3, h = bh & 7, r32 = lane & 31, hi = lane >> 5, col = h * 64 + lane;
    LAS float* CUM = (LAS float*)(sm + L_CUM); LAS float* GM = (LAS float*)(sm + L_GM); LAS float* GL = (LAS float*)(sm + L_GL);
    const float mu_r = p.mu[col], mu_k = p.mu[512 + col], mu_v = p.mu[1024 + col], ckk = p.kk[col], cka = p.ka[col], crk = p.rk[col], cw0 = p.w0[col], ca0 = p.a0[col];
    float av[4], bv[4], kv[4], rv[4], vv[4], lwv[4];
#pragma unroll
    for (int i = 0; i < 4; ++i) {
        const int tt = wave * 4 + i, t = c * 32 + tt; const size_t gm = (size_t)b * SEQ + t;
        const h16* zr = p.zrw + gm * DRW; const h16* lo = p.lout + gm * DLO;
        float r = (float)zr[col], k = (float)zr[512 + col], v = (float)zr[1024 + col], rp = 0.f, kp = 0.f, vp = 0.f;
        if (t > 0) { rp = (float)zr[col - DRW]; kp = (float)zr[512 + col - DRW]; vp = (float)zr[1024 + col - DRW]; }
        r += mu_r * (rp - r); k += mu_k * (kp - k); v += mu_v * (vp - v);
        const float xw = -(cw0 + (float)lo[col]), spw = fmaxf(xw, 0.f) + __logf(1.f + __expf(-fabsf(xw))), ar = sigmoidf_(ca0 + (float)lo[512 + col]);
        const float lw = -__expf(-spw - 0.5f);
        const float kkv = k * ckk, nrm = sqrtf(wave_sum(kkv * kkv)), kkn = kkv / fmaxf(nrm, 1e-12f);
        const float k2 = k * (1.0f + (ar - 1.0f) * cka), bon = wave_sum(r * k2 * crk);
        if (lane == 0) p.bon[gm * 8 + h] = bon;
        av[i] = -kkn; bv[i] = kkn * ar; kv[i] = k2; rv[i] = r; vv[i] = v; lwv[i] = lw;
        CUM[tt * 64 + lane] = lw;
    }
    __syncthreads();
    if (tid < 64) { float s = 0.f, mid = 0.f;
#pragma unroll 8
        for (int t = 0; t < 32; ++t) { s += CUM[t * 64 + tid]; CUM[t * 64 + tid] = s; if (t == 15) mid = s; }
        GM[tid] = __expf(mid); GL[tid] = __expf(s); }
    __syncthreads();
    {   const float mid = CUM[15 * 64 + lane];
#pragma unroll
        for (int i = 0; i < 4; ++i) { const int tt = wave * 4 + i; const float cum = CUM[tt * 64 + lane], cp = cum - lwv[i];
            const float e1 = __expf(mid - cum);
            const h16 am = (h16)(av[i] * __expf(cp - mid)), bm = (h16)(bv[i] * e1), km = (h16)(kv[i] * e1), rm = (h16)(rv[i] * __expf(cum - mid));
            ((LAS h16*)(sm + L_AM))[tt * P64 + lane] = am; ((LAS h16*)(sm + L_BM))[tt * P64 + lane] = bm; ((LAS h16*)(sm + L_KM))[tt * P64 + lane] = km; ((LAS h16*)(sm + L_RM))[tt * P64 + lane] = rm;
            ((LAS h16*)(sm + L_AMT))[lane * P32 + tt] = am; ((LAS h16*)(sm + L_BMT))[lane * P32 + tt] = bm; ((LAS h16*)(sm + L_KMT))[lane * P32 + tt] = km; ((LAS h16*)(sm + L_VT))[lane * P32 + tt] = (h16)vv[i]; }
    }
    __syncthreads();
    if (wave < 4) {
        f32x16 acc = mm_tile<4>(sm + (wave < 2 ? L_AM : L_RM), r32, P64, sm + ((wave & 1) ? L_KM : L_BM), r32, P64, zero16(), hi);
#pragma unroll
        for (int r = 0; r < 16; ++r) { const int t = crow(r, hi); const bool keep = (wave < 2) ? (r32 < t) : (r32 <= t); acc[r] = keep ? acc[r] : 0.f; }
        if (wave == 0) {
            wr_row(sm + L_NR0, acc, r32, hi); wr_tr(sm + L_NT0, acc, r32, hi);
            f32x16 tacc = acc;
#pragma unroll
            for (int r = 0; r < 16; ++r) if (crow(r, hi) == r32) tacc[r] += 1.0f;
            wr_row(sm + L_TR0, tacc, r32, hi);
#pragma unroll
            for (int i = 0; i < 4; ++i) {
                LAS unsigned char* nr = sm + ((i & 1) ? L_NR1 : L_NR0); LAS unsigned char* nt = sm + ((i & 1) ? L_NT1 : L_NT0);
                LAS unsigned char* nr2 = sm + ((i & 1) ? L_NR0 : L_NR1); LAS unsigned char* nt2 = sm + ((i & 1) ? L_NT0 : L_NT1);
                LAS unsigned char* tr = sm + ((i & 1) ? L_TR1 : L_TR0); LAS unsigned char* tr2 = sm + ((i & 1) ? L_TR0 : L_TR1);
                const f32x16 nacc = mm_tile<2>(nr, r32, P32, nt, r32, P32, zero16(), hi);
                wr_row(nr2, nacc, r32, hi); wr_tr(nt2, nacc, r32, hi);
                tacc = mm_tile<2>(tr, r32, P32, nt2, r32, P32, tacc, hi);
                wr_row(tr2, tacc, r32, hi);
            }
        } else if (wave == 1) {
            wr_row(sm + L_AAK, acc, r32, hi);
#pragma unroll
            for (int vt = 0; vt < 2; ++vt) { const f32x16 w1 = mm_tile<2>(sm + L_AAK, r32, P32, sm + L_VT, 32 * vt + r32, P32, zero16(), hi); wr_tr(sm + L_W1T, w1, 32 * vt + r32, hi); }
        } else if (wave == 2) wr_row(sm + L_ARB, acc, r32, hi);
        else wr_row(sm + L_ARK, acc, r32, hi);
    }
    __syncthreads();
    if (wave < 2) { const f32x16 u = mm_tile<2>(sm + L_TR0, r32, P32, sm + L_W1T, 32 * wave + r32, P32, zero16(), hi); wr_tr(sm + L_UT, u, 32 * wave + r32, hi); }
    else if (wave < 4) { const f32x16 ta = mm_tile<2>(sm + L_TR0, r32, P32, sm + L_AMT, 32 * (wave - 2) + r32, P32, zero16(), hi); wr_tr(sm + L_TAT, ta, 32 * (wave - 2) + r32, hi); }
    __syncthreads();
    if (wave < 4) {
        const int kt = wave >> 1, mt = wave & 1, k = 32 * mt + r32;
        const f32x16 x = mm_tile<2>(sm + L_TAT, 32 * kt + r32, P32, sm + L_BMT, k, P32, zero16(), hi);
        const float gl = GL[k], f1 = gl / GM[k]; float pv[16];
#pragma unroll
        for (int r = 0; r < 16; ++r) { const int k2 = 32 * kt + crow(r, hi); pv[r] = f1 * x[r] * GM[k2] + (k2 == k ? gl : 0.f); }
        u32x4 w0, w1; w0.x = pkh(pv[0], pv[1]); w0.y = pkh(pv[2], pv[3]); w0.z = pkh(pv[4], pv[5]); w0.w = pkh(pv[6], pv[7]); w1.x = pkh(pv[8], pv[9]); w1.y = pkh(pv[10], pv[11]); w1.z = pkh(pv[12], pv[13]); w1.w = pkh(pv[14], pv[15]);
        u32x4* dst = (u32x4*)p.pbuf + (size_t)unit * 512 + (mt * 4 + 2 * kt) * 64 + lane;
        dst[0] = w0; dst[64] = w1;
    } else if (wave < 6) {
        const int kt = wave - 4;
        const f32x16 x = mm_tile<2>(sm + L_TAT, 32 * kt + r32, P32, sm + L_ARB, r32, P32, zero16(), hi);
        float pv[16];
#pragma unroll
        for (int r = 0; r < 16; ++r) { const int k2 = 32 * kt + crow(r, hi); pv[r] = (x[r] + (float)((LAS h16*)(sm + L_RM))[r32 * P64 + k2]) * GM[k2]; }
        u32x4 w0, w1; w0.x = pkh(pv[0], pv[1]); w0.y = pkh(pv[2], pv[3]); w0.z = pkh(pv[4], pv[5]); w0.w = pkh(pv[6], pv[7]); w1.x = pkh(pv[8], pv[9]); w1.y = pkh(pv[10], pv[11]); w1.z = pkh(pv[12], pv[13]); w1.w = pkh(pv[14], pv[15]);
        u32x4* dst = (u32x4*)p.rbuf + (size_t)unit * 256 + (2 * kt) * 64 + lane;
        dst[0] = w0; dst[64] = w1;
    } else {
        const int vt = wave - 6;
        f32x16 y = mm_tile<2>(sm + L_ARB, r32, P32, sm + L_UT, 32 * vt + r32, P32, zero16(), hi);
        y = mm_tile<2>(sm + L_ARK, r32, P32, sm + L_VT, 32 * vt + r32, P32, y, hi);
        h16* dst = p.ya + ((size_t)b * SEQ + c * 32) * DH + h * 64 + 32 * vt + r32;
#pragma unroll
        for (int r = 0; r < 16; ++r) dst[(size_t)crow(r, hi) * DH] = (h16)y[r];
    }
    if (wave >= 4) {
        const int mt = (wave - 4) >> 1, vt = (wave - 4) & 1;
        f32x16 q = mm_tile<2>(sm + L_BMT, 32 * mt + r32, P32, sm + L_UT, 32 * vt + r32, P32, zero16(), hi);
        q = mm_tile<2>(sm + L_KMT, 32 * mt + r32, P32, sm + L_VT, 32 * vt + r32, P32, q, hi);
        unsigned qw[8];
#pragma unroll
        for (int r2 = 0; r2 < 8; ++r2) { const int k0 = 32 * mt + crow(2 * r2, hi), k1 = 32 * mt + crow(2 * r2 + 1, hi);
            qw[r2] = pkh(q[2 * r2] * (GL[k0] / GM[k0]), q[2 * r2 + 1] * (GL[k1] / GM[k1])); }
        u32x4* dst = (u32x4*)(p.qbuf + (size_t)unit * 2048 + ((vt * 2 + mt) * 64 + lane) * 8);
        dst[0] = (u32x4){qw[0], qw[1], qw[2], qw[3]}; dst[1] = (u32x4){qw[4], qw[5], qw[6], qw[7]};
    }
    __syncthreads();
}
__device__ __forceinline__ float h_lo(unsigned w) { return (float)__builtin_bit_cast(h16x2, w)[0]; }
__device__ __forceinline__ float h_hi(unsigned w) { return (float)__builtin_bit_cast(h16x2, w)[1]; }
struct LdSet { u32x4 v[11]; };
__device__ __forceinline__ void chain_ld(LdSet& d, const unsigned char* pb, const unsigned char* qb, int grp, int lt) {
#pragma unroll
    for (int i = 0; i < 11; ++i) { const int idx = lt + i * 384; if (idx < 4096) { const int ch = idx >> 10, w = idx & 1023; const size_t u = (size_t)(grp * 4 + ch) * 8192;
        d.v[i] = *(const u32x4*)((w < 512 ? pb : qb - 8192) + u + (size_t)w * 16); } }
}
__device__ __forceinline__ void chain_st(const LdSet& d, LAS unsigned char* set, int lt) {
    LAS unsigned char* b = set + lt * 16;
#pragma unroll
    for (int i = 0; i < 10; ++i) *(LAS u32x4*)(b + i * 6144) = d.v[i];
    if (lt < 256) *(LAS u32x4*)(b + 10 * 6144) = d.v[10];
}
__device__ __forceinline__ void chain_group(LAS unsigned char* pbase, LAS unsigned char* qbase, f32x16& c0, f32x16& c1, u32x4* sdst) {
#pragma unroll
    for (int cc = 0; cc < 4; ++cc) {
        h16x8 pa[8]; u32x4 q[4];
#pragma unroll
        for (int i = 0; i < 8; ++i) pa[i] = *(const LAS h16x8*)(pbase + cc * 16384 + i * 1024);
#pragma unroll
        for (int i = 0; i < 4; ++i) q[i] = *(const LAS u32x4*)(qbase + cc * 16384 + (i >> 1) * 2048 + (i & 1) * 16);
        h16x8 bs[4];
#pragma unroll
        for (int e = 0; e < 8; ++e) { bs[0][e] = (h16)c0[e]; bs[1][e] = (h16)c0[8 + e]; bs[2][e] = (h16)c1[e]; bs[3][e] = (h16)c1[8 + e]; }
#pragma unroll
        for (int s = 0; s < 4; ++s) sdst[cc * 512 + s * 64] = __builtin_bit_cast(u32x4, bs[s]);
        f32x16 n0, n1;
#pragma unroll
        for (int w = 0; w < 4; ++w) { n0[2 * w] = h_lo(q[0][w]); n0[2 * w + 1] = h_hi(q[0][w]); n0[8 + 2 * w] = h_lo(q[1][w]); n0[8 + 2 * w + 1] = h_hi(q[1][w]);
                                      n1[2 * w] = h_lo(q[2][w]); n1[2 * w + 1] = h_hi(q[2][w]); n1[8 + 2 * w] = h_lo(q[3][w]); n1[8 + 2 * w + 1] = h_hi(q[3][w]); }
#pragma unroll
        for (int s = 0; s < 4; ++s) { n0 = __builtin_amdgcn_mfma_f32_32x32x16_f16(pa[s], bs[s], n0, 0, 0, 0); n1 = __builtin_amdgcn_mfma_f32_32x32x16_f16(pa[4 + s], bs[s], n1, 0, 0, 0); }
        c0 = n0; c1 = n1;
        asm volatile("" ::: "memory");
    }
}
__device__ __forceinline__ void chain_block(const P& p, LAS unsigned char* sm, int bh, int tid, int lane, int wave) {
    const unsigned char* pb = (const unsigned char*)p.pbuf + (size_t)bh * 256 * 8192;
    const unsigned char* qb = (const unsigned char*)p.qbuf + (size_t)bh * 256 * 8192;
    const int lt = tid - 128;
#define CH_BAR() asm volatile("s_waitcnt lgkmcnt(0)\n\ts_barrier" ::: "memory")
    if (wave >= 2) {
        LdSet A, B;
        chain_ld(A, pb, qb, 0, lt); chain_ld(B, pb, qb, 1, lt); chain_st(A, sm, lt); chain_ld(A, pb, qb, 2, lt);
        CH_BAR();
        for (int g = 0; g < 64; g += 2) {
            chain_st(B, sm + 65536, lt); if (g + 3 < 64) chain_ld(B, pb, qb, g + 3, lt);
            CH_BAR();
            if (g + 2 < 64) { chain_st(A, sm, lt); if (g + 4 < 64) chain_ld(A, pb, qb, g + 4, lt); }
            CH_BAR();
        }
    } else {
        f32x16 c0 = zero16(), c1 = zero16();
        u32x4* sbase = (u32x4*)p.qbuf + (size_t)bh * 256 * 512 + wave * 256 + lane;
        LAS unsigned char* pbase = sm + lane * 16; LAS unsigned char* qbase = sm + 8192 + (wave * 128 + lane) * 32;
        CH_BAR();
        for (int g = 0; g < 64; g += 2) {
            chain_group(pbase, qbase, c0, c1, sbase + (size_t)(g * 4) * 512);
            CH_BAR();
            chain_group(pbase + 65536, qbase + 65536, c0, c1, sbase + (size_t)((g + 1) * 4) * 512);
            CH_BAR();
        }
    }
#undef CH_BAR
    __syncthreads();
}
__device__ __forceinline__ void attn_unit(const P& p, LAS unsigned char* sm, int unit, int tid, int lane, int wave) {
    const int bh = unit >> 5, qb = unit & 31, b = bh >> 3, h = bh & 7, q0 = qb * 256, qw0 = q0 + wave * 32, r32 = lane & 31, hi = lane >> 5, qabs = qw0 + r32;
    const h16* base = p.qkv + (size_t)b * SEQ * DQKV + h * 64;
    h16x8 qf[4];
#pragma unroll
    for (int d0 = 0; d0 < 4; ++d0) qf[d0] = *(const h16x8*)(base + (size_t)(qw0 + r32) * DQKV + d0 * 16 + hi * 8);
    f32x16 o0, o1;
#pragma unroll
    for (int r = 0; r < 16; ++r) { o0[r] = 0.f; o1[r] = 0.f; }
    float carry = 0.f; int done = 0;
    const int lkey = tid >> 3, lc = tid & 7, ks_ = lkey >> 4, rem = lkey & 15, hk = (rem >> 2) & 1, e_ = ((rem >> 3) << 2) | (rem & 3);
    LAS unsigned short* vt = (LAS unsigned short*)(sm + 8192 + (((ks_ * 2 + hk) * 64 + lc * 8) * 8 + e_) * 2);
    volatile LAS unsigned* nd = (volatile LAS unsigned*)(sm + RING_BYTES + 16);
    if (tid == 0) { nd[0] = 0u; nd[1] = 0u; }
    int it = 0;
    for (int jt = (q0 + 255) >> 6; jt >= 0; --jt, ++it) {
        const int k0 = jt * 64;
        { const h16* src = base + (size_t)(k0 + lkey) * DQKV + lc * 8;
          const u32x4 kv = *(const u32x4*)(src + 512), vv = *(const u32x4*)(src + 1024);
          *(LAS u32x4*)(sm + lc * 1024 + lkey * 16) = kv;
          vt[0] = (unsigned short)(vv.x & 0xffffu); vt[8] = (unsigned short)(vv.x >> 16); vt[16] = (unsigned short)(vv.y & 0xffffu); vt[24] = (unsigned short)(vv.y >> 16);
          vt[32] = (unsigned short)(vv.z & 0xffffu); vt[40] = (unsigned short)(vv.z >> 16); vt[48] = (unsigned short)(vv.w & 0xffffu); vt[56] = (unsigned short)(vv.w >> 16); }
        __syncthreads();
        if (tid == 0) nd[(it + 1) & 1] = 0u;
        if (!done && k0 <= qw0 + 31) {
            f32x16 p0, p1;
#pragma unroll
            for (int r = 0; r < 16; ++r) { p0[r] = 0.f; p1[r] = 0.f; }
#pragma unroll
            for (int d0 = 0; d0 < 4; ++d0) { const h16x8 a0 = *(const LAS h16x8*)(sm + (d0 * 2 + hi) * 1024 + r32 * 16), a1 = *(const LAS h16x8*)(sm + (d0 * 2 + hi) * 1024 + 512 + r32 * 16);
                p0 = __builtin_amdgcn_mfma_f32_32x32x16_f16(a0, qf[d0], p0, 0, 0, 0); p1 = __builtin_amdgcn_mfma_f32_32x32x16_f16(a1, qf[d0], p1, 0, 0, 0); }
            float L0[16], L1[16];
#pragma unroll
            for (int r = 0; r < 16; ++r) { const int key = k0 + crow(r, hi);
                { const float z = p0[r], sp = fmaxf(z, 0.f) + __logf(1.f + __expf(-fabsf(z))); L0[r] = (key < qabs) ? -sp : 0.f; p0[r] = z - sp; }
                { const float z = p1[r], sp = fmaxf(z, 0.f) + __logf(1.f + __expf(-fabsf(z))); L1[r] = (key + 32 < qabs) ? -sp : 0.f; p1[r] = z - sp; } }
            float Gs[8], PG[8], sgo[8];
#pragma unroll
            for (int j = 0; j < 4; ++j) { Gs[j] = (L0[4 * j] + L0[4 * j + 1]) + (L0[4 * j + 2] + L0[4 * j + 3]); Gs[4 + j] = (L1[4 * j] + L1[4 * j + 1]) + (L1[4 * j + 2] + L1[4 * j + 3]); }
#pragma unroll
            for (int j = 0; j < 8; ++j) PG[j] = __shfl_xor(Gs[j], 32);
            float run = 0.f;
#pragma unroll
            for (int j = 7; j >= 0; --j) { const float ev = hi ? PG[j] : Gs[j], od = hi ? Gs[j] : PG[j]; const float so = run; run += od; const float se = run; run += ev; sgo[j] = hi ? so : se; }
            h16x8 pa[4];
#pragma unroll
            for (int j = 0; j < 4; ++j) {
                float acc = carry + sgo[j], acc1 = carry + sgo[4 + j];
#pragma unroll
                for (int i = 3; i >= 0; --i) { const int r = 4 * j + i, key = k0 + crow(r, hi);
                    const float a0 = (key < qabs) ? __expf(p0[r] + acc) : 0.f; acc += L0[r];
                    const float a1 = (key + 32 < qabs) ? __expf(p1[r] + acc1) : 0.f; acc1 += L1[r];
                    pa[j >> 1][(j & 1) * 4 + i] = (h16)a0; pa[2 + (j >> 1)][(j & 1) * 4 + i] = (h16)a1; }
            }
            carry += run;
#pragma unroll
            for (int ks = 0; ks < 4; ++ks) { const h16x8 v0 = *(const LAS h16x8*)(sm + 8192 + ((ks * 2 + hi) * 64 + r32) * 16), v1 = *(const LAS h16x8*)(sm + 8192 + ((ks * 2 + hi) * 64 + 32 + r32) * 16);
                o0 = __builtin_amdgcn_mfma_f32_32x32x16_f16(pa[ks], v0, o0, 0, 0, 0); o1 = __builtin_amdgcn_mfma_f32_32x32x16_f16(pa[ks], v1, o1, 0, 0, 0); }
            done = __all(carry < -104.0f) ? 1 : 0;
        }
        if (lane == 0 && !done) nd[it & 1] = 1u;
        __syncthreads();
        if (nd[it & 1] == 0u) break;
    }
    h16* ob = p.ob + ((size_t)b * SEQ + qw0) * DH + h * 64;
#pragma unroll
    for (int r = 0; r < 16; ++r) { const int q = crow(r, hi); ob[(size_t)q * DH + r32] = (h16)o0[r]; ob[(size_t)q * DH + 32 + r32] = (h16)o1[r]; }
}
__device__ __forceinline__ void phase4b(const P& p, LAS unsigned char* lds, int lane, int wave) {
    const int gw = blockIdx.x * 8 + wave, NGW = gridDim.x * 8, r32 = lane & 31, hi = lane >> 5;
    LAS float* yt = (LAS float*)(lds + wave * 8448);
    for (int unit = gw; unit < NPRE; unit += NGW) {
        const int bh = unit >> 8, c = unit & 255, b = bh >> 3, h = bh & 7; const size_t tok0 = (size_t)b * SEQ + c * 32;
        h16x8 ra[4];
#pragma unroll
        for (int s = 0; s < 4; ++s) ra[s] = __builtin_bit_cast(h16x8, ((const u32x4*)p.rbuf)[(size_t)unit * 256 + s * 64 + lane]);
#pragma unroll
        for (int vt = 0; vt < 2; ++vt) {
            const h16* yl = p.ya + tok0 * DH + h * 64 + 32 * vt + r32; f32x16 y;
#pragma unroll
            for (int r = 0; r < 16; ++r) y[r] = (float)yl[(size_t)crow(r, hi) * DH];
#pragma unroll
            for (int s = 0; s < 4; ++s) { const h16x8 sb = __builtin_bit_cast(h16x8, ((const u32x4*)p.qbuf)[(size_t)unit * 512 + vt * 256 + s * 64 + lane]); y = __builtin_amdgcn_mfma_f32_32x32x16_f16(ra[s], sb, y, 0, 0, 0); }
#pragma unroll
            for (int r = 0; r < 16; ++r) yt[crow(r, hi) * 66 + 32 * vt + r32] = y[r];
        }
        const int col = h * 64 + lane; const float gg = p.gn_g[col], gb = p.gn_b[col], muv = p.mu[1024 + col];
#pragma unroll 4
        for (int t = 0; t < 32; ++t) {
            const size_t gm = tok0 + t;
            const float y = yt[t * 66 + lane], mean = wave_sum(y) * (1.f / 64.f), d = y - mean, var = wave_sum(d * d) * (1.f / 64.f);
            const float gn = d * (1.0f / sqrtf(var + GN_EPS)) * gg + gb;
            float v = (float)p.zrw[gm * DRW + 1024 + col], vp = 0.f; if (c * 32 + t > 0) vp = (float)p.zrw[(gm - 1) * DRW + 1024 + col];
            v += muv * (vp - v);
            const float g = (float)p.lout[gm * DLO + 1024 + col], bon = p.bon[gm * 8 + h];
            p.ya[gm * DH + col] = (h16)((gn + bon * v) * g);
        }
    }
}
template <bool FINAL> __device__ __forceinline__ void phase_ln(const P& p, int lane, int wave) {
    const int gw = blockIdx.x * 8 + wave, NGW = gridDim.x * 8;
    const float* lg = FINAL ? p.ln2g : p.ln1g; const float* lb = FINAL ? p.ln2b : p.ln1b;
    for (int m = gw; m < M; m += NGW) {
        f32x4* xr = (f32x4*)(p.out + (size_t)m * D) + lane; const int b = m >> 13;
        f32x4 v[4]; float s = 0.f;
#pragma unroll
        for (int j = 0; j < 4; ++j) { v[j] = xr[64 * j]; s += (v[j].x + v[j].y) + (v[j].z + v[j].w); }
        float mean = wave_sum(s) * (1.f / D), s2 = 0.f;
#pragma unroll
        for (int j = 0; j < 4; ++j) { v[j] = v[j] - mean; s2 += (v[j].x * v[j].x + v[j].y * v[j].y) + (v[j].z * v[j].z + v[j].w * v[j].w); }
        float rstd = 1.f / sqrtf(wave_sum(s2) * (1.f / D) + LN_EPS);
        s = 0.f;
#pragma unroll
        for (int j = 0; j < 4; ++j) { const int col = 4 * (lane + 64 * j); v[j] = v[j] * rstd * *(const f32x4*)(lg + col) + *(const f32x4*)(lb + col); xr[64 * j] = v[j]; s += (v[j].x + v[j].y) + (v[j].z + v[j].w); }
        if (!FINAL) {
            mean = wave_sum(s) * (1.f / D); s2 = 0.f;
#pragma unroll
            for (int j = 0; j < 4; ++j) { v[j] = v[j] - mean; s2 += (v[j].x * v[j].x + v[j].y * v[j].y) + (v[j].z * v[j].z + v[j].w * v[j].w); }
            rstd = 1.f / sqrtf(wave_sum(s2) * (1.f / D) + ADA_EPS);
            uint2* o8 = (uint2*)(p.h + (size_t)m * D) + lane; const float* ad = p.ada + b * 6144;
#pragma unroll
            for (int j = 0; j < 4; ++j) { const int col = 4 * (lane + 64 * j); const f32x4 sh = *(const f32x4*)(ad + 3072 + col), sc = *(const f32x4*)(ad + 4096 + col);
                const f32x4 r = v[j] * rstd * (sc + 1.0f) + sh; uint2 w; w.x = pkh(r.x, r.y); w.y = pkh(r.z, r.w); o8[64 * j] = w; }
        }
    }
}

typedef __attribute__((address_space(4))) const unsigned char* kargp_t;
__device__ __forceinline__ void make_p(P& p) {
    kargp_t ka = (kargp_t)__builtin_amdgcn_kernarg_segment_ptr(); asm volatile("" : "+s"(ka));
    const float* const __attribute__((address_space(4)))* in = (const float* const __attribute__((address_space(4)))*)ka;
    p.x = in[0]; p.c = in[1]; p.w_ada = in[2]; p.b_ada = in[3]; p.w_in = in[4]; p.mu = in[5]; p.w0 = in[6]; p.w2 = in[7]; p.a0 = in[8]; p.a2 = in[9]; p.g2 = in[10];
    p.kk = in[11]; p.ka = in[12]; p.rk = in[13]; p.gn_g = in[14]; p.gn_b = in[15]; p.wba = in[16]; p.wbb = in[17]; p.wout = in[18]; p.ln1g = in[19]; p.ln1b = in[20];
    p.w1 = in[21]; p.b1 = in[22]; p.wf2 = in[23]; p.b2 = in[24]; p.ln2g = in[25]; p.ln2b = in[26];
    p.out = (float*)in[27]; unsigned char* ws = (unsigned char*)in[28]; p.ws = ws;
    p.ctl = (unsigned*)(ws + WS_CTL); p.adap = (float*)(ws + WS_ADAP); p.ada = (float*)(ws + WS_ADA); p.bon = (float*)(ws + WS_BON);
    p.win_t = (h16*)(ws + WS_WIN); p.wlora_t = (h16*)(ws + WS_WLORA); p.wba_t = (h16*)(ws + WS_WBA); p.wbb_t = (h16*)(ws + WS_WBB); p.wout_t = (h16*)(ws + WS_WOUT); p.w1_t = (h16*)(ws + WS_W1); p.w2_t = (h16*)(ws + WS_W2);
    p.h = (h16*)(ws + WS_H16); p.zrw = (h16*)(ws + WS_ZRW); p.qkv = (h16*)(ws + WS_QKV); p.lin = (h16*)(ws + WS_LIN); p.lout = (h16*)(ws + WS_LOUT); p.mrg = (h16*)(ws + WS_MRG); p.hid = (h16*)(ws + WS_HID);
    p.pbuf = (h16*)(ws + WS_PB); p.rbuf = (h16*)(ws + WS_RB); p.qbuf = (unsigned*)(ws + WS_QB); p.ya = (h16*)(ws + WS_H16); p.ob = (h16*)(ws + WS_H16 + 16 * MiB); p.gates = (h16*)p.out;
}
__global__ void __launch_bounds__(512, 2) mk_fwd(KArgs a) {
    extern __shared__ __attribute__((aligned(16))) unsigned char lds_raw[];
    LAS unsigned char* lds = (LAS unsigned char*)lds_raw;
    volatile LAS unsigned* MISC = (volatile LAS unsigned*)(lds + MISC_OFF);
    int tid = threadIdx.x, lane = tid & 63, wave = __builtin_amdgcn_readfirstlane(tid >> 6);
#define FRESH() do { tid = threadIdx.x; asm volatile("" : "+v"(tid)); lane = tid & 63; wave = __builtin_amdgcn_readfirstlane(tid >> 6); make_p(p); } while (0)
    P p; make_p(p);
    for (int u = tid; u < (LDS_BYTES - RING_BYTES) / 4; u += 512) ((LAS unsigned*)(lds + RING_BYTES))[u] = 0u;
    __syncthreads();
    XcdBarrier bar = xcd_barrier_post(p.ctl + CW_BAR, MISC + 8);
#define GRID_BAR() xcd_barrier(bar)

    FRESH();
    phase0(p, lds, tid, lane, wave);
    cg::this_grid().sync();
    FRESH();
    phase0b(p, lds, tid, lane, wave);
    GRID_BAR();
    FRESH();
    run_gemm(lds, p.h, p.win_t, DIN, D, F1{p.zrw, p.qkv, p.gates});
    GRID_BAR();
    FRESH();
    phase2(p, tid);
    GRID_BAR();
    FRESH();
    run_gemm(lds, p.lin, p.wlora_t, DLO, 256, F3{p.lout});
    GRID_BAR();
    {
        for (;;) {
            if (tid == 0) MISC[0] = atomicAdd(p.ctl + CW_ATTQ, 1u);
            __syncthreads();
            const int u = (int)MISC[0];
            __syncthreads();
            if (u >= NATT) break;
            FRESH();
            attn_unit(p, lds, u, tid, lane, wave);
        }
    }
    GRID_BAR();
    FRESH();
    for (int u = (int)blockIdx.x; u < NPRE; u += (int)gridDim.x) pre_unit(p, lds, u, tid, lane, wave);
    GRID_BAR();
    FRESH();
    if ((int)blockIdx.x < NCHAINB) chain_block(p, lds, (int)blockIdx.x, tid, lane, wave);
    else run_gemm(lds, p.ob, p.wbb_t, D, DH, F5Y{p.gates}, (int)gridDim.x - NCHAINB, (int)blockIdx.x - NCHAINB);
    GRID_BAR();
    FRESH();
    phase4b(p, lds, lane, wave);
    GRID_BAR();
    FRESH();
    run_gemm(lds, p.ya, p.wba_t, D, DH, F5X{p.mrg, p.gates});
    GRID_BAR();
    FRESH();
    run_gemm(lds, p.mrg, p.wout_t, D, D, F6{p.x, p.out, p.ada});
    GRID_BAR();
    FRESH();
    phase_ln<false>(p, lane, wave);
    GRID_BAR();
    FRESH();
    run_gemm(lds, p.h, p.w1_t, DFF, D, F8{p.hid, p.b1});
    GRID_BAR();
    FRESH();
    run_gemm(lds, p.hid, p.w2_t, D, DFF, F9{p.out, p.ada, p.b2});
    GRID_BAR();
    FRESH();
    phase_ln<true>(p, lane, wave);
}

extern "C" void kernel_launch(void* const* d_in, const int* in_sizes, int n_in, void* d_out, int out_size, void* d_ws, size_t ws_size, hipStream_t stream) {
    static int grid = 0;
    if (grid == 0) {
        if (n_in != 27 || out_size != M * D || ws_size < WS_END) { fprintf(stderr, "kernel_launch: unexpected shapes (n_in %d, out %d, ws %zu)\n", n_in, out_size, ws_size); grid = -1; return; }
        int dev = 0, cus = 0, per_cu = 0;
        hipGetDevice(&dev); hipDeviceGetAttribute(&cus, hipDeviceAttributeMultiprocessorCount, dev);
        if (hipFuncSetAttribute((const void*)mk_fwd, hipFuncAttributeMaxDynamicSharedMemorySize, LDS_BYTES) != hipSuccess) { fprintf(stderr, "kernel_launch: hipFuncSetAttribute failed\n"); grid = -1; return; }
        hipOccupancyMaxActiveBlocksPerMultiprocessor(&per_cu, (const void*)mk_fwd, 512, LDS_BYTES);
        (void)hipGetLastError();
        if (per_cu < 1) fprintf(stderr, "kernel_launch: occupancy query says %d blocks per CU\n", per_cu);
        grid = cus;
    }
    if (grid < 0) return;
    hipMemsetAsync((char*)d_ws + WS_CTL, 0, CTL_ZERO_BYTES, stream);
    KArgs a{};
    for (int i = 0; i < 27; ++i) a.in[i] = (const float*)d_in[i];
    a.out = (float*)d_out; a.ws = (unsigned char*)d_ws;
    void* args[] = {&a};
    hipError_t e = hipLaunchCooperativeKernel((const void*)mk_fwd, dim3(grid), dim3(512), args, LDS_BYTES, stream);
    if (e != hipSuccess) fprintf(stderr, "cooperative launch failed: %s (grid %d)\n", hipGetErrorString(e), grid);
}
```

```cpp
#include <hip/hip_runtime.h>
#include <hip/hip_cooperative_groups.h>
#include <cstdio>
#include <cstdint>
namespace cg = cooperative_groups;
namespace pg8 {
#define PG8_LAS __attribute__((address_space(3)))
typedef unsigned short bf16_t;
typedef _Float16 bf16x8 __attribute__((ext_vector_type(8)));
typedef float f32x4 __attribute__((ext_vector_type(4)));
typedef unsigned u32x4 __attribute__((ext_vector_type(4)));
constexpr int BM = 256, BK = 64, HALF = 128, HTB = HALF * BK * 2  , STAGE_BYTES = 8 * HTB, NXCD = 8, WGM = 8;

__host__ __device__ __forceinline__ int lds_byte(int r, int c) { const int st = (r >> 4) * 2 + (c >> 5), rr = r & 15, cc = c & 31, ob = rr * 64 + cc * 2; return st * 1024 + (ob ^ (((ob >> 9) & 1) << 5)); }
__host__ __device__ __forceinline__ void stage_rc(int b, int& R, int& C) { const int st = b / 1024, sb = b % 1024, swz = sb ^ (((sb >> 9) & 1) << 5); R = (st >> 1) * 16 + swz / 64; C = (st & 1) * 32 + (swz % 64) / 2; }
__host__ __device__ __forceinline__ int perm32(int rho) { const int n = rho >> 4, i = rho & 15; return 8 * (i >> 2) + 4 * n + (i & 3); }

struct Unit { int pm, pn; };
struct Gemm { const bf16_t* A; const bf16_t* Bt; int M, N, K; };

struct StaticOrder {
    int nM, nN, nwg, G, c;
    __host__ __device__ void init(int M, int N, int G_, int c_) { nM = M / BM; nN = N / BM; nwg = nM * nN; G = G_; c = c_; }
    __host__ __device__ bool next(int i, Unit& u) const {
        const long L = (long)i * G + c; if (L >= nwg) return false;
        int wgid = (int)L; { const int q = nwg / NXCD, r = nwg % NXCD, xcd = wgid % NXCD, off = wgid / NXCD; wgid = (xcd < r ? xcd * (q + 1) : r * (q + 1) + (xcd - r) * q) + off; }
        const int nig = WGM * nN, gid = wgid / nig, fm = gid * WGM, gsz = (nM - fm) < WGM ? (nM - fm) : WGM;
        u.pm = fm + ((wgid % nig) % gsz); u.pn = (wgid % nig) / gsz; return true;
    }
    __device__ __forceinline__ void a_ready(const Unit&) const {}
    __device__ __forceinline__ void done(const Unit&) const {}
};
template <class Epi, class Sched, bool ALIGN_EPI = false, bool SP2 = false>
__device__ __forceinline__ void gemm_phase(PG8_LAS unsigned char* lds, const Gemm g, const Sched& S, const Epi& E) {
    int tid_ = threadIdx.x; asm volatile("" : "+v"(tid_)); const int tid = tid_, wid = __builtin_amdgcn_readfirstlane(tid >> 6), lane = tid & 63, wr = wid >> 2, wc = wid & 3, fr = lane & 15, fq = lane >> 4;
    const int K = g.K, nt = K / BK;
    unsigned voffA[2], voffB[2];
#pragma unroll
    for (int i = 0; i < 2; ++i) { int R, C; stage_rc(tid * 16 + i * 8192, R, C); const int Rb = Epi::PERM ? ((R & ~31) + perm32(R & 31)) : R;
        voffA[i] = (unsigned)(R * K + C) * 2u; voffB[i] = (unsigned)(Rb * K + C) * 2u; }
    const size_t kstep = (size_t)(BK * 2);
    const size_t hstep = (size_t)HALF * K * 2;
    const size_t tstep = 2 * hstep;
    const unsigned ldsw = (unsigned)wid * 1024u;
    const int aoff = lds_byte(wr * 64 + fr, fq * 8), boff = lds_byte(wc * 32 + fr, fq * 8);
#define PG8_SA(b, h) (((b) * 2 + (h)) * HTB)
#define PG8_SB(b, h) ((4 + (b) * 2 + (h)) * HTB)
#define PG8_STAGE(bufoff, gbase, voff) do { _Pragma("unroll") for (int _i = 0; _i < 2; ++_i) \
        __builtin_amdgcn_global_load_lds((const unsigned*)((const char*)(gbase) + (voff)[_i]), (PG8_LAS unsigned*)(lds + (bufoff) + ldsw + _i * 8192), 16, 0, 0); } while (0)
#define PG8_LDA(dst, b, h) do { _Pragma("unroll") for (int m = 0; m < 4; ++m) _Pragma("unroll") for (int k = 0; k < 2; ++k) dst[m][k] = *(const PG8_LAS bf16x8*)(lds + PG8_SA(b, h) + aoff + m * 2048 + k * 1024); } while (0)
#define PG8_LDB(dst, b, h) do { _Pragma("unroll") for (int n = 0; n < 2; ++n) _Pragma("unroll") for (int k = 0; k < 2; ++k) dst[n][k] = *(const PG8_LAS bf16x8*)(lds + PG8_SB(b, h) + boff + n * 2048 + k * 1024); } while (0)
#define PG8_MMA(ai, bj, At, Bt) do { __builtin_amdgcn_s_setprio(1); _Pragma("unroll") for (int m = 0; m < 4; ++m) _Pragma("unroll") for (int n = 0; n < 2; ++n) _Pragma("unroll") for (int k = 0; k < 2; ++k) \
        acc[ai][bj][m][n] = __builtin_amdgcn_mfma_f32_16x16x32_f16(Bt[n][k], At[m][k], acc[ai][bj][m][n], 0, 0, 0); __builtin_amdgcn_s_setprio(0); } while (0)
#define PG8_WAIT_V(n) asm volatile("s_waitcnt vmcnt(" #n ")" ::: "memory")
#define PG8_WAIT_L(n) asm volatile("s_waitcnt lgkmcnt(" #n ")" ::: "memory")
#define PG8_BAR __builtin_amdgcn_s_barrier()
#define PG8_SCHED __builtin_amdgcn_sched_barrier(0)
    Unit cur, nxt; int ui = 0;
    if (!S.next(0, cur)) return;
    f32x4 acc[2][2][4][2];
#pragma unroll
    for (int a = 0; a < 2; ++a)
#pragma unroll
        for (int b = 0; b < 2; ++b)
#pragma unroll
            for (int m = 0; m < 4; ++m)
#pragma unroll
                for (int n = 0; n < 2; ++n) acc[a][b][m][n] = (f32x4){0.f, 0.f, 0.f, 0.f};
    bf16x8 At[4][2], B0[2][2], B1[2][2];
    const char* cA = (const char*)g.A + (size_t)cur.pm * tstep; const char* cB = (const char*)g.Bt + (size_t)cur.pn * tstep;
    S.a_ready(cur);
    if constexpr (SP2) {
        PG8_STAGE(PG8_SB(0, 0), cB, voffB); PG8_STAGE(PG8_SB(0, 1), cB + hstep, voffB); PG8_STAGE(PG8_SA(0, 0), cA, voffA); PG8_STAGE(PG8_SA(0, 1), cA + hstep, voffA);
        if (wr == 1) PG8_BAR;
        PG8_WAIT_V(2); PG8_BAR;
        PG8_STAGE(PG8_SB(1, 0), cB + kstep, voffB); PG8_STAGE(PG8_SA(1, 0), cA + kstep, voffA); PG8_STAGE(PG8_SB(1, 1), cB + hstep + kstep, voffB);
        PG8_WAIT_V(6); PG8_BAR;
    } else {
        PG8_STAGE(PG8_SB(0, 0), cB, voffB); PG8_STAGE(PG8_SA(0, 0), cA, voffA); PG8_STAGE(PG8_SB(0, 1), cB + hstep, voffB); PG8_STAGE(PG8_SA(0, 1), cA + hstep, voffA);
        if (wr == 1) PG8_BAR;
        PG8_WAIT_V(4); PG8_BAR;
        PG8_STAGE(PG8_SB(1, 0), cB + kstep, voffB); PG8_STAGE(PG8_SA(1, 0), cA + kstep, voffA); PG8_STAGE(PG8_SB(1, 1), cB + hstep + kstep, voffB);
        PG8_WAIT_V(6); PG8_BAR;
    }
    for (;;) {
        const bool has_next = S.next(ui + 1, nxt);
        const char* nA = has_next ? (const char*)g.A + (size_t)nxt.pm * tstep : cA; const char* nB = has_next ? (const char*)g.Bt + (size_t)nxt.pn * tstep : cB;
        for (int t = 0; t < nt; t += 2) {
            const bool last = (t == nt - 2);
            const char* a1 = cA + (size_t)(t + 1) * kstep;
            const char* a2 = last ? nA : cA + (size_t)(t + 2) * kstep; const char* b2 = last ? nB : cB + (size_t)(t + 2) * kstep;
            const char* a3 = a2 + kstep; const char* b3 = b2 + kstep;
            if (last && has_next) S.a_ready(nxt);
            if constexpr (SP2) {
            PG8_LDB(B0, 0, 0); PG8_LDB(B1, 0, 1); PG8_SCHED; PG8_LDA(At, 0, 0); PG8_STAGE(PG8_SA(1, 1), a1 + hstep, voffA);
            PG8_WAIT_V(8); PG8_WAIT_L(0); PG8_BAR; PG8_MMA(0, 0, At, B0); PG8_MMA(0, 1, At, B1); PG8_BAR; PG8_SCHED;
            PG8_LDA(At, 0, 1); PG8_STAGE(PG8_SB(0, 0), b2, voffB); PG8_STAGE(PG8_SB(0, 1), b2 + hstep, voffB); PG8_STAGE(PG8_SA(0, 0), a2, voffA);
            PG8_WAIT_V(8); PG8_WAIT_L(0); PG8_BAR; PG8_MMA(1, 0, At, B0); PG8_MMA(1, 1, At, B1); PG8_BAR; PG8_SCHED;
            PG8_LDB(B0, 1, 0); PG8_LDB(B1, 1, 1); PG8_SCHED; PG8_LDA(At, 1, 0); PG8_STAGE(PG8_SA(0, 1), a2 + hstep, voffA);
            PG8_WAIT_V(8); PG8_WAIT_L(0); PG8_BAR; PG8_MMA(0, 0, At, B0); PG8_MMA(0, 1, At, B1); PG8_BAR; PG8_SCHED;
            PG8_LDA(At, 1, 1); PG8_STAGE(PG8_SB(1, 0), b3, voffB); PG8_STAGE(PG8_SB(1, 1), b3 + hstep, voffB); PG8_STAGE(PG8_SA(1, 0), a3, voffA);
            PG8_WAIT_V(8); PG8_WAIT_L(0); PG8_BAR; PG8_MMA(1, 0, At, B0); PG8_MMA(1, 1, At, B1); PG8_BAR; PG8_SCHED;
            } else {
            PG8_LDB(B0, 0, 0); PG8_SCHED; PG8_LDA(At, 0, 0); PG8_STAGE(PG8_SA(1, 1), a1 + hstep, voffA);
            PG8_WAIT_L(8); PG8_BAR; PG8_WAIT_L(0); PG8_MMA(0, 0, At, B0); PG8_BAR; PG8_SCHED;
            PG8_LDB(B1, 0, 1); PG8_STAGE(PG8_SB(0, 0), b2, voffB);
            PG8_BAR; PG8_WAIT_L(0); PG8_MMA(0, 1, At, B1); PG8_BAR;
            PG8_LDA(At, 0, 1); PG8_STAGE(PG8_SA(0, 0), a2, voffA);
            PG8_BAR; PG8_WAIT_L(0); PG8_MMA(1, 0, At, B0); PG8_BAR; PG8_SCHED;
            PG8_STAGE(PG8_SB(0, 1), b2 + hstep, voffB);
            PG8_WAIT_V(6); PG8_BAR; PG8_MMA(1, 1, At, B1); PG8_BAR;
            PG8_LDB(B0, 1, 0); PG8_SCHED; PG8_LDA(At, 1, 0); PG8_STAGE(PG8_SA(0, 1), a2 + hstep, voffA);
            PG8_WAIT_L(8); PG8_BAR; PG8_WAIT_L(0); PG8_MMA(0, 0, At, B0); PG8_BAR; PG8_SCHED;
            PG8_LDB(B1, 1, 1); PG8_STAGE(PG8_SB(1, 0), b3, voffB);
            PG8_BAR; PG8_WAIT_L(0); PG8_MMA(0, 1, At, B1); PG8_BAR;
            PG8_LDA(At, 1, 1); PG8_STAGE(PG8_SA(1, 0), a3, voffA);
            PG8_BAR; PG8_WAIT_L(0); PG8_MMA(1, 0, At, B0); PG8_BAR; PG8_SCHED;
            PG8_STAGE(PG8_SB(1, 1), b3 + hstep, voffB);
            PG8_WAIT_V(6); PG8_BAR; PG8_MMA(1, 1, At, B1); PG8_BAR;
            }
        }
        if constexpr (ALIGN_EPI) { if (wr == 0) PG8_BAR; }
        if constexpr (!Epi::AFTER_DRAIN) { E(acc, cur, wr, wc, fr, fq); S.done(cur); }
        if (!has_next) break;
#pragma unroll
        for (int a = 0; a < 2; ++a)
#pragma unroll
            for (int b = 0; b < 2; ++b)
#pragma unroll
                for (int m = 0; m < 4; ++m)
#pragma unroll
                    for (int n = 0; n < 2; ++n) acc[a][b][m][n] = (f32x4){0.f, 0.f, 0.f, 0.f};
        cur = nxt; cA = nA; cB = nB; ++ui;
        if constexpr (ALIGN_EPI) { if (wr == 1) PG8_BAR; }
    }
    PG8_WAIT_V(0);
    if constexpr (!ALIGN_EPI) { if (wr == 0) PG8_BAR; }
    PG8_BAR;
    if constexpr (Epi::AFTER_DRAIN) { E.fused(acc, cur, wr, wc, fr, fq, lds, wid, lane); S.done(cur); }
#undef PG8_SA
#undef PG8_SB
#undef PG8_STAGE
#undef PG8_LDA
#undef PG8_LDB
#undef PG8_MMA
#undef PG8_WAIT_V
#undef PG8_WAIT_L
#undef PG8_BAR
#undef PG8_SCHED
}
}
#define GAS __attribute__((address_space(1)))
#define LAS __attribute__((address_space(3)))
typedef unsigned short bf16;
typedef unsigned v4u __attribute__((ext_vector_type(4)));
typedef float f32x4 __attribute__((ext_vector_type(4)));
typedef short bf16x8 __attribute__((ext_vector_type(8)));
typedef GAS unsigned gu32;
typedef GAS unsigned long long gu64;
#define RLX_AGENT __ATOMIC_RELAXED, __HIP_MEMORY_SCOPE_AGENT
#define LDS_WAIT() asm volatile("s_waitcnt lgkmcnt(0)" ::: "memory")
#define VM_WAIT() asm volatile("s_waitcnt vmcnt(0)" ::: "memory")
__device__ __forceinline__ unsigned long long rt() { return __builtin_amdgcn_s_memrealtime(); }
__device__ __forceinline__ unsigned f2bf(float f) { unsigned u = __builtin_bit_cast(unsigned, f); return (u + 0x7fffu + ((u >> 16) & 1u)) >> 16; }
__device__ __forceinline__ unsigned pk2(float lo, float hi) { return f2bf(lo) | (f2bf(hi) << 16); }

#define XB_TMO      128
#define XB_XCNT(j)  (256  + 64 * (j))
#define XB_XSUB(j)  (1280 + 64 * (j))
#define XB_XGEN(j)  (2304 + 64 * (j))
#define XB_TOP      3328
#define XB_TOPGEN   3392
#define XCD_BAR_WORDS 3456
#define XB_SPIN_CAP (1u << 18)

__device__ __forceinline__ unsigned xb_ld(unsigned* p)              { return __hip_atomic_load(p, __ATOMIC_RELAXED, __HIP_MEMORY_SCOPE_AGENT); }
__device__ __forceinline__ unsigned xb_add(unsigned* p, unsigned v) { return __hip_atomic_fetch_add(p, v, __ATOMIC_RELAXED, __HIP_MEMORY_SCOPE_AGENT); }
__device__ __forceinline__ unsigned xb_xcc_id() { return (unsigned)__builtin_amdgcn_s_getreg((3 << 11) | 20) & 0xFu; }
#define XB_SPIN(cond, bar) do { unsigned _sp = 0; while (cond) { __builtin_amdgcn_s_sleep(1); \
    if ((++_sp & 255u) == 0u) { if (xb_ld(&(bar)[XB_TMO])) break; if (_sp > XB_SPIN_CAP) { atomicAdd(&(bar)[XB_TMO], 1u); break; } } } } while (0)

struct XcdBarrier {
    unsigned* bar; unsigned x;
    volatile LAS unsigned* st;
};

__device__ __forceinline__ XcdBarrier xcd_barrier_post(unsigned* bar, volatile LAS unsigned* st) {
    XcdBarrier b; b.bar = bar; b.x = xb_xcc_id(); b.st = st;
    if (threadIdx.x == 0) (void)xb_add(&bar[XB_XCNT(b.x)], 1u);
    return b;
}
__device__ __forceinline__ void xcd_barrier_complete(unsigned* bar, unsigned x, unsigned& nloc, unsigned& nx) {
    const unsigned G = gridDim.x * gridDim.y * gridDim.z;
    unsigned sum, cnt, mine, sp = 0u;
    for (;;) {
        sum = 0u; cnt = 0u; mine = 0u;
#pragma unroll
        for (unsigned j = 0; j < 16; ++j) { const unsigned c = xb_ld(&bar[XB_XCNT(j)]); sum += c; cnt += (c > 0u) ? 1u : 0u; mine = (j == x) ? c : mine; }
        if (sum == G) break;
        __builtin_amdgcn_s_sleep(1);
        if ((++sp & 255u) == 0u) { if (xb_ld(&bar[XB_TMO])) break; if (sp > XB_SPIN_CAP) { atomicAdd(&bar[XB_TMO], 1u); break; } }
    }
    nloc = mine > 0u ? mine : 1u; nx = cnt > 0u ? cnt : 1u;
}

__device__ __forceinline__ void xcd_barrier(const XcdBarrier& b) {
    asm volatile("s_waitcnt vmcnt(0)" ::: "memory");
    __syncthreads();
    if (threadIdx.x == 0) {
        unsigned* bar = b.bar;
        __builtin_amdgcn_s_waitcnt(0);
        unsigned nloc = b.st[0], nx = b.st[1];
        if (nloc == 0u) { xcd_barrier_complete(bar, b.x, nloc, nx); b.st[0] = nloc; b.st[1] = nx; }
        const unsigned old = xb_add(&bar[XB_XSUB(b.x)], 1u);
        const unsigned gen = old / nloc;
        if (old + 1u == (gen + 1u) * nloc) {
            __builtin_amdgcn_fence(__ATOMIC_RELEASE, "agent");
            asm volatile("s_waitcnt vmcnt(0)" ::: "memory");
            const unsigned og = xb_add(&bar[XB_TOP], 1u);
            const unsigned tg = og / nx;
            if (og + 1u == (tg + 1u) * nx) xb_add(&bar[XB_TOPGEN], 1u);
            else XB_SPIN(xb_ld(&bar[XB_TOPGEN]) == tg, bar);
            __builtin_amdgcn_fence(__ATOMIC_ACQUIRE, "agent");
            xb_add(&bar[XB_XGEN(b.x)], 1u);
            asm volatile("s_waitcnt vmcnt(0)" ::: "memory");
        } else {
            XB_SPIN(xb_ld(&bar[XB_XGEN(b.x)]) == gen, bar);
            __builtin_amdgcn_fence(__ATOMIC_ACQUIRE, "agent");
            asm volatile("s_waitcnt vmcnt(0)" ::: "memory");
        }
    }
    __syncthreads();
}
typedef _Float16 h16;
typedef _Float16 h16x8 __attribute__((ext_vector_type(8)));
typedef _Float16 h16x2 __attribute__((ext_vector_type(2)));
typedef float f32x16 __attribute__((ext_vector_type(16)));
typedef unsigned u32x4 __attribute__((ext_vector_type(4)));
typedef unsigned u32x2 __attribute__((ext_vector_type(2)));
constexpr int NB = 2, SEQ = 8192, M = NB * SEQ, D = 1024, DIN = 5376, DRW = 1792, DQKV = 1536, DG = 2048, DFF = 4096, DH = 512, DLO = 1536;
constexpr float ALPHA = 1.189207115002721f;
constexpr float QSCALE = 0.125f * 1.4426950408889634f;
constexpr float LN_EPS = 1e-5f, ADA_EPS = 1e-6f, GN_EPS = 64e-5f;
constexpr size_t MiB = 1u << 20, KiB = 1u << 10;
constexpr size_t WS_CTL = 0, CTL_ZERO_BYTES = 1 * MiB;
constexpr size_t WS_ADAP = 1 * MiB, WS_ADA = 1 * MiB + 896 * KiB, WS_BON = 2 * MiB;
constexpr size_t WS_WIN = 3 * MiB, WS_WLORA = 13 * MiB + 512 * KiB, WS_WBA = 14 * MiB + 256 * KiB, WS_WBB = 15 * MiB + 256 * KiB, WS_WOUT = 16 * MiB + 256 * KiB,
                 WS_W1 = 18 * MiB + 256 * KiB, WS_W2 = 26 * MiB + 256 * KiB;
constexpr size_t WS_H16 = 36 * MiB, WS_ZRW = 68 * MiB, WS_QKV = 124 * MiB, WS_LOUT = 172 * MiB, WS_LIN = 220 * MiB, WS_PB = 124 * MiB, WS_RB = 156 * MiB, WS_QB = 220 * MiB, WS_MRG = 68 * MiB, WS_HID = 68 * MiB, WS_END = 252 * MiB;
constexpr int CW_ATTQ = 64, CW_BAR = 4096;
constexpr int RING_BYTES = 131072, MISC_OFF = RING_BYTES + 64, LDS_BYTES = RING_BYTES + 512;
constexpr int NATT = 16 * 256, NPRE = 16 * 256, NCHAINB = 16;

struct KArgs { const float* in[27]; float* out; unsigned char* ws; };
struct P {
    const float *x, *c, *w_ada, *b_ada, *w_in, *mu, *w0, *w2, *a0, *a2, *g2, *kk, *ka, *rk, *gn_g, *gn_b, *wba, *wbb, *wout, *ln1g, *ln1b, *w1, *b1, *wf2, *b2, *ln2g, *ln2b;
    float* out; unsigned char* ws;
    unsigned* ctl; float *adap, *ada, *bon;
    h16 *pbuf, *rbuf, *vt; unsigned* qbuf; h16 *win_t, *wlora_t, *wba_t, *wbb_t, *wout_t, *w1_t, *w2_t, *h, *zrw, *qkv, *lin, *lout, *mrg, *hid, *ya, *ob, *gates;
};

__device__ __forceinline__ unsigned pkh(float a, float b) { h16x2 v = {(h16)a, (h16)b}; return __builtin_bit_cast(unsigned, v); }
__device__ __forceinline__ void store8h(h16* p, const f32x4& v0, const f32x4& v1) { u32x4 w; w.x = pkh(v0.x, v0.y); w.y = pkh(v0.z, v0.w); w.z = pkh(v1.x, v1.y); w.w = pkh(v1.z, v1.w); *(u32x4*)p = w; }
__device__ __forceinline__ void load8h(const h16* p, f32x4& v0, f32x4& v1) { const h16x8 t = *(const h16x8*)p; v0 = (f32x4){(float)t[0], (float)t[1], (float)t[2], (float)t[3]}; v1 = (f32x4){(float)t[4], (float)t[5], (float)t[6], (float)t[7]}; }
__device__ __forceinline__ float sigmoidf_(float x) { return 1.0f / (1.0f + __expf(-x)); }
__device__ __forceinline__ float wave_sum(float v) {
#pragma unroll
    for (int o = 1; o < 64; o <<= 1) v += __shfl_xor(v, o);
    return v;
}
template <int CTRL> __device__ __forceinline__ float dppmov(float x) { return __builtin_bit_cast(float, __builtin_amdgcn_update_dpp(0, __builtin_bit_cast(int, x), CTRL, 0xf, 0xf, true)); }
__device__ __forceinline__ float red16(float v) { v += dppmov<0xB1>(v); v += dppmov<0x4E>(v); v += dppmov<0x124>(v); v += dppmov<0x128>(v); return v; }

template <class F> struct EpiGen {
    static constexpr bool PERM = true, AFTER_DRAIN = false;
    F f;
    __device__ __forceinline__ void operator()(const f32x4 (&acc)[2][2][4][2], const pg8::Unit& u, int wr, int wc, int fr, int fq) const {
        const int row0 = u.pm * 256 + wr * 64 + fr, col0 = u.pn * 256 + wc * 32 + 8 * fq;
#pragma unroll
        for (int ai = 0; ai < 2; ++ai)
#pragma unroll
            for (int m = 0; m < 4; ++m)
#pragma unroll
                for (int bj = 0; bj < 2; ++bj) f(row0 + ai * 128 + m * 16, col0 + bj * 128, acc[ai][bj][m][0], acc[ai][bj][m][1]);
    }
};
struct F1 {
    h16 *zrw, *qkv, *gates;
    __device__ __forceinline__ void operator()(int row, int col, f32x4 v0, f32x4 v1) const {
        if (col < DRW) store8h(zrw + (size_t)row * DRW + col, v0, v1);
        else if (col < DRW + DQKV) { const int c = col - DRW; if (c < 512) { v0 = v0 * QSCALE; v1 = v1 * QSCALE; } store8h(qkv + (size_t)row * DQKV + c, v0, v1); }
        else { const int c = col - DRW - DQKV;
#pragma unroll
            for (int i = 0; i < 4; ++i) { v0[i] = sigmoidf_(v0[i]); v1[i] = sigmoidf_(v1[i]); }
            store8h(gates + (size_t)row * DG + c, v0, v1); }
    }
};
struct F3 {
    h16* lout;
    __device__ __forceinline__ void operator()(int row, int col, f32x4 v0, f32x4 v1) const { store8h(lout + (size_t)row * DLO + col, v0, v1); }
};
struct F5Y { h16* gates;
    __device__ __forceinline__ void operator()(int row, int col, f32x4 v0, f32x4 v1) const {
        f32x4 g0, g1; h16* gp = gates + (size_t)row * DG + 1024 + col; load8h(gp, g0, g1); store8h(gp, v0 * g0, v1 * g1); } };
struct F5X { h16* mrg; const h16* gates;
    __device__ __forceinline__ void operator()(int row, int col, f32x4 v0, f32x4 v1) const {
        f32x4 g0, g1, m0, m1; load8h(gates + (size_t)row * DG + col, g0, g1); load8h(gates + (size_t)row * DG + 1024 + col, m0, m1); store8h(mrg + (size_t)row * D + col, m0 + v0 * g0, m1 + v1 * g1); } };
struct F6 { const float* x; float* out; const float* ada;
    __device__ __forceinline__ void operator()(int row, int col, f32x4 v0, f32x4 v1) const {
        const float* g = ada + (row >> 13) * 6144 + 2048 + col; const size_t o = (size_t)row * D + col;
        const f32x4 x0 = *(const f32x4*)(x + o), x1 = *(const f32x4*)(x + o + 4), g0 = *(const f32x4*)g, g1 = *(const f32x4*)(g + 4);
        *(f32x4*)(out + o) = x0 * ALPHA + g0 * v0; *(f32x4*)(out + o + 4) = x1 * ALPHA + g1 * v1; } };
struct F8 { h16* hid; const float* b1;
    __device__ __forceinline__ void operator()(int row, int col, f32x4 v0, f32x4 v1) const {
        const f32x4 c0 = *(const f32x4*)(b1 + col), c1 = *(const f32x4*)(b1 + col + 4);
#pragma unroll
        for (int i = 0; i < 4; ++i) { float a = fmaxf(v0[i] + c0[i], 0.f); v0[i] = a * a; a = fmaxf(v1[i] + c1[i], 0.f); v1[i] = a * a; }
        store8h(hid + (size_t)row * DFF + col, v0, v1); } };
struct F9 { float* out; const float* ada; const float* b2;
    __device__ __forceinline__ void operator()(int row, int col, f32x4 v0, f32x4 v1) const {
        const float* g = ada + (row >> 13) * 6144 + 5120 + col; const size_t o = (size_t)row * D + col;
        const f32x4 x0 = *(const f32x4*)(out + o), x1 = *(const f32x4*)(out + o + 4), g0 = *(const f32x4*)g, g1 = *(const f32x4*)(g + 4), c0 = *(const f32x4*)(b2 + col), c1 = *(const f32x4*)(b2 + col + 4);
        *(f32x4*)(out + o) = x0 * ALPHA + g0 * (v0 + c0); *(f32x4*)(out + o + 4) = x1 * ALPHA + g1 * (v1 + c1); } };

template <class F> __device__ __forceinline__ void run_gemm(LAS unsigned char* lds, const h16* A, const h16* Bt, int N, int K, const F& f, int gsz = -1, int gidx = -1) {
    asm volatile("" : "+s"(N), "+s"(K));
    if (gsz < 0) { gsz = (int)gridDim.x; gidx = (int)blockIdx.x; }
    pg8::Gemm g{(const pg8::bf16_t*)A, (const pg8::bf16_t*)Bt, M, N, K}; pg8::StaticOrder S; S.init(M, N, gsz, gidx);
    EpiGen<F> E{f};
    pg8::gemm_phase<EpiGen<F>, pg8::StaticOrder, true, true>(lds, g, S, E);
}

__device__ __forceinline__ void p0_transpose_item(const float* W, int K, int N, h16* WT, LAS float* scr, int item, int lane) {
    const int nblk = N / 32, kb = item / nblk, nb = item % nblk, k0 = 64 * kb, n0 = 32 * nb;
#pragma unroll 8
    for (int i = 0; i < 32; ++i) { const int kk = 2 * i + (lane >> 5); scr[kk * 33 + (lane & 31)] = W[(size_t)(k0 + kk) * N + n0 + (lane & 31)]; }
    LDS_WAIT(); asm volatile("" ::: "memory");
    const int c = lane & 7;
#pragma unroll
    for (int j = 0; j < 4; ++j) { const int n = (lane >> 3) + 8 * j; const LAS float* s = scr + (8 * c) * 33 + n;
        u32x4 o; o.x = pkh(s[0 * 33], s[1 * 33]); o.y = pkh(s[2 * 33], s[3 * 33]); o.z = pkh(s[4 * 33], s[5 * 33]); o.w = pkh(s[6 * 33], s[7 * 33]);
        *(u32x4*)(WT + (size_t)(n0 + n) * K + k0 + 8 * c) = o; }
    LDS_WAIT(); asm volatile("" ::: "memory");
}
__device__ __forceinline__ void phase0(const P& p, LAS unsigned char* lds, int tid, int lane, int wave) {
    LAS float* scr = (LAS float*)(lds + wave * 16384);
    const int G = gridDim.x, gw = blockIdx.x * 8 + wave, NGW = G * 8;
    constexpr int I_IN = (D / 64) * (DIN / 32), I_BA = (DH / 64) * (D / 32), I_OUT = (D / 64) * (D / 32), I_1 = (D / 64) * (DFF / 32), I_2 = (DFF / 64) * (D / 32);
    constexpr int NITEMS = I_IN + 2 * I_BA + I_OUT + I_1 + I_2;
    for (int it = gw; it < NITEMS; it += NGW) {
        int r = it;
        if (r < I_IN) { p0_transpose_item(p.w_in, D, DIN, p.win_t, scr, r, lane); continue; } r -= I_IN;
        if (r < I_BA) { p0_transpose_item(p.wba, DH, D, p.wba_t, scr, r, lane); continue; } r -= I_BA;
        if (r < I_BA) { p0_transpose_item(p.wbb, DH, D, p.wbb_t, scr, r, lane); continue; } r -= I_BA;
        if (r < I_OUT) { p0_transpose_item(p.wout, D, D, p.wout_t, scr, r, lane); continue; } r -= I_OUT;
        if (r < I_1) { p0_transpose_item(p.w1, D, DFF, p.w1_t, scr, r, lane); continue; } r -= I_1;
        p0_transpose_item(p.wf2, DFF, D, p.w2_t, scr, r, lane);
    }
    for (int idx = blockIdx.x * 512 + tid; idx < DLO * 256; idx += G * 512) {
        const int n = idx >> 8, k = idx & 255; float v = 0.f;
        if (n < 512) { if (k < 64) v = p.w2[k * 512 + n]; }
        else if (n < 1024) { if (k >= 64 && k < 128) v = p.a2[(k - 64) * 512 + n - 512]; }
        else { if (k >= 128) v = p.g2[(k - 128) * 512 + n - 1024]; }
        p.wlora_t[idx] = (h16)v;
    }
    for (int u = blockIdx.x; u < 192; u += G) {
        const int slice = u / 12, n = (u % 12) * 512 + tid; float a0 = 0.f, a1 = 0.f;
#pragma unroll 8
        for (int kk = 0; kk < 64; ++kk) { const int k = slice * 64 + kk; const float c0 = p.c[k], c1 = p.c[1024 + k], w = p.w_ada[(size_t)k * 6144 + n];
            a0 += c0 * sigmoidf_(c0) * w; a1 += c1 * sigmoidf_(c1) * w; }
        p.adap[(slice * 2 + 0) * 6144 + n] = a0; p.adap[(slice * 2 + 1) * 6144 + n] = a1;
    }
}
__device__ __forceinline__ void phase0b(const P& p, LAS unsigned char* lds, int tid, int lane, int wave) {
    LAS float* mod = (LAS float*)lds;
    for (int i = tid; i < 4096; i += 512) { const int b = i >> 11, j = i & 2047; float s = p.b_ada[j];
#pragma unroll
        for (int sl = 0; sl < 16; ++sl) s += p.adap[(sl * 2 + b) * 6144 + j];
        mod[i] = s; }
    if (blockIdx.x == 0) for (int i = tid; i < 2 * 6144; i += 512) { const int b = i / 6144, j = i % 6144; float s = p.b_ada[j];
#pragma unroll
        for (int sl = 0; sl < 16; ++sl) s += p.adap[(sl * 2 + b) * 6144 + j];
        p.ada[i] = s; }
    __syncthreads();
    const int gw = blockIdx.x * 8 + wave, NGW = gridDim.x * 8;
    for (int m = gw; m < M; m += NGW) {
        const f32x4* xr = (const f32x4*)(p.x + (size_t)m * D) + lane; const int b = m >> 13;
        f32x4 v[4]; float s = 0.f;
#pragma unroll
        for (int j = 0; j < 4; ++j) { v[j] = xr[64 * j]; s += (v[j].x + v[j].y) + (v[j].z + v[j].w); }
        const float mean = wave_sum(s) * (1.f / D); float s2 = 0.f;
#pragma unroll
        for (int j = 0; j < 4; ++j) { v[j] = v[j] - mean; s2 += (v[j].x * v[j].x + v[j].y * v[j].y) + (v[j].z * v[j].z + v[j].w * v[j].w); }
        const float rstd = 1.f / sqrtf(wave_sum(s2) * (1.f / D) + ADA_EPS);
        uint2* o8 = (uint2*)(p.h + (size_t)m * D) + lane;
#pragma unroll
        for (int j = 0; j < 4; ++j) { const int col = 4 * (lane + 64 * j); const f32x4 sh = *(const LAS f32x4*)(mod + b * 2048 + col), sc = *(const LAS f32x4*)(mod + b * 2048 + 1024 + col);
            const f32x4 r = v[j] * rstd * (sc + 1.0f) + sh; uint2 w; w.x = pkh(r.x, r.y); w.y = pkh(r.z, r.w); o8[64 * j] = w; }
    }
}
__device__ __forceinline__ void phase2(const P& p, int tid) {
    for (int idx = blockIdx.x * 512 + tid; idx < M * 32; idx += gridDim.x * 512) {
        const int t = idx >> 5, j8 = (idx & 31) * 8, col = 1536 + j8;
        f32x4 c0, c1, q0 = {0.f, 0.f, 0.f, 0.f}, q1 = {0.f, 0.f, 0.f, 0.f};
        load8h(p.zrw + (size_t)t * DRW + col, c0, c1); if (t & (SEQ - 1)) load8h(p.zrw + (size_t)(t - 1) * DRW + col, q0, q1);
        const f32x4 m0 = *(const f32x4*)(p.mu + col), m1 = *(const f32x4*)(p.mu + col + 4);
        c0 = c0 + m0 * (q0 - c0); c1 = c1 + m1 * (q1 - c1);
#pragma unroll
        for (int i = 0; i < 4; ++i) { if (j8 < 64) { c0[i] = tanhf(c0[i]); c1[i] = tanhf(c1[i]); } else if (j8 >= 128) { c0[i] = sigmoidf_(c0[i]); c1[i] = sigmoidf_(c1[i]); } }
        store8h(p.lin + (size_t)t * 256 + j8, c0, c1);
    }
}
constexpr int P64 = 72, P32 = 40;
constexpr int L_AM = 0, L_BM = 4608, L_KM = 9216, L_RM = 13824, L_AMT = 18432, L_BMT = 23552, L_KMT = 28672, L_VT = 33792, L_NR0 = 38912, L_NR1 = 41472, L_NT0 = 44032, L_NT1 = 46592,
              L_TR0 = 49152, L_TR1 = 51712, L_AAK = 54272, L_ARB = 56832, L_ARK = 59392, L_W1T = 61952, L_UT = 67072, L_TAT = 72192, L_CUM = 77312, L_GM = 85504, L_GL = 85760;
__device__ __forceinline__ int crow(int r, int hi) { return (r & 3) + 8 * (r >> 2) + 4 * hi; }
template <int KS> __device__ __forceinline__ f32x16 mm_tile(LAS unsigned char* A, int arow, int apitch, LAS unsigned char* B, int brow, int bpitch, f32x16 acc, int hi) {
#pragma unroll
    for (int s = 0; s < KS; ++s) { const h16x8 a = *(const LAS h16x8*)(A + (arow * apitch + 16 * s + 8 * hi) * 2), b = *(const LAS h16x8*)(B + (brow * bpitch + 16 * s + 8 * hi) * 2);
        acc = __builtin_amdgcn_mfma_f32_32x32x16_f16(a, b, acc, 0, 0, 0); }
    return acc;
}
__device__ __forceinline__ void wr_row(LAS unsigned char* arr, const f32x16& v, int n, int hi) {
#pragma unroll
    for (int r = 0; r < 16; ++r) ((LAS h16*)arr)[crow(r, hi) * P32 + n] = (h16)v[r];
}
__device__ __forceinline__ void wr_tr(LAS unsigned char* arr, const f32x16& v, int nrow, int hi) {
#pragma unroll
    for (int jj = 0; jj < 4; ++jj) { u32x2 w; w.x = pkh(v[4 * jj], v[4 * jj + 1]); w.y = pkh(v[4 * jj + 2], v[4 * jj + 3]); *(LAS u32x2*)(arr + (nrow * P32 + 8 * jj + 4 * hi) * 2) = w; }
}
__device__ __forceinline__ f32x16 zero16() { f32x16 z;
#pragma unroll
    for (int r = 0; r < 16; ++r) z[r] = 0.f;
    return z; }
__device__ __forceinline__ void pre_unit(const P& p, LAS unsigned char* sm, int unit, int tid, int lane, int wave) {
    const int bh = unit >> 8, c = unit & 255, b = bh >> 3, h = bh & 7, r32 = lane & 31, hi = lane >> 5, col = h * 64 + lane;
    LAS float* CUM = (LAS float*)(sm + L_CUM); LAS float* GM = (LAS float*)(sm + L_GM); LAS float* GL = (LAS float*)(sm + L_GL);
    const float mu_r = p.mu[col], mu_k = p.mu[512 + col], mu_v = p.mu[1024 + col], ckk = p.kk[col], cka = p.ka[col], crk = p.rk[col], cw0 = p.w0[col], ca0 = p.a0[col];
    float av[4], bv[4], kv[4], rv[4], vv[4], lwv[4];
#pragma unroll
    for (int i = 0; i < 4; ++i) {
        const int tt = wave * 4 + i, t = c * 32 + tt; const size_t gm = (size_t)b * SEQ + t;
        const h16* zr = p.zrw + gm * DRW; const h16* lo = p.lout + gm * DLO;
        float r = (float)zr[col], k = (float)zr[512 + col], v = (float)zr[1024 + col], rp = 0.f, kp = 0.f, vp = 0.f;
        if (t > 0) { rp = (float)zr[col - DRW]; kp = (float)zr[512 + col - DRW]; vp = (float)zr[1024 + col - DRW]; }
        r += mu_r * (rp - r); k += mu_k * (kp - k); v += mu_v * (vp - v);
        const float xw = -(cw0 + (float)lo[col]), spw = fmaxf(xw, 0.f) + __logf(1.f + __expf(-fabsf(xw))), ar = sigmoidf_(ca0 + (float)lo[512 + col]);
        const float lw = -__expf(-spw - 0.5f);
        const float kkv = k * ckk, nrm = sqrtf(wave_sum(kkv * kkv)), kkn = kkv / fmaxf(nrm, 1e-12f);
        const float k2 = k * (1.0f + (ar - 1.0f) * cka), bon = wave_sum(r * k2 * crk);
        if (lane == 0) p.bon[gm * 8 + h] = bon;
        av[i] = -kkn; bv[i] = kkn * ar; kv[i] = k2; rv[i] = r; vv[i] = v; lwv[i] = lw;
        CUM[tt * 64 + lane] = lw;
    }
    __syncthreads();
    if (tid < 64) { float s = 0.f, mid = 0.f;
#pragma unroll 8
        for (int t = 0; t < 32; ++t) { s += CUM[t * 64 + tid]; CUM[t * 64 + tid] = s; if (t == 15) mid = s; }
        GM[tid] = __expf(mid); GL[tid] = __expf(s); }
    __syncthreads();
    {   const float mid = CUM[15 * 64 + lane];
#pragma unroll
        for (int i = 0; i < 4; ++i) { const int tt = wave * 4 + i; const float cum = CUM[tt * 64 + lane], cp = cum - lwv[i];
            const float e1 = __expf(mid - cum);
            const h16 am = (h16)(av[i] * __expf(cp - mid)), bm = (h16)(bv[i] * e1), km = (h16)(kv[i] * e1), rm = (h16)(rv[i] * __expf(cum - mid));
            ((LAS h16*)(sm + L_AM))[tt * P64 + lane] = am; ((LAS h16*)(sm + L_BM))[tt * P64 + lane] = bm; ((LAS h16*)(sm + L_KM))[tt * P64 + lane] = km; ((LAS h16*)(sm + L_RM))[tt * P64 + lane] = rm;
            ((LAS h16*)(sm + L_AMT))[lane * P32 + tt] = am; ((LAS h16*)(sm + L_BMT))[lane * P32 + tt] = bm; ((LAS h16*)(sm + L_KMT))[lane * P32 + tt] = km; ((LAS h16*)(sm + L_VT))[lane * P32 + tt] = (h16)vv[i]; }
    }
    __syncthreads();
    if (wave < 4) {
        f32x16 acc = mm_tile<4>(sm + (wave < 2 ? L_AM : L_RM), r32, P64, sm + ((wave & 1) ? L_KM : L_BM), r32, P64, zero16(), hi);
#pragma unroll
        for (int r = 0; r < 16; ++r) { const int t = crow(r, hi); const bool keep = (wave < 2) ? (r32 < t) : (r32 <= t); acc[r] = keep ? acc[r] : 0.f; }
        if (wave == 0) {
            wr_row(sm + L_NR0, acc, r32, hi); wr_tr(sm + L_NT0, acc, r32, hi);
            f32x16 tacc = acc;
#pragma unroll
            for (int r = 0; r < 16; ++r) if (crow(r, hi) == r32) tacc[r] += 1.0f;
            wr_row(sm + L_TR0, tacc, r32, hi);
#pragma unroll
            for (int i = 0; i < 4; ++i) {
                LAS unsigned char* nr = sm + ((i & 1) ? L_NR1 : L_NR0); LAS unsigned char* nt = sm + ((i & 1) ? L_NT1 : L_NT0);
                LAS unsigned char* nr2 = sm + ((i & 1) ? L_NR0 : L_NR1); LAS unsigned char* nt2 = sm + ((i & 1) ? L_NT0 : L_NT1);
                LAS unsigned char* tr = sm + ((i & 1) ? L_TR1 : L_TR0); LAS unsigned char* tr2 = sm + ((i & 1) ? L_TR0 : L_TR1);
                const f32x16 nacc = mm_tile<2>(nr, r32, P32, nt, r32, P32, zero16(), hi);
                wr_row(nr2, nacc, r32, hi); wr_tr(nt2, nacc, r32, hi);
                tacc = mm_tile<2>(tr, r32, P32, nt2, r32, P32, tacc, hi);
                wr_row(tr2, tacc, r32, hi);
            }
        } else if (wave == 1) {
            wr_row(sm + L_AAK, acc, r32, hi);
#pragma unroll
            for (int vt = 0; vt < 2; ++vt) { const f32x16 w1 = mm_tile<2>(sm + L_AAK, r32, P32, sm + L_VT, 32 * vt + r32, P32, zero16(), hi); wr_tr(sm + L_W1T, w1, 32 * vt + r32, hi); }
        } else if (wave == 2) wr_row(sm + L_ARB, acc, r32, hi);
        else wr_row(sm + L_ARK, acc, r32, hi);
    }
    __syncthreads();
    if (wave < 2) { const f32x16 u = mm_tile<2>(sm + L_TR0, r32, P32, sm + L_W1T, 32 * wave + r32, P32, zero16(), hi); wr_tr(sm + L_UT, u, 32 * wave + r32, hi); }
    else if (wave < 4) { const f32x16 ta = mm_tile<2>(sm + L_TR0, r32, P32, sm + L_AMT, 32 * (wave - 2) + r32, P32, zero16(), hi); wr_tr(sm + L_TAT, ta, 32 * (wave - 2) + r32, hi); }
    __syncthreads();
    if (wave < 4) {
        const int kt = wave >> 1, mt = wave & 1, k = 32 * mt + r32;
        const f32x16 x = mm_tile<2>(sm + L_TAT, 32 * kt + r32, P32, sm + L_BMT, k, P32, zero16(), hi);
        const float gl = GL[k], f1 = gl / GM[k]; float pv[16];
#pragma unroll
        for (int r = 0; r < 16; ++r) { const int k2 = 32 * kt + crow(r, hi); pv[r] = f1 * x[r] * GM[k2] + (k2 == k ? gl : 0.f); }
        u32x4 w0, w1; w0.x = pkh(pv[0], pv[1]); w0.y = pkh(pv[2], pv[3]); w0.z = pkh(pv[4], pv[5]); w0.w = pkh(pv[6], pv[7]); w1.x = pkh(pv[8], pv[9]); w1.y = pkh(pv[10], pv[11]); w1.z = pkh(pv[12], pv[13]); w1.w = pkh(pv[14], pv[15]);
        u32x4* dst = (u32x4*)p.pbuf + (size_t)unit * 512 + (mt * 4 + 2 * kt) * 64 + lane;
        dst[0] = w0; dst[64] = w1;
    } else if (wave < 6) {
        const int kt = wave - 4;
        const f32x16 x = mm_tile<2>(sm + L_TAT, 32 * kt + r32, P32, sm + L_ARB, r32, P32, zero16(), hi);
        float pv[16];
#pragma unroll
        for (int r = 0; r < 16; ++r) { const int k2 = 32 * kt + crow(r, hi); pv[r] = (x[r] + (float)((LAS h16*)(sm + L_RM))[r32 * P64 + k2]) * GM[k2]; }
        u32x4 w0, w1; w0.x = pkh(pv[0], pv[1]); w0.y = pkh(pv[2], pv[3]); w0.z = pkh(pv[4], pv[5]); w0.w = pkh(pv[6], pv[7]); w1.x = pkh(pv[8], pv[9]); w1.y = pkh(pv[10], pv[11]); w1.z = pkh(pv[12], pv[13]); w1.w = pkh(pv[14], pv[15]);
        u32x4* dst = (u32x4*)p.rbuf + (size_t)unit * 256 + (2 * kt) * 64 + lane;
        dst[0] = w0; dst[64] = w1;
    } else {
        const int vt = wave - 6;
        f32x16 y = mm_tile<2>(sm + L_ARB, r32, P32, sm + L_UT, 32 * vt + r32, P32, zero16(), hi);
        y = mm_tile<2>(sm + L_ARK, r32, P32, sm + L_VT, 32 * vt + r32, P32, y, hi);
        h16* dst = p.ya + ((size_t)b * SEQ + c * 32) * DH + h * 64 + 32 * vt + r32;
#pragma unroll
        for (int r = 0; r < 16; ++r) dst[(size_t)crow(r, hi) * DH] = (h16)y[r];
    }
    if (wave >= 4) {
        const int mt = (wave - 4) >> 1, vt = (wave - 4) & 1;
        f32x16 q = mm_tile<2>(sm + L_BMT, 32 * mt + r32, P32, sm + L_UT, 32 * vt + r32, P32, zero16(), hi);
        q = mm_tile<2>(sm + L_KMT, 32 * mt + r32, P32, sm + L_VT, 32 * vt + r32, P32, q, hi);
        unsigned qw[8];
#pragma unroll
        for (int r2 = 0; r2 < 8; ++r2) { const int k0 = 32 * mt + crow(2 * r2, hi), k1 = 32 * mt + crow(2 * r2 + 1, hi);
            qw[r2] = pkh(q[2 * r2] * (GL[k0] / GM[k0]), q[2 * r2 + 1] * (GL[k1] / GM[k1])); }
        u32x4* dst = (u32x4*)(p.qbuf + (size_t)unit * 2048 + ((vt * 2 + mt) * 64 + lane) * 8);
        dst[0] = (u32x4){qw[0], qw[1], qw[2], qw[3]}; dst[1] = (u32x4){qw[4], qw[5], qw[6], qw[7]};
    }
    __syncthreads();
}
__device__ __forceinline__ float h_lo(unsigned w) { return (float)__builtin_bit_cast(h16x2, w)[0]; }
__device__ __forceinline__ float h_hi(unsigned w) { return (float)__builtin_bit_cast(h16x2, w)[1]; }
struct LdSet { u32x4 v[11]; };
__device__ __forceinline__ void chain_ld(LdSet& d, const unsigned char* pb, const unsigned char* qb, int grp, int lt) {
#pragma unroll
    for (int i = 0; i < 11; ++i) { const int idx = lt + i * 384; if (idx < 4096) { const int ch = idx >> 10, w = idx & 1023; const size_t u = (size_t)(grp * 4 + ch) * 8192;
        d.v[i] = *(const u32x4*)((w < 512 ? pb : qb - 8192) + u + (size_t)w * 16); } }
}
__device__ __forceinline__ void chain_st(const LdSet& d, LAS unsigned char* set, int lt) {
    LAS unsigned char* b = set + lt * 16;
#pragma unroll
    for (int i = 0; i < 10; ++i) *(LAS u32x4*)(b + i * 6144) = d.v[i];
    if (lt < 256) *(LAS u32x4*)(b + 10 * 6144) = d.v[10];
}
__device__ __forceinline__ void chain_group(LAS unsigned char* pbase, LAS unsigned char* qbase, f32x16& c0, f32x16& c1, u32x4* sdst) {
#pragma unroll
    for (int cc = 0; cc < 4; ++cc) {
        h16x8 pa[8]; u32x4 q[4];
#pragma unroll
        for (int i = 0; i < 8; ++i) pa[i] = *(const LAS h16x8*)(pbase + cc * 16384 + i * 1024);
#pragma unroll
        for (int i = 0; i < 4; ++i) q[i] = *(const LAS u32x4*)(qbase + cc * 16384 + (i >> 1) * 2048 + (i & 1) * 16);
        h16x8 bs[4];
#pragma unroll
        for (int e = 0; e < 8; ++e) { bs[0][e] = (h16)c0[e]; bs[1][e] = (h16)c0[8 + e]; bs[2][e] = (h16)c1[e]; bs[3][e] = (h16)c1[8 + e]; }
#pragma unroll
        for (int s = 0; s < 4; ++s) sdst[cc * 512 + s * 64] = __builtin_bit_cast(u32x4, bs[s]);
        f32x16 n0, n1;
#pragma unroll
        for (int w = 0; w < 4; ++w) { n0[2 * w] = h_lo(q[0][w]); n0[2 * w + 1] = h_hi(q[0][w]); n0[8 + 2 * w] = h_lo(q[1][w]); n0[8 + 2 * w + 1] = h_hi(q[1][w]);
                                      n1[2 * w] = h_lo(q[2][w]); n1[2 * w + 1] = h_hi(q[2][w]); n1[8 + 2 * w] = h_lo(q[3][w]); n1[8 + 2 * w + 1] = h_hi(q[3][w]); }
#pragma unroll
        for (int s = 0; s < 4; ++s) { n0 = __builtin_amdgcn_mfma_f32_32x32x16_f16(pa[s], bs[s], n0, 0, 0, 0); n1 = __builtin_amdgcn_mfma_f32_32x32x16_f16(pa[4 + s], bs[s], n1, 0, 0, 0); }
        c0 = n0; c1 = n1;
        asm volatile("" ::: "memory");
    }
}
__device__ __forceinline__ void chain_block(const P& p, LAS unsigned char* sm, int bh, int tid, int lane, int wave) {
    const unsigned char* pb = (const unsigned char*)p.pbuf + (size_t)bh * 256 * 8192;
    const unsigned char* qb = (const unsigned char*)p.qbuf + (size_t)bh * 256 * 8192;
    const int lt = tid - 128;
#define CH_BAR() asm volatile("s_waitcnt lgkmcnt(0)\n\ts_barrier" ::: "memory")
    if (wave >= 2) {
        LdSet A, B;
        chain_ld(A, pb, qb, 0, lt); chain_ld(B, pb, qb, 1, lt); chain_st(A, sm, lt); chain_ld(A, pb, qb, 2, lt);
        CH_BAR();
        for (int g = 0; g < 64; g += 2) {
            chain_st(B, sm + 65536, lt); if (g + 3 < 64) chain_ld(B, pb, qb, g + 3, lt);
            CH_BAR();
            if (g + 2 < 64) { chain_st(A, sm, lt); if (g + 4 < 64) chain_ld(A, pb, qb, g + 4, lt); }
            CH_BAR();
        }
    } else {
        f32x16 c0 = zero16(), c1 = zero16();
        u32x4* sbase = (u32x4*)p.qbuf + (size_t)bh * 256 * 512 + wave * 256 + lane;
        LAS unsigned char* pbase = sm + lane * 16; LAS unsigned char* qbase = sm + 8192 + (wave * 128 + lane) * 32;
        CH_BAR();
        for (int g = 0; g < 64; g += 2) {
            chain_group(pbase, qbase, c0, c1, sbase + (size_t)(g * 4) * 512);
            CH_BAR();
            chain_group(pbase + 65536, qbase + 65536, c0, c1, sbase + (size_t)((g + 1) * 4) * 512);
            CH_BAR();
        }
    }
#undef CH_BAR
    __syncthreads();
}
__device__ __forceinline__ void phase2v(const P& p, LAS unsigned char* lds, int tid) {
    for (int tile = blockIdx.x; tile < 256; tile += gridDim.x) {
        const int b = tile >> 7, tl = tile & 127; const size_t m0 = (size_t)b * SEQ + tl * 64;
#pragma unroll
        for (int i = 0; i < 8; ++i) { const int idx = tid + i * 512, key = idx >> 6, ch = idx & 63; *(LAS u32x4*)(lds + key * 1040 + ch * 16) = *(const u32x4*)(p.qkv + (m0 + key) * DQKV + 1024 + ch * 8); }
        __syncthreads();
#pragma unroll
        for (int i = 0; i < 8; ++i) { const int o = tid + i * 512, h = o >> 9, g = (o >> 6) & 7, d = o & 63, ks = g >> 1, hk = g & 1; unsigned short e[8];
#pragma unroll
            for (int j = 0; j < 8; ++j) e[j] = ((const LAS unsigned short*)lds)[(16 * ks + 8 * (j >> 2) + 4 * hk + (j & 3)) * 520 + h * 64 + d];
            u32x4 w; w.x = e[0] | ((unsigned)e[1] << 16); w.y = e[2] | ((unsigned)e[3] << 16); w.z = e[4] | ((unsigned)e[5] << 16); w.w = e[6] | ((unsigned)e[7] << 16);
            ((u32x4*)p.vt)[((((size_t)(b * 8 + h) * 128 + tl) * 8 + g) * 64 + d)] = w; }
        __syncthreads();
    }
}
struct KVF { h16x8 k[8]; u32x4 v[8]; };
__device__ __forceinline__ void attn_ld(KVF& f, const h16* kbase, const u32x4* vtb, int jt) {
    const h16* kp = kbase + (size_t)(jt * 64) * DQKV;
#pragma unroll
    for (int d0 = 0; d0 < 4; ++d0) { f.k[2 * d0] = *(const h16x8*)(kp + d0 * 16); f.k[2 * d0 + 1] = *(const h16x8*)(kp + (size_t)32 * DQKV + d0 * 16); }
    const u32x4* vp = vtb + (size_t)jt * 512;
#pragma unroll
    for (int ks = 0; ks < 4; ++ks) { f.v[2 * ks] = vp[ks * 128]; f.v[2 * ks + 1] = vp[ks * 128 + 32]; }
}
__device__ __forceinline__ void attn_wave_unit(const P& p, int unit, int lane) {
    const int bh = unit >> 8, qblk = unit & 255, b = bh >> 3, h = bh & 7, qw0 = qblk * 32, r32 = lane & 31, hi = lane >> 5, qabs = qw0 + r32;
    const h16* base = p.qkv + (size_t)b * SEQ * DQKV + h * 64;
    const h16* kbase = base + 512 + (size_t)r32 * DQKV + hi * 8;
    const u32x4* vtb = (const u32x4*)p.vt + (size_t)bh * 128 * 512 + hi * 64 + r32;
    h16x8 qf[4];
#pragma unroll
    for (int d0 = 0; d0 < 4; ++d0) qf[d0] = *(const h16x8*)(base + (size_t)(qw0 + r32) * DQKV + d0 * 16 + hi * 8);
    f32x16 o0 = zero16(), o1 = zero16();
    float carry = 1.f;
    KVF cur, nxt;
    int jt = (qw0 + 31) >> 6;
    attn_ld(cur, kbase, vtb, jt);
    for (; jt >= 0; --jt) {
        const int k0 = jt * 64;
        if (jt > 0) attn_ld(nxt, kbase, vtb, jt - 1);
        f32x16 p0 = zero16(), p1 = zero16();
#pragma unroll
        for (int d0 = 0; d0 < 4; ++d0) { p0 = __builtin_amdgcn_mfma_f32_32x32x16_f16(cur.k[2 * d0], qf[d0], p0, 0, 0, 0); p1 = __builtin_amdgcn_mfma_f32_32x32x16_f16(cur.k[2 * d0 + 1], qf[d0], p1, 0, 0, 0); }
        float M0[16], M1[16];
#pragma unroll
        for (int r = 0; r < 16; ++r) { const int key = k0 + crow(r, hi);
            const float m0 = __builtin_amdgcn_rcpf(1.f + __builtin_amdgcn_exp2f(p0[r])), m1 = __builtin_amdgcn_rcpf(1.f + __builtin_amdgcn_exp2f(p1[r]));
            M0[r] = (key < qabs) ? m0 : 1.f; M1[r] = (key + 32 < qabs) ? m1 : 1.f; }
        float Gs[8], PG[8], sgo[8];
#pragma unroll
        for (int j = 0; j < 4; ++j) { Gs[j] = (M0[4 * j] * M0[4 * j + 1]) * (M0[4 * j + 2] * M0[4 * j + 3]); Gs[4 + j] = (M1[4 * j] * M1[4 * j + 1]) * (M1[4 * j + 2] * M1[4 * j + 3]); }
#pragma unroll
        for (int j = 0; j < 8; ++j) PG[j] = __shfl_xor(Gs[j], 32);
        float run = 1.f;
#pragma unroll
        for (int j = 7; j >= 0; --j) { const float ev = hi ? PG[j] : Gs[j], od = hi ? Gs[j] : PG[j]; const float so = run; run *= od; const float se = run; run *= ev; sgo[j] = hi ? so : se; }
        h16x8 pa[4];
#pragma unroll
        for (int j = 0; j < 4; ++j) {
            float acc = carry * sgo[j], acc1 = carry * sgo[4 + j];
#pragma unroll
            for (int i = 3; i >= 0; --i) { const int r = 4 * j + i;
                const float a0 = acc * (1.f - M0[r]); acc *= M0[r];
                const float a1 = acc1 * (1.f - M1[r]); acc1 *= M1[r];
                pa[j >> 1][(j & 1) * 4 + i] = (h16)a0; pa[2 + (j >> 1)][(j & 1) * 4 + i] = (h16)a1; }
        }
        carry *= run;
#pragma unroll
        for (int ks = 0; ks < 4; ++ks) { o0 = __builtin_amdgcn_mfma_f32_32x32x16_f16(pa[ks], __builtin_bit_cast(h16x8, cur.v[2 * ks]), o0, 0, 0, 0); o1 = __builtin_amdgcn_mfma_f32_32x32x16_f16(pa[ks], __builtin_bit_cast(h16x8, cur.v[2 * ks + 1]), o1, 0, 0, 0); }
        if (__all(carry < 1.1754944e-38f)) break;
        cur = nxt;
    }
    h16* ob = p.ob + ((size_t)b * SEQ + qw0) * DH + h * 64;
#pragma unroll
    for (int r = 0; r < 16; ++r) { const int q = crow(r, hi); ob[(size_t)q * DH + r32] = (h16)o0[r]; ob[(size_t)q * DH + 32 + r32] = (h16)o1[r]; }
}
__device__ __forceinline__ void phase4b(const P& p, LAS unsigned char* lds, int lane, int wave) {
    const int gw = blockIdx.x * 8 + wave, NGW = gridDim.x * 8, r32 = lane & 31, hi = lane >> 5;
    LAS float* yt = (LAS float*)(lds + wave * 8448);
    for (int unit = gw; unit < NPRE; unit += NGW) {
        const int bh = unit >> 8, c = unit & 255, b = bh >> 3, h = bh & 7; const size_t tok0 = (size_t)b * SEQ + c * 32;
        h16x8 ra[4];
#pragma unroll
        for (int s = 0; s < 4; ++s) ra[s] = __builtin_bit_cast(h16x8, ((const u32x4*)p.rbuf)[(size_t)unit * 256 + s * 64 + lane]);
#pragma unroll
        for (int vt = 0; vt < 2; ++vt) {
            const h16* yl = p.ya + tok0 * DH + h * 64 + 32 * vt + r32; f32x16 y;
#pragma unroll
            for (int r = 0; r < 16; ++r) y[r] = (float)yl[(size_t)crow(r, hi) * DH];
#pragma unroll
            for (int s = 0; s < 4; ++s) { const h16x8 sb = __builtin_bit_cast(h16x8, ((const u32x4*)p.qbuf)[(size_t)unit * 512 + vt * 256 + s * 64 + lane]); y = __builtin_amdgcn_mfma_f32_32x32x16_f16(ra[s], sb, y, 0, 0, 0); }
#pragma unroll
            for (int r = 0; r < 16; ++r) yt[crow(r, hi) * 66 + 32 * vt + r32] = y[r];
        }
        const int col = h * 64 + lane; const float gg = p.gn_g[col], gb = p.gn_b[col], muv = p.mu[1024 + col];
#pragma unroll 4
        for (int t = 0; t < 32; ++t) {
            const size_t gm = tok0 + t;
            const float y = yt[t * 66 + lane], mean = wave_sum(y) * (1.f / 64.f), d = y - mean, var = wave_sum(d * d) * (1.f / 64.f);
            const float gn = d * (1.0f / sqrtf(var + GN_EPS)) * gg + gb;
            float v = (float)p.zrw[gm * DRW + 1024 + col], vp = 0.f; if (c * 32 + t > 0) vp = (float)p.zrw[(gm - 1) * DRW + 1024 + col];
            v += muv * (vp - v);
            const float g = (float)p.lout[gm * DLO + 1024 + col], bon = p.bon[gm * 8 + h];
            p.ya[gm * DH + col] = (h16)((gn + bon * v) * g);
        }
    }
}
template <bool FINAL> __device__ __forceinline__ void phase_ln(const P& p, int lane, int wave) {
    const int gw = blockIdx.x * 8 + wave, NGW = gridDim.x * 8;
    const float* lg = FINAL ? p.ln2g : p.ln1g; const float* lb = FINAL ? p.ln2b : p.ln1b;
    for (int m = gw; m < M; m += NGW) {
        f32x4* xr = (f32x4*)(p.out + (size_t)m * D) + lane; const int b = m >> 13;
        f32x4 v[4]; float s = 0.f;
#pragma unroll
        for (int j = 0; j < 4; ++j) { v[j] = xr[64 * j]; s += (v[j].x + v[j].y) + (v[j].z + v[j].w); }
        float mean = wave_sum(s) * (1.f / D), s2 = 0.f;
#pragma unroll
        for (int j = 0; j < 4; ++j) { v[j] = v[j] - mean; s2 += (v[j].x * v[j].x + v[j].y * v[j].y) + (v[j].z * v[j].z + v[j].w * v[j].w); }
        float rstd = 1.f / sqrtf(wave_sum(s2) * (1.f / D) + LN_EPS);
        s = 0.f;
#pragma unroll
        for (int j = 0; j < 4; ++j) { const int col = 4 * (lane + 64 * j); v[j] = v[j] * rstd * *(const f32x4*)(lg + col) + *(const f32x4*)(lb + col); xr[64 * j] = v[j]; s += (v[j].x + v[j].y) + (v[j].z + v[j].w); }
        if (!FINAL) {
            mean = wave_sum(s) * (1.f / D); s2 = 0.f;
#pragma unroll
            for (int j = 0; j < 4; ++j) { v[j] = v[j] - mean; s2 += (v[j].x * v[j].x + v[j].y * v[j].y) + (v[j].z * v[j].z + v[j].w * v[j].w); }
            rstd = 1.f / sqrtf(wave_sum(s2) * (1.f / D) + ADA_EPS);
            uint2* o8 = (uint2*)(p.h + (size_t)m * D) + lane; const float* ad = p.ada + b * 6144;
#pragma unroll
            for (int j = 0; j < 4; ++j) { const int col = 4 * (lane + 64 * j); const f32x4 sh = *(const f32x4*)(ad + 3072 + col), sc = *(const f32x4*)(ad + 4096 + col);
                const f32x4 r = v[j] * rstd * (sc + 1.0f) + sh; uint2 w; w.x = pkh(r.x, r.y); w.y = pkh(r.z, r.w); o8[64 * j] = w; }
        }
    }
}

typedef __attribute__((address_space(4))) const unsigned char* kargp_t;
__device__ __forceinline__ void make_p(P& p) {
    kargp_t ka = (kargp_t)__builtin_amdgcn_kernarg_segment_ptr(); asm volatile("" : "+s"(ka));
    const float* const __attribute__((address_space(4)))* in = (const float* const __attribute__((address_space(4)))*)ka;
    p.x = in[0]; p.c = in[1]; p.w_ada = in[2]; p.b_ada = in[3]; p.w_in = in[4]; p.mu = in[5]; p.w0 = in[6]; p.w2 = in[7]; p.a0 = in[8]; p.a2 = in[9]; p.g2 = in[10];
    p.kk = in[11]; p.ka = in[12]; p.rk = in[13]; p.gn_g = in[14]; p.gn_b = in[15]; p.wba = in[16]; p.wbb = in[17]; p.wout = in[18]; p.ln1g = in[19]; p.ln1b = in[20];
    p.w1 = in[21]; p.b1 = in[22]; p.wf2 = in[23]; p.b2 = in[24]; p.ln2g = in[25]; p.ln2b = in[26];
    p.out = (float*)in[27]; unsigned char* ws = (unsigned char*)in[28]; p.ws = ws;
    p.ctl = (unsigned*)(ws + WS_CTL); p.adap = (float*)(ws + WS_ADAP); p.ada = (float*)(ws + WS_ADA); p.bon = (float*)(ws + WS_BON);
    p.win_t = (h16*)(ws + WS_WIN); p.wlora_t = (h16*)(ws + WS_WLORA); p.wba_t = (h16*)(ws + WS_WBA); p.wbb_t = (h16*)(ws + WS_WBB); p.wout_t = (h16*)(ws + WS_WOUT); p.w1_t = (h16*)(ws + WS_W1); p.w2_t = (h16*)(ws + WS_W2);
    p.h = (h16*)(ws + WS_H16); p.zrw = (h16*)(ws + WS_ZRW); p.qkv = (h16*)(ws + WS_QKV); p.lin = (h16*)(ws + WS_LIN); p.lout = (h16*)(ws + WS_LOUT); p.mrg = (h16*)(ws + WS_MRG); p.hid = (h16*)(ws + WS_HID);
    p.pbuf = (h16*)(ws + WS_PB); p.rbuf = (h16*)(ws + WS_RB); p.qbuf = (unsigned*)(ws + WS_QB); p.vt = (h16*)(ws + WS_H16); p.ya = (h16*)(ws + WS_H16); p.ob = (h16*)(ws + WS_H16 + 16 * MiB); p.gates = (h16*)p.out;
}
__global__ void __launch_bounds__(512, 2) mk_fwd(KArgs a) {
    extern __shared__ __attribute__((aligned(16))) unsigned char lds_raw[];
    LAS unsigned char* lds = (LAS unsigned char*)lds_raw;
    volatile LAS unsigned* MISC = (volatile LAS unsigned*)(lds + MISC_OFF);
    int tid = threadIdx.x, lane = tid & 63, wave = __builtin_amdgcn_readfirstlane(tid >> 6);
#define FRESH() do { tid = threadIdx.x; asm volatile("" : "+v"(tid)); lane = tid & 63; wave = __builtin_amdgcn_readfirstlane(tid >> 6); make_p(p); } while (0)
    P p; make_p(p);
    for (int u = tid; u < (LDS_BYTES - RING_BYTES) / 4; u += 512) ((LAS unsigned*)(lds + RING_BYTES))[u] = 0u;
    __syncthreads();
    XcdBarrier bar = xcd_barrier_post(p.ctl + CW_BAR, MISC + 8);
#define GRID_BAR() xcd_barrier(bar)

    FRESH();
    phase0(p, lds, tid, lane, wave);
    if (gridDim.x == 0x7fffffffu) cg::this_grid().sync();
    GRID_BAR();
    FRESH();
    phase0b(p, lds, tid, lane, wave);
    GRID_BAR();
    FRESH();
    run_gemm(lds, p.h, p.win_t, DIN, D, F1{p.zrw, p.qkv, p.gates});
    GRID_BAR();
    FRESH();
    phase2(p, tid);
    phase2v(p, lds, tid);
    GRID_BAR();
    FRESH();
    run_gemm(lds, p.lin, p.wlora_t, DLO, 256, F3{p.lout});
    GRID_BAR();
    for (;;) {
        unsigned u = 0; if (lane == 0) u = atomicAdd(p.ctl + CW_ATTQ, 1u);
        u = (unsigned)__builtin_amdgcn_readfirstlane((int)u);
        if (u >= (unsigned)NATT) break;
        attn_wave_unit(p, (int)u, lane);
    }
    GRID_BAR();
    FRESH();
    for (int u = (int)blockIdx.x; u < NPRE; u += (int)gridDim.x) pre_unit(p, lds, u, tid, lane, wave);
    GRID_BAR();
    FRESH();
    if ((int)blockIdx.x < NCHAINB) chain_block(p, lds, (int)blockIdx.x, tid, lane, wave);
    else run_gemm(lds, p.ob, p.wbb_t, D, DH, F5Y{p.gates}, (int)gridDim.x - NCHAINB, (int)blockIdx.x - NCHAINB);
    GRID_BAR();
    FRESH();
    phase4b(p, lds, lane, wave);
    GRID_BAR();
    FRESH();
    run_gemm(lds, p.ya, p.wba_t, D, DH, F5X{p.mrg, p.gates});
    GRID_BAR();
    FRESH();
    run_gemm(lds, p.mrg, p.wout_t, D, D, F6{p.x, p.out, p.ada});
    GRID_BAR();
    FRESH();
    phase_ln<false>(p, lane, wave);
    GRID_BAR();
    FRESH();
    run_gemm(lds, p.h, p.w1_t, DFF, D, F8{p.hid, p.b1});
    GRID_BAR();
    FRESH();
    run_gemm(lds, p.hid, p.w2_t, D, DFF, F9{p.out, p.ada, p.b2});
    GRID_BAR();
    FRESH();
    phase_ln<true>(p, lane, wave);
}

extern "C" void kernel_launch(void* const* d_in, const int* in_sizes, int n_in, void* d_out, int out_size, void* d_ws, size_t ws_size, hipStream_t stream) {
    static int grid = 0;
    if (grid == 0) {
        if (n_in != 27 || out_size != M * D || ws_size < WS_END) { fprintf(stderr, "kernel_launch: unexpected shapes (n_in %d, out %d, ws %zu)\n", n_in, out_size, ws_size); grid = -1; return; }
        int dev = 0, cus = 0, per_cu = 0;
        hipGetDevice(&dev); hipDeviceGetAttribute(&cus, hipDeviceAttributeMultiprocessorCount, dev);
        if (hipFuncSetAttribute((const void*)mk_fwd, hipFuncAttributeMaxDynamicSharedMemorySize, LDS_BYTES) != hipSuccess) { fprintf(stderr, "kernel_launch: hipFuncSetAttribute failed\n"); grid = -1; return; }
        hipOccupancyMaxActiveBlocksPerMultiprocessor(&per_cu, (const void*)mk_fwd, 512, LDS_BYTES);
        (void)hipGetLastError();
        if (per_cu < 1) fprintf(stderr, "kernel_launch: occupancy query says %d blocks per CU\n", per_cu);
        grid = cus;
    }
    if (grid < 0) return;
    hipMemsetAsync((char*)d_ws + WS_CTL, 0, CTL_ZERO_BYTES, stream);
    KArgs a{};
    for (int i = 0; i < 27; ++i) a.in[i] = (const float*)d_in[i];
    a.out = (float*)d_out; a.ws = (unsigned char*)d_ws;
    void* args[] = {&a};
    hipError_t e = hipLaunchCooperativeKernel((const void*)mk_fwd, dim3(grid), dim3(512), args, LDS_BYTES, stream);
    if (e != hipSuccess) fprintf(stderr, "cooperative launch failed: %s (grid %d)\n", hipGetErrorString(e), grid);
}
```

```cpp
#include <hip/hip_runtime.h>
#include <hip/hip_cooperative_groups.h>
#include <cstdio>
#include <cstdint>
namespace cg = cooperative_groups;
namespace pg8 {
#define PG8_LAS __attribute__((address_space(3)))
typedef unsigned short bf16_t;
typedef _Float16 bf16x8 __attribute__((ext_vector_type(8)));
typedef float f32x4 __attribute__((ext_vector_type(4)));
typedef unsigned u32x4 __attribute__((ext_vector_type(4)));
constexpr int BM = 256, BK = 64, HALF = 128, HTB = HALF * BK * 2  , STAGE_BYTES = 8 * HTB, NXCD = 8, WGM = 8;

__host__ __device__ __forceinline__ int lds_byte(int r, int c) { const int st = (r >> 4) * 2 + (c >> 5), rr = r & 15, cc = c & 31, ob = rr * 64 + cc * 2; return st * 1024 + (ob ^ (((ob >> 9) & 1) << 5)); }
__host__ __device__ __forceinline__ void stage_rc(int b, int& R, int& C) { const int st = b / 1024, sb = b % 1024, swz = sb ^ (((sb >> 9) & 1) << 5); R = (st >> 1) * 16 + swz / 64; C = (st & 1) * 32 + (swz % 64) / 2; }
__host__ __device__ __forceinline__ int perm32(int rho) { const int n = rho >> 4, i = rho & 15; return 8 * (i >> 2) + 4 * n + (i & 3); }

struct Unit { int pm, pn; };
struct Gemm { const bf16_t* A; const bf16_t* Bt; int M, N, K; };

struct StaticOrder {
    int nM, nN, nwg, G, c;
    __host__ __device__ void init(int M, int N, int G_, int c_) { nM = M / BM; nN = N / BM; nwg = nM * nN; G = G_; c = c_; }
    __host__ __device__ bool next(int i, Unit& u) const {
        const long L = (long)i * G + c; if (L >= nwg) return false;
        int wgid = (int)L; { const int q = nwg / NXCD, r = nwg % NXCD, xcd = wgid % NXCD, off = wgid / NXCD; wgid = (xcd < r ? xcd * (q + 1) : r * (q + 1) + (xcd - r) * q) + off; }
        const int nig = WGM * nN, gid = wgid / nig, fm = gid * WGM, gsz = (nM - fm) < WGM ? (nM - fm) : WGM;
        u.pm = fm + ((wgid % nig) % gsz); u.pn = (wgid % nig) / gsz; return true;
    }
    __device__ __forceinline__ void a_ready(const Unit&) const {}
    __device__ __forceinline__ void done(const Unit&) const {}
};
template <class Epi, class Sched, bool ALIGN_EPI = false, bool SP2 = false>
__device__ __forceinline__ void gemm_phase(PG8_LAS unsigned char* lds, const Gemm g, const Sched& S, const Epi& E) {
    int tid_ = threadIdx.x; asm volatile("" : "+v"(tid_)); const int tid = tid_, wid = __builtin_amdgcn_readfirstlane(tid >> 6), lane = tid & 63, wr = wid >> 2, wc = wid & 3, fr = lane & 15, fq = lane >> 4;
    const int K = g.K, nt = K / BK;
    unsigned voffA[2], voffB[2];
#pragma unroll
    for (int i = 0; i < 2; ++i) { int R, C; stage_rc(tid * 16 + i * 8192, R, C); const int Rb = Epi::PERM ? ((R & ~31) + perm32(R & 31)) : R;
        voffA[i] = (unsigned)(R * K + C) * 2u; voffB[i] = (unsigned)(Rb * K + C) * 2u; }
    const size_t kstep = (size_t)(BK * 2);
    const size_t hstep = (size_t)HALF * K * 2;
    const size_t tstep = 2 * hstep;
    const unsigned ldsw = (unsigned)wid * 1024u;
    const int aoff = lds_byte(wr * 64 + fr, fq * 8), boff = lds_byte(wc * 32 + fr, fq * 8);
#define PG8_SA(b, h) (((b) * 2 + (h)) * HTB)
#define PG8_SB(b, h) ((4 + (b) * 2 + (h)) * HTB)
#define PG8_STAGE(bufoff, gbase, voff) do { _Pragma("unroll") for (int _i = 0; _i < 2; ++_i) \
        __builtin_amdgcn_global_load_lds((const unsigned*)((const char*)(gbase) + (voff)[_i]), (PG8_LAS unsigned*)(lds + (bufoff) + ldsw + _i * 8192), 16, 0, 0); } while (0)
#define PG8_LDA(dst, b, h) do { _Pragma("unroll") for (int m = 0; m < 4; ++m) _Pragma("unroll") for (int k = 0; k < 2; ++k) dst[m][k] = *(const PG8_LAS bf16x8*)(lds + PG8_SA(b, h) + aoff + m * 2048 + k * 1024); } while (0)
#define PG8_LDB(dst, b, h) do { _Pragma("unroll") for (int n = 0; n < 2; ++n) _Pragma("unroll") for (int k = 0; k < 2; ++k) dst[n][k] = *(const PG8_LAS bf16x8*)(lds + PG8_SB(b, h) + boff + n * 2048 + k * 1024); } while (0)
#define PG8_MMA(ai, bj, At, Bt) do { __builtin_amdgcn_s_setprio(1); _Pragma("unroll") for (int m = 0; m < 4; ++m) _Pragma("unroll") for (int n = 0; n < 2; ++n) _Pragma("unroll") for (int k = 0; k < 2; ++k) \
        acc[ai][bj][m][n] = __builtin_amdgcn_mfma_f32_16x16x32_f16(Bt[n][k], At[m][k], acc[ai][bj][m][n], 0, 0, 0); __builtin_amdgcn_s_setprio(0); } while (0)
#define PG8_WAIT_V(n) asm volatile("s_waitcnt vmcnt(" #n ")" ::: "memory")
#define PG8_WAIT_L(n) asm volatile("s_waitcnt lgkmcnt(" #n ")" ::: "memory")
#define PG8_BAR __builtin_amdgcn_s_barrier()
#define PG8_SCHED __builtin_amdgcn_sched_barrier(0)
    Unit cur, nxt; int ui = 0;
    if (!S.next(0, cur)) return;
    f32x4 acc[2][2][4][2];
#pragma unroll
    for (int a = 0; a < 2; ++a)
#pragma unroll
        for (int b = 0; b < 2; ++b)
#pragma unroll
            for (int m = 0; m < 4; ++m)
#pragma unroll
                for (int n = 0; n < 2; ++n) acc[a][b][m][n] = (f32x4){0.f, 0.f, 0.f, 0.f};
    bf16x8 At[4][2], B0[2][2], B1[2][2];
    const char* cA = (const char*)g.A + (size_t)cur.pm * tstep; const char* cB = (const char*)g.Bt + (size_t)cur.pn * tstep;
    S.a_ready(cur);
    if constexpr (SP2) {
        PG8_STAGE(PG8_SB(0, 0), cB, voffB); PG8_STAGE(PG8_SB(0, 1), cB + hstep, voffB); PG8_STAGE(PG8_SA(0, 0), cA, voffA); PG8_STAGE(PG8_SA(0, 1), cA + hstep, voffA);
        if (wr == 1) PG8_BAR;
        PG8_WAIT_V(2); PG8_BAR;
        PG8_STAGE(PG8_SB(1, 0), cB + kstep, voffB); PG8_STAGE(PG8_SA(1, 0), cA + kstep, voffA); PG8_STAGE(PG8_SB(1, 1), cB + hstep + kstep, voffB);
        PG8_WAIT_V(6); PG8_BAR;
    } else {
        PG8_STAGE(PG8_SB(0, 0), cB, voffB); PG8_STAGE(PG8_SA(0, 0), cA, voffA); PG8_STAGE(PG8_SB(0, 1), cB + hstep, voffB); PG8_STAGE(PG8_SA(0, 1), cA + hstep, voffA);
        if (wr == 1) PG8_BAR;
        PG8_WAIT_V(4); PG8_BAR;
        PG8_STAGE(PG8_SB(1, 0), cB + kstep, voffB); PG8_STAGE(PG8_SA(1, 0), cA + kstep, voffA); PG8_STAGE(PG8_SB(1, 1), cB + hstep + kstep, voffB);
        PG8_WAIT_V(6); PG8_BAR;
    }
    for (;;) {
        const bool has_next = S.next(ui + 1, nxt);
        const char* nA = has_next ? (const char*)g.A + (size_t)nxt.pm * tstep : cA; const char* nB = has_next ? (const char*)g.Bt + (size_t)nxt.pn * tstep : cB;
        for (int t = 0; t < nt; t += 2) {
            const bool last = (t == nt - 2);
            const char* a1 = cA + (size_t)(t + 1) * kstep;
            const char* a2 = last ? nA : cA + (size_t)(t + 2) * kstep; const char* b2 = last ? nB : cB + (size_t)(t + 2) * kstep;
            const char* a3 = a2 + kstep; const char* b3 = b2 + kstep;
            if (last && has_next) S.a_ready(nxt);
            if constexpr (SP2) {
            PG8_LDB(B0, 0, 0); PG8_LDB(B1, 0, 1); PG8_SCHED; PG8_LDA(At, 0, 0); PG8_STAGE(PG8_SA(1, 1), a1 + hstep, voffA);
            PG8_WAIT_V(8); PG8_WAIT_L(0); PG8_BAR; PG8_MMA(0, 0, At, B0); PG8_MMA(0, 1, At, B1); PG8_BAR; PG8_SCHED;
            PG8_LDA(At, 0, 1); PG8_STAGE(PG8_SB(0, 0), b2, voffB); PG8_STAGE(PG8_SB(0, 1), b2 + hstep, voffB); PG8_STAGE(PG8_SA(0, 0), a2, voffA);
            PG8_WAIT_V(8); PG8_WAIT_L(0); PG8_BAR; PG8_MMA(1, 0, At, B0); PG8_MMA(1, 1, At, B1); PG8_BAR; PG8_SCHED;
            PG8_LDB(B0, 1, 0); PG8_LDB(B1, 1, 1); PG8_SCHED; PG8_LDA(At, 1, 0); PG8_STAGE(PG8_SA(0, 1), a2 + hstep, voffA);
            PG8_WAIT_V(8); PG8_WAIT_L(0); PG8_BAR; PG8_MMA(0, 0, At, B0); PG8_MMA(0, 1, At, B1); PG8_BAR; PG8_SCHED;
            PG8_LDA(At, 1, 1); PG8_STAGE(PG8_SB(1, 0), b3, voffB); PG8_STAGE(PG8_SB(1, 1), b3 + hstep, voffB); PG8_STAGE(PG8_SA(1, 0), a3, voffA);
            PG8_WAIT_V(8); PG8_WAIT_L(0); PG8_BAR; PG8_MMA(1, 0, At, B0); PG8_MMA(1, 1, At, B1); PG8_BAR; PG8_SCHED;
            } else {
            PG8_LDB(B0, 0, 0); PG8_SCHED; PG8_LDA(At, 0, 0); PG8_STAGE(PG8_SA(1, 1), a1 + hstep, voffA);
            PG8_WAIT_L(8); PG8_BAR; PG8_WAIT_L(0); PG8_MMA(0, 0, At, B0); PG8_BAR; PG8_SCHED;
            PG8_LDB(B1, 0, 1); PG8_STAGE(PG8_SB(0, 0), b2, voffB);
            PG8_BAR; PG8_WAIT_L(0); PG8_MMA(0, 1, At, B1); PG8_BAR;
            PG8_LDA(At, 0, 1); PG8_STAGE(PG8_SA(0, 0), a2, voffA);
            PG8_BAR; PG8_WAIT_L(0); PG8_MMA(1, 0, At, B0); PG8_BAR; PG8_SCHED;
            PG8_STAGE(PG8_SB(0, 1), b2 + hstep, voffB);
            PG8_WAIT_V(6); PG8_BAR; PG8_MMA(1, 1, At, B1); PG8_BAR;
            PG8_LDB(B0, 1, 0); PG8_SCHED; PG8_LDA(At, 1, 0); PG8_STAGE(PG8_SA(0, 1), a2 + hstep, voffA);
            PG8_WAIT_L(8); PG8_BAR; PG8_WAIT_L(0); PG8_MMA(0, 0, At, B0); PG8_BAR; PG8_SCHED;
            PG8_LDB(B1, 1, 1); PG8_STAGE(PG8_SB(1, 0), b3, voffB);
            PG8_BAR; PG8_WAIT_L(0); PG8_MMA(0, 1, At, B1); PG8_BAR;
            PG8_LDA(At, 1, 1); PG8_STAGE(PG8_SA(1, 0), a3, voffA);
            PG8_BAR; PG8_WAIT_L(0); PG8_MMA(1, 0, At, B0); PG8_BAR; PG8_SCHED;
            PG8_STAGE(PG8_SB(1, 1), b3 + hstep, voffB);
            PG8_WAIT_V(6); PG8_BAR; PG8_MMA(1, 1, At, B1); PG8_BAR;
            }
        }
        if constexpr (ALIGN_EPI) { if (wr == 0) PG8_BAR; }
        if constexpr (!Epi::AFTER_DRAIN) { E(acc, cur, wr, wc, fr, fq); S.done(cur); }
        if (!has_next) break;
#pragma unroll
        for (int a = 0; a < 2; ++a)
#pragma unroll
            for (int b = 0; b < 2; ++b)
#pragma unroll
                for (int m = 0; m < 4; ++m)
#pragma unroll
                    for (int n = 0; n < 2; ++n) acc[a][b][m][n] = (f32x4){0.f, 0.f, 0.f, 0.f};
        cur = nxt; cA = nA; cB = nB; ++ui;
        if constexpr (ALIGN_EPI) { if (wr == 1) PG8_BAR; }
    }
    PG8_WAIT_V(0);
    if constexpr (!ALIGN_EPI) { if (wr == 0) PG8_BAR; }
    PG8_BAR;
    if constexpr (Epi::AFTER_DRAIN) { E.fused(acc, cur, wr, wc, fr, fq, lds, wid, lane); S.done(cur); }
#undef PG8_SA
#undef PG8_SB
#undef PG8_STAGE
#undef PG8_LDA
#undef PG8_LDB
#undef PG8_MMA
#undef PG8_WAIT_V
#undef PG8_WAIT_L
#undef PG8_BAR
#undef PG8_SCHED
}
}
#define GAS __attribute__((address_space(1)))
#define LAS __attribute__((address_space(3)))
typedef unsigned short bf16;
typedef unsigned v4u __attribute__((ext_vector_type(4)));
typedef float f32x4 __attribute__((ext_vector_type(4)));
typedef short bf16x8 __attribute__((ext_vector_type(8)));
typedef GAS unsigned gu32;
typedef GAS unsigned long long gu64;
#define RLX_AGENT __ATOMIC_RELAXED, __HIP_MEMORY_SCOPE_AGENT
#define LDS_WAIT() asm volatile("s_waitcnt lgkmcnt(0)" ::: "memory")
#define VM_WAIT() asm volatile("s_waitcnt vmcnt(0)" ::: "memory")
__device__ __forceinline__ unsigned long long rt() { return __builtin_amdgcn_s_memrealtime(); }
__device__ __forceinline__ unsigned f2bf(float f) { unsigned u = __builtin_bit_cast(unsigned, f); return (u + 0x7fffu + ((u >> 16) & 1u)) >> 16; }
__device__ __forceinline__ unsigned pk2(float lo, float hi) { return f2bf(lo) | (f2bf(hi) << 16); }

#define XB_TMO      128
#define XB_XCNT(j)  (256  + 64 * (j))
#define XB_XSUB(j)  (1280 + 64 * (j))
#define XB_XGEN(j)  (2304 + 64 * (j))
#define XB_TOP      3328
#define XB_TOPGEN   3392
#define XCD_BAR_WORDS 3456
#define XB_SPIN_CAP (1u << 18)

__device__ __forceinline__ unsigned xb_ld(unsigned* p)              { return __hip_atomic_load(p, __ATOMIC_RELAXED, __HIP_MEMORY_SCOPE_AGENT); }
__device__ __forceinline__ unsigned xb_add(unsigned* p, unsigned v) { return __hip_atomic_fetch_add(p, v, __ATOMIC_RELAXED, __HIP_MEMORY_SCOPE_AGENT); }
__device__ __forceinline__ unsigned xb_xcc_id() { return (unsigned)__builtin_amdgcn_s_getreg((3 << 11) | 20) & 0xFu; }
#define XB_SPIN(cond, bar) do { unsigned _sp = 0; while (cond) { __builtin_amdgcn_s_sleep(1); \
    if ((++_sp & 255u) == 0u) { if (xb_ld(&(bar)[XB_TMO])) break; if (_sp > XB_SPIN_CAP) { atomicAdd(&(bar)[XB_TMO], 1u); break; } } } } while (0)

struct XcdBarrier {
    unsigned* bar; unsigned x;
    volatile LAS unsigned* st;
};

__device__ __forceinline__ XcdBarrier xcd_barrier_post(unsigned* bar, volatile LAS unsigned* st) {
    XcdBarrier b; b.bar = bar; b.x = xb_xcc_id(); b.st = st;
    if (threadIdx.x == 0) (void)xb_add(&bar[XB_XCNT(b.x)], 1u);
    return b;
}
__device__ __forceinline__ void xcd_barrier_complete(unsigned* bar, unsigned x, unsigned& nloc, unsigned& nx) {
    const unsigned G = gridDim.x * gridDim.y * gridDim.z;
    unsigned sum, cnt, mine, sp = 0u;
    for (;;) {
        sum = 0u; cnt = 0u; mine = 0u;
#pragma unroll
        for (unsigned j = 0; j < 16; ++j) { const unsigned c = xb_ld(&bar[XB_XCNT(j)]); sum += c; cnt += (c > 0u) ? 1u : 0u; mine = (j == x) ? c : mine; }
        if (sum == G) break;
        __builtin_amdgcn_s_sleep(1);
        if ((++sp & 255u) == 0u) { if (xb_ld(&bar[XB_TMO])) break; if (sp > XB_SPIN_CAP) { atomicAdd(&bar[XB_TMO], 1u); break; } }
    }
    nloc = mine > 0u ? mine : 1u; nx = cnt > 0u ? cnt : 1u;
}

__device__ __forceinline__ void xcd_barrier(const XcdBarrier& b) {
    asm volatile("s_waitcnt vmcnt(0)" ::: "memory");
    __syncthreads();
    if (threadIdx.x == 0) {
        unsigned* bar = b.bar;
        __builtin_amdgcn_s_waitcnt(0);
        unsigned nloc = b.st[0], nx = b.st[1];
        if (nloc == 0u) { xcd_barrier_complete(bar, b.x, nloc, nx); b.st[0] = nloc; b.st[1] = nx; }
        const unsigned old = xb_add(&bar[XB_XSUB(b.x)], 1u);
        const unsigned gen = old / nloc;
        if (old + 1u == (gen + 1u) * nloc) {
            __builtin_amdgcn_fence(__ATOMIC_RELEASE, "agent");
            asm volatile("s_waitcnt vmcnt(0)" ::: "memory");
            const unsigned og = xb_add(&bar[XB_TOP], 1u);
            const unsigned tg = og / nx;
            if (og + 1u == (tg + 1u) * nx) xb_add(&bar[XB_TOPGEN], 1u);
            else XB_SPIN(xb_ld(&bar[XB_TOPGEN]) == tg, bar);
            __builtin_amdgcn_fence(__ATOMIC_ACQUIRE, "agent");
            xb_add(&bar[XB_XGEN(b.x)], 1u);
            asm volatile("s_waitcnt vmcnt(0)" ::: "memory");
        } else {
            XB_SPIN(xb_ld(&bar[XB_XGEN(b.x)]) == gen, bar);
            __builtin_amdgcn_fence(__ATOMIC_ACQUIRE, "agent");
            asm volatile("s_waitcnt vmcnt(0)" ::: "memory");
        }
    }
    __syncthreads();
}
typedef _Float16 h16;
typedef _Float16 h16x8 __attribute__((ext_vector_type(8)));
typedef _Float16 h16x2 __attribute__((ext_vector_type(2)));
typedef float f32x16 __attribute__((ext_vector_type(16)));
typedef unsigned u32x4 __attribute__((ext_vector_type(4)));
typedef unsigned u32x2 __attribute__((ext_vector_type(2)));
constexpr int NB = 2, SEQ = 8192, M = NB * SEQ, D = 1024, DIN = 5376, DRW = 1792, DQKV = 1536, DG = 2048, DFF = 4096, DH = 512, DLO = 1536;
constexpr float ALPHA = 1.189207115002721f;
constexpr float QSCALE = 0.125f * 1.4426950408889634f;
constexpr float LN_EPS = 1e-5f, ADA_EPS = 1e-6f, GN_EPS = 64e-5f;
constexpr size_t MiB = 1u << 20, KiB = 1u << 10;
constexpr size_t WS_CTL = 0, CTL_ZERO_BYTES = 1 * MiB;
constexpr size_t WS_ADAP = 1 * MiB, WS_ADA = 1 * MiB + 896 * KiB, WS_BON = 2 * MiB;
constexpr size_t WS_WIN = 3 * MiB, WS_WLORA = 13 * MiB + 512 * KiB, WS_WBA = 14 * MiB + 256 * KiB, WS_WBB = 15 * MiB + 256 * KiB, WS_WOUT = 16 * MiB + 256 * KiB,
                 WS_W1 = 18 * MiB + 256 * KiB, WS_W2 = 26 * MiB + 256 * KiB;
constexpr size_t WS_H16 = 36 * MiB, WS_ZRW = 68 * MiB, WS_QKV = 124 * MiB, WS_LOUT = 172 * MiB, WS_LIN = 220 * MiB, WS_PB = 124 * MiB, WS_RB = 156 * MiB, WS_QB = 220 * MiB, WS_MRG = 68 * MiB, WS_HID = 68 * MiB, WS_END = 252 * MiB;
constexpr int CW_ATTQ = 64, CW_BAR = 4096;
constexpr int RING_BYTES = 131072, MISC_OFF = RING_BYTES + 64, LDS_BYTES = RING_BYTES + 512;
constexpr int NATT = 16 * 256, NPRE = 16 * 256, NCHAINB = 16;

struct KArgs { const float* in[27]; float* out; unsigned char* ws; };
struct P {
    const float *x, *c, *w_ada, *b_ada, *w_in, *mu, *w0, *w2, *a0, *a2, *g2, *kk, *ka, *rk, *gn_g, *gn_b, *wba, *wbb, *wout, *ln1g, *ln1b, *w1, *b1, *wf2, *b2, *ln2g, *ln2b;
    float* out; unsigned char* ws;
    unsigned* ctl; float *adap, *ada, *bon;
    h16 *pbuf, *rbuf, *vt; unsigned* qbuf; h16 *win_t, *wlora_t, *wba_t, *wbb_t, *wout_t, *w1_t, *w2_t, *h, *zrw, *qkv, *lin, *lout, *mrg, *hid, *ya, *ob, *gates;
};

__device__ __forceinline__ unsigned pkh(float a, float b) { h16x2 v = {(h16)a, (h16)b}; return __builtin_bit_cast(unsigned, v); }
__device__ __forceinline__ void store8h(h16* p, const f32x4& v0, const f32x4& v1) { u32x4 w; w.x = pkh(v0.x, v0.y); w.y = pkh(v0.z, v0.w); w.z = pkh(v1.x, v1.y); w.w = pkh(v1.z, v1.w); *(u32x4*)p = w; }
__device__ __forceinline__ void load8h(const h16* p, f32x4& v0, f32x4& v1) { const h16x8 t = *(const h16x8*)p; v0 = (f32x4){(float)t[0], (float)t[1], (float)t[2], (float)t[3]}; v1 = (f32x4){(float)t[4], (float)t[5], (float)t[6], (float)t[7]}; }
__device__ __forceinline__ float sigmoidf_(float x) { return 1.0f / (1.0f + __expf(-x)); }
template <int CTRL> __device__ __forceinline__ float dppmov(float x) { return __builtin_bit_cast(float, __builtin_amdgcn_update_dpp(0, __builtin_bit_cast(int, x), CTRL, 0xf, 0xf, true)); }
__device__ __forceinline__ float red16(float v) { v += dppmov<0xB1>(v); v += dppmov<0x4E>(v); v += dppmov<0x124>(v); v += dppmov<0x128>(v); return v; }

__device__ __forceinline__ float wave_sum(float v) {
    v = red16(v);
    const int b = __builtin_bit_cast(int, v);
    return (__builtin_bit_cast(float, __builtin_amdgcn_readlane(b, 0)) + __builtin_bit_cast(float, __builtin_amdgcn_readlane(b, 16))) +
           (__builtin_bit_cast(float, __builtin_amdgcn_readlane(b, 32)) + __builtin_bit_cast(float, __builtin_amdgcn_readlane(b, 48)));
}
template <class F> struct EpiGen {
    static constexpr bool PERM = true, AFTER_DRAIN = false;
    F f;
    __device__ __forceinline__ void operator()(const f32x4 (&acc)[2][2][4][2], const pg8::Unit& u, int wr, int wc, int fr, int fq) const {
        const int row0 = u.pm * 256 + wr * 64 + fr, col0 = u.pn * 256 + wc * 32 + 8 * fq;
#pragma unroll
        for (int ai = 0; ai < 2; ++ai)
#pragma unroll
            for (int m = 0; m < 4; ++m)
#pragma unroll
                for (int bj = 0; bj < 2; ++bj) f(row0 + ai * 128 + m * 16, col0 + bj * 128, acc[ai][bj][m][0], acc[ai][bj][m][1]);
    }
};
struct F1 {
    h16 *zrw, *qkv, *gates;
    __device__ __forceinline__ void operator()(int row, int col, f32x4 v0, f32x4 v1) const {
        if (col < DRW) store8h(zrw + (size_t)row * DRW + col, v0, v1);
        else if (col < DRW + DQKV) { const int c = col - DRW; if (c < 512) { v0 = v0 * QSCALE; v1 = v1 * QSCALE; } store8h(qkv + (size_t)row * DQKV + c, v0, v1); }
        else { const int c = col - DRW - DQKV;
#pragma unroll
            for (int i = 0; i < 4; ++i) { v0[i] = sigmoidf_(v0[i]); v1[i] = sigmoidf_(v1[i]); }
            store8h(gates + (size_t)row * DG + c, v0, v1); }
    }
};
struct F3 {
    h16* lout;
    __device__ __forceinline__ void operator()(int row, int col, f32x4 v0, f32x4 v1) const { store8h(lout + (size_t)row * DLO + col, v0, v1); }
};
struct F5Y { h16* gates;
    __device__ __forceinline__ void operator()(int row, int col, f32x4 v0, f32x4 v1) const {
        f32x4 g0, g1; h16* gp = gates + (size_t)row * DG + 1024 + col; load8h(gp, g0, g1); store8h(gp, v0 * g0, v1 * g1); } };
struct F5X { h16* mrg; const h16* gates;
    __device__ __forceinline__ void operator()(int row, int col, f32x4 v0, f32x4 v1) const {
        f32x4 g0, g1, m0, m1; load8h(gates + (size_t)row * DG + col, g0, g1); load8h(gates + (size_t)row * DG + 1024 + col, m0, m1); store8h(mrg + (size_t)row * D + col, m0 + v0 * g0, m1 + v1 * g1); } };
struct F6 { const float* x; float* out; const float* ada;
    __device__ __forceinline__ void operator()(int row, int col, f32x4 v0, f32x4 v1) const {
        const float* g = ada + (row >> 13) * 6144 + 2048 + col; const size_t o = (size_t)row * D + col;
        const f32x4 x0 = *(const f32x4*)(x + o), x1 = *(const f32x4*)(x + o + 4), g0 = *(const f32x4*)g, g1 = *(const f32x4*)(g + 4);
        *(f32x4*)(out + o) = x0 * ALPHA + g0 * v0; *(f32x4*)(out + o + 4) = x1 * ALPHA + g1 * v1; } };
struct F8 { h16* hid; const float* b1;
    __device__ __forceinline__ void operator()(int row, int col, f32x4 v0, f32x4 v1) const {
        const f32x4 c0 = *(const f32x4*)(b1 + col), c1 = *(const f32x4*)(b1 + col + 4);
#pragma unroll
        for (int i = 0; i < 4; ++i) { float a = fmaxf(v0[i] + c0[i], 0.f); v0[i] = a * a; a = fmaxf(v1[i] + c1[i], 0.f); v1[i] = a * a; }
        store8h(hid + (size_t)row * DFF + col, v0, v1); } };
struct F9 { float* out; const float* ada; const float* b2;
    __device__ __forceinline__ void operator()(int row, int col, f32x4 v0, f32x4 v1) const {
        const float* g = ada + (row >> 13) * 6144 + 5120 + col; const size_t o = (size_t)row * D + col;
        const f32x4 x0 = *(const f32x4*)(out + o), x1 = *(const f32x4*)(out + o + 4), g0 = *(const f32x4*)g, g1 = *(const f32x4*)(g + 4), c0 = *(const f32x4*)(b2 + col), c1 = *(const f32x4*)(b2 + col + 4);
        *(f32x4*)(out + o) = x0 * ALPHA + g0 * (v0 + c0); *(f32x4*)(out + o + 4) = x1 * ALPHA + g1 * (v1 + c1); } };

template <class F> __device__ __forceinline__ void run_gemm(LAS unsigned char* lds, const h16* A, const h16* Bt, int N, int K, const F& f, int gsz = -1, int gidx = -1) {
    asm volatile("" : "+s"(N), "+s"(K));
    if (gsz < 0) { gsz = (int)gridDim.x; gidx = (int)blockIdx.x; }
    pg8::Gemm g{(const pg8::bf16_t*)A, (const pg8::bf16_t*)Bt, M, N, K}; pg8::StaticOrder S; S.init(M, N, gsz, gidx);
    EpiGen<F> E{f};
    pg8::gemm_phase<EpiGen<F>, pg8::StaticOrder, true, true>(lds, g, S, E);
}

__device__ __forceinline__ void p0_transpose_item(const float* W, int K, int N, h16* WT, LAS float* scr, int item, int lane) {
    const int nblk = N / 32, kb = item / nblk, nb = item % nblk, k0 = 64 * kb, n0 = 32 * nb;
#pragma unroll 8
    for (int i = 0; i < 32; ++i) { const int kk = 2 * i + (lane >> 5); scr[kk * 33 + (lane & 31)] = W[(size_t)(k0 + kk) * N + n0 + (lane & 31)]; }
    LDS_WAIT(); asm volatile("" ::: "memory");
    const int c = lane & 7;
#pragma unroll
    for (int j = 0; j < 4; ++j) { const int n = (lane >> 3) + 8 * j; const LAS float* s = scr + (8 * c) * 33 + n;
        u32x4 o; o.x = pkh(s[0 * 33], s[1 * 33]); o.y = pkh(s[2 * 33], s[3 * 33]); o.z = pkh(s[4 * 33], s[5 * 33]); o.w = pkh(s[6 * 33], s[7 * 33]);
        *(u32x4*)(WT + (size_t)(n0 + n) * K + k0 + 8 * c) = o; }
    LDS_WAIT(); asm volatile("" ::: "memory");
}
__device__ __forceinline__ void phase0(const P& p, LAS unsigned char* lds, int tid, int lane, int wave) {
    LAS float* scr = (LAS float*)(lds + wave * 16384);
    const int G = gridDim.x, gw = blockIdx.x * 8 + wave, NGW = G * 8;
    constexpr int I_IN = (D / 64) * (DIN / 32), I_BA = (DH / 64) * (D / 32), I_OUT = (D / 64) * (D / 32), I_1 = (D / 64) * (DFF / 32), I_2 = (DFF / 64) * (D / 32);
    constexpr int NITEMS = I_IN + 2 * I_BA + I_OUT + I_1 + I_2;
    for (int it = gw; it < I_IN + I_BA; it += NGW) {
        int r = it;
        if (r < I_IN) { p0_transpose_item(p.w_in, D, DIN, p.win_t, scr, r, lane); continue; } r -= I_IN;
        p0_transpose_item(p.wbb, DH, D, p.wbb_t, scr, r, lane);
    }
    for (int idx = blockIdx.x * 512 + tid; idx < DLO * 256; idx += G * 512) {
        const int n = idx >> 8, k = idx & 255; float v = 0.f;
        if (n < 512) { if (k < 64) v = p.w2[k * 512 + n]; }
        else if (n < 1024) { if (k >= 64 && k < 128) v = p.a2[(k - 64) * 512 + n - 512]; }
        else { if (k >= 128) v = p.g2[(k - 128) * 512 + n - 1024]; }
        p.wlora_t[idx] = (h16)v;
    }
    for (int u = blockIdx.x; u < 192; u += G) {
        const int slice = u / 12, n = (u % 12) * 512 + tid; float a0 = 0.f, a1 = 0.f;
#pragma unroll 8
        for (int kk = 0; kk < 64; ++kk) { const int k = slice * 64 + kk; const float c0 = p.c[k], c1 = p.c[1024 + k], w = p.w_ada[(size_t)k * 6144 + n];
            a0 += c0 * sigmoidf_(c0) * w; a1 += c1 * sigmoidf_(c1) * w; }
        p.adap[(slice * 2 + 0) * 6144 + n] = a0; p.adap[(slice * 2 + 1) * 6144 + n] = a1;
    }
}
__device__ __forceinline__ void phase0_late(const P& p, LAS unsigned char* lds, int lane, int wave, int gsz, int gidx) {
    LAS float* scr = (LAS float*)(lds + wave * 16384);
    const int gw = gidx * 8 + wave, NGW = gsz * 8;
    constexpr int I_BA = (DH / 64) * (D / 32), I_OUT = (D / 64) * (D / 32), I_1 = (D / 64) * (DFF / 32), I_2 = (DFF / 64) * (D / 32);
    for (int it = gw; it < I_BA + I_OUT + I_1 + I_2; it += NGW) {
        int r = it;
        if (r < I_BA) { p0_transpose_item(p.wba, DH, D, p.wba_t, scr, r, lane); continue; } r -= I_BA;
        if (r < I_OUT) { p0_transpose_item(p.wout, D, D, p.wout_t, scr, r, lane); continue; } r -= I_OUT;
        if (r < I_1) { p0_transpose_item(p.w1, D, DFF, p.w1_t, scr, r, lane); continue; } r -= I_1;
        p0_transpose_item(p.wf2, DFF, D, p.w2_t, scr, r, lane);
    }
}
__device__ __forceinline__ void phase0b(const P& p, LAS unsigned char* lds, int tid, int lane, int wave) {
    LAS float* mod = (LAS float*)lds;
    for (int i = tid; i < 4096; i += 512) { const int b = i >> 11, j = i & 2047; float s = p.b_ada[j];
#pragma unroll
        for (int sl = 0; sl < 16; ++sl) s += p.adap[(sl * 2 + b) * 6144 + j];
        mod[i] = s; }
    if (blockIdx.x == 0) for (int i = tid; i < 2 * 6144; i += 512) { const int b = i / 6144, j = i % 6144; float s = p.b_ada[j];
#pragma unroll
        for (int sl = 0; sl < 16; ++sl) s += p.adap[(sl * 2 + b) * 6144 + j];
        p.ada[i] = s; }
    __syncthreads();
    const int gw = blockIdx.x * 8 + wave, NGW = gridDim.x * 8;
    for (int m = gw; m < M; m += NGW) {
        const f32x4* xr = (const f32x4*)(p.x + (size_t)m * D) + lane; const int b = m >> 13;
        f32x4 v[4]; float s = 0.f;
#pragma unroll
        for (int j = 0; j < 4; ++j) { v[j] = xr[64 * j]; s += (v[j].x + v[j].y) + (v[j].z + v[j].w); }
        const float mean = wave_sum(s) * (1.f / D); float s2 = 0.f;
#pragma unroll
        for (int j = 0; j < 4; ++j) { v[j] = v[j] - mean; s2 += (v[j].x * v[j].x + v[j].y * v[j].y) + (v[j].z * v[j].z + v[j].w * v[j].w); }
        const float rstd = 1.f / sqrtf(wave_sum(s2) * (1.f / D) + ADA_EPS);
        uint2* o8 = (uint2*)(p.h + (size_t)m * D) + lane;
#pragma unroll
        for (int j = 0; j < 4; ++j) { const int col = 4 * (lane + 64 * j); const f32x4 sh = *(const LAS f32x4*)(mod + b * 2048 + col), sc = *(const LAS f32x4*)(mod + b * 2048 + 1024 + col);
            const f32x4 r = v[j] * rstd * (sc + 1.0f) + sh; uint2 w; w.x = pkh(r.x, r.y); w.y = pkh(r.z, r.w); o8[64 * j] = w; }
    }
}
__device__ __forceinline__ void phase2(const P& p, int tid) {
    for (int idx = blockIdx.x * 512 + tid; idx < M * 32; idx += gridDim.x * 512) {
        const int t = idx >> 5, j8 = (idx & 31) * 8, col = 1536 + j8;
        f32x4 c0, c1, q0 = {0.f, 0.f, 0.f, 0.f}, q1 = {0.f, 0.f, 0.f, 0.f};
        load8h(p.zrw + (size_t)t * DRW + col, c0, c1); if (t & (SEQ - 1)) load8h(p.zrw + (size_t)(t - 1) * DRW + col, q0, q1);
        const f32x4 m0 = *(const f32x4*)(p.mu + col), m1 = *(const f32x4*)(p.mu + col + 4);
        c0 = c0 + m0 * (q0 - c0); c1 = c1 + m1 * (q1 - c1);
#pragma unroll
        for (int i = 0; i < 4; ++i) { if (j8 < 64) { c0[i] = tanhf(c0[i]); c1[i] = tanhf(c1[i]); } else if (j8 >= 128) { c0[i] = sigmoidf_(c0[i]); c1[i] = sigmoidf_(c1[i]); } }
        store8h(p.lin + (size_t)t * 256 + j8, c0, c1);
    }
}
constexpr int P64 = 72, P32 = 40;
constexpr int L_AM = 0, L_BM = 4608, L_KM = 9216, L_RM = 13824, L_AMT = 18432, L_BMT = 23552, L_KMT = 28672, L_VT = 33792, L_NR0 = 38912, L_NR1 = 41472, L_NT0 = 44032, L_NT1 = 46592,
              L_TR0 = 49152, L_TR1 = 51712, L_AAK = 54272, L_ARB = 56832, L_ARK = 59392, L_W1T = 61952, L_UT = 67072, L_TAT = 72192, L_CUM = 77312, L_GM = 85504, L_GL = 85760;
__device__ __forceinline__ int crow(int r, int hi) { return (r & 3) + 8 * (r >> 2) + 4 * hi; }
template <int KS> __device__ __forceinline__ f32x16 mm_tile(LAS unsigned char* A, int arow, int apitch, LAS unsigned char* B, int brow, int bpitch, f32x16 acc, int hi) {
#pragma unroll
    for (int s = 0; s < KS; ++s) { const h16x8 a = *(const LAS h16x8*)(A + (arow * apitch + 16 * s + 8 * hi) * 2), b = *(const LAS h16x8*)(B + (brow * bpitch + 16 * s + 8 * hi) * 2);
        acc = __builtin_amdgcn_mfma_f32_32x32x16_f16(a, b, acc, 0, 0, 0); }
    return acc;
}
__device__ __forceinline__ void wr_row(LAS unsigned char* arr, const f32x16& v, int n, int hi) {
#pragma unroll
    for (int r = 0; r < 16; ++r) ((LAS h16*)arr)[crow(r, hi) * P32 + n] = (h16)v[r];
}
__device__ __forceinline__ void wr_tr(LAS unsigned char* arr, const f32x16& v, int nrow, int hi) {
#pragma unroll
    for (int jj = 0; jj < 4; ++jj) { u32x2 w; w.x = pkh(v[4 * jj], v[4 * jj + 1]); w.y = pkh(v[4 * jj + 2], v[4 * jj + 3]); *(LAS u32x2*)(arr + (nrow * P32 + 8 * jj + 4 * hi) * 2) = w; }
}
__device__ __forceinline__ f32x16 zero16() { f32x16 z;
#pragma unroll
    for (int r = 0; r < 16; ++r) z[r] = 0.f;
    return z; }
__device__ __forceinline__ void pre_unit(const P& p, LAS unsigned char* sm, int unit, int tid, int lane, int wave) {
    const int bh = unit >> 8, c = unit & 255, b = bh >> 3, h = bh & 7, r32 = lane & 31, hi = lane >> 5, col = h * 64 + lane;
    LAS float* CUM = (LAS float*)(sm + L_CUM); LAS float* GM = (LAS float*)(sm + L_GM); LAS float* GL = (LAS float*)(sm + L_GL);
    const float mu_r = p.mu[col], mu_k = p.mu[512 + col], mu_v = p.mu[1024 + col], ckk = p.kk[col], cka = p.ka[col], crk = p.rk[col], cw0 = p.w0[col], ca0 = p.a0[col];
    float av[4], bv[4], kv[4], rv[4], vv[4], lwv[4];
#pragma unroll
    for (int i = 0; i < 4; ++i) {
        const int tt = wave * 4 + i, t = c * 32 + tt; const size_t gm = (size_t)b * SEQ + t;
        const h16* zr = p.zrw + gm * DRW; const h16* lo = p.lout + gm * DLO;
        float r = (float)zr[col], k = (float)zr[512 + col], v = (float)zr[1024 + col], rp = 0.f, kp = 0.f, vp = 0.f;
        if (t > 0) { rp = (float)zr[col - DRW]; kp = (float)zr[512 + col - DRW]; vp = (float)zr[1024 + col - DRW]; }
        r += mu_r * (rp - r); k += mu_k * (kp - k); v += mu_v * (vp - v);
        const float xw = -(cw0 + (float)lo[col]), spw = fmaxf(xw, 0.f) + __logf(1.f + __expf(-fabsf(xw))), ar = sigmoidf_(ca0 + (float)lo[512 + col]);
        const float lw = -__expf(-spw - 0.5f);
        const float kkv = k * ckk, nrm = sqrtf(wave_sum(kkv * kkv)), kkn = kkv / fmaxf(nrm, 1e-12f);
        const float k2 = k * (1.0f + (ar - 1.0f) * cka), bon = wave_sum(r * k2 * crk);
        if (lane == 0) p.bon[gm * 8 + h] = bon;
        av[i] = -kkn; bv[i] = kkn * ar; kv[i] = k2; rv[i] = r; vv[i] = v; lwv[i] = lw;
    }
    float cumv[4]; cumv[0] = lwv[0]; cumv[1] = cumv[0] + lwv[1]; cumv[2] = cumv[1] + lwv[2]; cumv[3] = cumv[2] + lwv[3];
    CUM[wave * 64 + lane] = cumv[3];
    __syncthreads();
    {   float off = 0.f, mid = 0.f, tot = 0.f;
#pragma unroll
        for (int w = 0; w < 8; ++w) { const float tw = CUM[w * 64 + lane]; if (w < wave) off += tw; if (w < 4) mid += tw; tot += tw; }
        if (wave == 0) { GM[lane] = __expf(mid); GL[lane] = __expf(tot); }
#pragma unroll
        for (int i = 0; i < 4; ++i) { const int tt = wave * 4 + i; const float cum = off + cumv[i], cp = cum - lwv[i];
            const float e1 = __expf(mid - cum);
            const h16 am = (h16)(av[i] * __expf(cp - mid)), bm = (h16)(bv[i] * e1), km = (h16)(kv[i] * e1), rm = (h16)(rv[i] * __expf(cum - mid));
            ((LAS h16*)(sm + L_AM))[tt * P64 + lane] = am; ((LAS h16*)(sm + L_BM))[tt * P64 + lane] = bm; ((LAS h16*)(sm + L_KM))[tt * P64 + lane] = km; ((LAS h16*)(sm + L_RM))[tt * P64 + lane] = rm;
            ((LAS h16*)(sm + L_AMT))[lane * P32 + tt] = am; ((LAS h16*)(sm + L_BMT))[lane * P32 + tt] = bm; ((LAS h16*)(sm + L_KMT))[lane * P32 + tt] = km; ((LAS h16*)(sm + L_VT))[lane * P32 + tt] = (h16)vv[i]; }
    }
    __syncthreads();
    if (wave < 4) {
        f32x16 acc = mm_tile<4>(sm + (wave < 2 ? L_AM : L_RM), r32, P64, sm + ((wave & 1) ? L_KM : L_BM), r32, P64, zero16(), hi);
#pragma unroll
        for (int r = 0; r < 16; ++r) { const int t = crow(r, hi); const bool keep = (wave < 2) ? (r32 < t) : (r32 <= t); acc[r] = keep ? acc[r] : 0.f; }
        if (wave == 0) {
            wr_row(sm + L_NR0, acc, r32, hi); wr_tr(sm + L_NT0, acc, r32, hi);
            f32x16 tacc = acc;
#pragma unroll
            for (int r = 0; r < 16; ++r) if (crow(r, hi) == r32) tacc[r] += 1.0f;
            wr_row(sm + L_TR0, tacc, r32, hi);
#pragma unroll
            for (int i = 0; i < 4; ++i) {
                LAS unsigned char* nr = sm + ((i & 1) ? L_NR1 : L_NR0); LAS unsigned char* nt = sm + ((i & 1) ? L_NT1 : L_NT0);
                LAS unsigned char* nr2 = sm + ((i & 1) ? L_NR0 : L_NR1); LAS unsigned char* nt2 = sm + ((i & 1) ? L_NT0 : L_NT1);
                LAS unsigned char* tr = sm + ((i & 1) ? L_TR1 : L_TR0); LAS unsigned char* tr2 = sm + ((i & 1) ? L_TR0 : L_TR1);
                const f32x16 nacc = mm_tile<2>(nr, r32, P32, nt, r32, P32, zero16(), hi);
                wr_row(nr2, nacc, r32, hi); wr_tr(nt2, nacc, r32, hi);
                tacc = mm_tile<2>(tr, r32, P32, nt2, r32, P32, tacc, hi);
                wr_row(tr2, tacc, r32, hi);
            }
        } else if (wave == 1) {
            wr_row(sm + L_AAK, acc, r32, hi);
#pragma unroll
            for (int vt = 0; vt < 2; ++vt) { const f32x16 w1 = mm_tile<2>(sm + L_AAK, r32, P32, sm + L_VT, 32 * vt + r32, P32, zero16(), hi); wr_tr(sm + L_W1T, w1, 32 * vt + r32, hi); }
        } else if (wave == 2) wr_row(sm + L_ARB, acc, r32, hi);
        else wr_row(sm + L_ARK, acc, r32, hi);
    }
    __syncthreads();
    if (wave < 2) { const f32x16 u = mm_tile<2>(sm + L_TR0, r32, P32, sm + L_W1T, 32 * wave + r32, P32, zero16(), hi); wr_tr(sm + L_UT, u, 32 * wave + r32, hi); }
    else if (wave < 4) { const f32x16 ta = mm_tile<2>(sm + L_TR0, r32, P32, sm + L_AMT, 32 * (wave - 2) + r32, P32, zero16(), hi); wr_tr(sm + L_TAT, ta, 32 * (wave - 2) + r32, hi); }
    __syncthreads();
    if (wave < 4) {
        const int kt = wave >> 1, mt = wave & 1, k = 32 * mt + r32;
        const f32x16 x = mm_tile<2>(sm + L_TAT, 32 * kt + r32, P32, sm + L_BMT, k, P32, zero16(), hi);
        const float gl = GL[k], f1 = gl / GM[k]; float pv[16];
#pragma unroll
        for (int r = 0; r < 16; ++r) { const int k2 = 32 * kt + crow(r, hi); pv[r] = f1 * x[r] * GM[k2] + (k2 == k ? gl : 0.f); }
        u32x4 w0, w1; w0.x = pkh(pv[0], pv[1]); w0.y = pkh(pv[2], pv[3]); w0.z = pkh(pv[4], pv[5]); w0.w = pkh(pv[6], pv[7]); w1.x = pkh(pv[8], pv[9]); w1.y = pkh(pv[10], pv[11]); w1.z = pkh(pv[12], pv[13]); w1.w = pkh(pv[14], pv[15]);
        u32x4* dst = (u32x4*)p.pbuf + (size_t)unit * 512 + (mt * 4 + 2 * kt) * 64 + lane;
        dst[0] = w0; dst[64] = w1;
    } else if (wave < 6) {
        const int kt = wave - 4;
        const f32x16 x = mm_tile<2>(sm + L_TAT, 32 * kt + r32, P32, sm + L_ARB, r32, P32, zero16(), hi);
        float pv[16];
#pragma unroll
        for (int r = 0; r < 16; ++r) { const int k2 = 32 * kt + crow(r, hi); pv[r] = (x[r] + (float)((LAS h16*)(sm + L_RM))[r32 * P64 + k2]) * GM[k2]; }
        u32x4 w0, w1; w0.x = pkh(pv[0], pv[1]); w0.y = pkh(pv[2], pv[3]); w0.z = pkh(pv[4], pv[5]); w0.w = pkh(pv[6], pv[7]); w1.x = pkh(pv[8], pv[9]); w1.y = pkh(pv[10], pv[11]); w1.z = pkh(pv[12], pv[13]); w1.w = pkh(pv[14], pv[15]);
        u32x4* dst = (u32x4*)p.rbuf + (size_t)unit * 256 + (2 * kt) * 64 + lane;
        dst[0] = w0; dst[64] = w1;
    } else {
        const int vt = wave - 6;
        f32x16 y = mm_tile<2>(sm + L_ARB, r32, P32, sm + L_UT, 32 * vt + r32, P32, zero16(), hi);
        y = mm_tile<2>(sm + L_ARK, r32, P32, sm + L_VT, 32 * vt + r32, P32, y, hi);
        h16* dst = p.ya + ((size_t)b * SEQ + c * 32) * DH + h * 64 + 32 * vt + r32;
#pragma unroll
        for (int r = 0; r < 16; ++r) dst[(size_t)crow(r, hi) * DH] = (h16)y[r];
    }
    if (wave >= 4) {
        const int mt = (wave - 4) >> 1, vt = (wave - 4) & 1;
        f32x16 q = mm_tile<2>(sm + L_BMT, 32 * mt + r32, P32, sm + L_UT, 32 * vt + r32, P32, zero16(), hi);
        q = mm_tile<2>(sm + L_KMT, 32 * mt + r32, P32, sm + L_VT, 32 * vt + r32, P32, q, hi);
        unsigned qw[8];
#pragma unroll
        for (int r2 = 0; r2 < 8; ++r2) { const int k0 = 32 * mt + crow(2 * r2, hi), k1 = 32 * mt + crow(2 * r2 + 1, hi);
            qw[r2] = pkh(q[2 * r2] * (GL[k0] / GM[k0]), q[2 * r2 + 1] * (GL[k1] / GM[k1])); }
        u32x4* dst = (u32x4*)(p.qbuf + (size_t)unit * 2048 + ((vt * 2 + mt) * 64 + lane) * 8);
        dst[0] = (u32x4){qw[0], qw[1], qw[2], qw[3]}; dst[1] = (u32x4){qw[4], qw[5], qw[6], qw[7]};
    }
    __syncthreads();
}
__device__ __forceinline__ float h_lo(unsigned w) { return (float)__builtin_bit_cast(h16x2, w)[0]; }
__device__ __forceinline__ float h_hi(unsigned w) { return (float)__builtin_bit_cast(h16x2, w)[1]; }
struct LdSet { u32x4 v[11]; };
__device__ __forceinline__ void chain_ld(LdSet& d, const unsigned char* pb, const unsigned char* qb, int grp, int lt) {
#pragma unroll
    for (int i = 0; i < 11; ++i) { const int idx = lt + i * 384; if (idx < 4096) { const int ch = idx >> 10, w = idx & 1023; const size_t u = (size_t)(grp * 4 + ch) * 8192;
        d.v[i] = *(const u32x4*)((w < 512 ? pb : qb - 8192) + u + (size_t)w * 16); } }
}
__device__ __forceinline__ void chain_st(const LdSet& d, LAS unsigned char* set, int lt) {
    LAS unsigned char* b = set + lt * 16;
#pragma unroll
    for (int i = 0; i < 10; ++i) *(LAS u32x4*)(b + i * 6144) = d.v[i];
    if (lt < 256) *(LAS u32x4*)(b + 10 * 6144) = d.v[10];
}
__device__ __forceinline__ void chain_group(LAS unsigned char* pbase, LAS unsigned char* qbase, f32x16& c0, f32x16& c1, u32x4* sdst) {
#pragma unroll
    for (int cc = 0; cc < 4; ++cc) {
        h16x8 pa[8]; u32x4 q[4];
#pragma unroll
        for (int i = 0; i < 8; ++i) pa[i] = *(const LAS h16x8*)(pbase + cc * 16384 + i * 1024);
#pragma unroll
        for (int i = 0; i < 4; ++i) q[i] = *(const LAS u32x4*)(qbase + cc * 16384 + (i >> 1) * 2048 + (i & 1) * 16);
        h16x8 bs[4];
#pragma unroll
        for (int e = 0; e < 8; ++e) { bs[0][e] = (h16)c0[e]; bs[1][e] = (h16)c0[8 + e]; bs[2][e] = (h16)c1[e]; bs[3][e] = (h16)c1[8 + e]; }
#pragma unroll
        for (int s = 0; s < 4; ++s) sdst[cc * 512 + s * 64] = __builtin_bit_cast(u32x4, bs[s]);
        f32x16 n0, n1;
#pragma unroll
        for (int w = 0; w < 4; ++w) { n0[2 * w] = h_lo(q[0][w]); n0[2 * w + 1] = h_hi(q[0][w]); n0[8 + 2 * w] = h_lo(q[1][w]); n0[8 + 2 * w + 1] = h_hi(q[1][w]);
                                      n1[2 * w] = h_lo(q[2][w]); n1[2 * w + 1] = h_hi(q[2][w]); n1[8 + 2 * w] = h_lo(q[3][w]); n1[8 + 2 * w + 1] = h_hi(q[3][w]); }
#pragma unroll
        for (int s = 0; s < 4; ++s) { n0 = __builtin_amdgcn_mfma_f32_32x32x16_f16(pa[s], bs[s], n0, 0, 0, 0); n1 = __builtin_amdgcn_mfma_f32_32x32x16_f16(pa[4 + s], bs[s], n1, 0, 0, 0); }
        c0 = n0; c1 = n1;
        asm volatile("" ::: "memory");
    }
}
__device__ __forceinline__ void chain_block(const P& p, LAS unsigned char* sm, int bh, int tid, int lane, int wave) {
    const unsigned char* pb = (const unsigned char*)p.pbuf + (size_t)bh * 256 * 8192;
    const unsigned char* qb = (const unsigned char*)p.qbuf + (size_t)bh * 256 * 8192;
    const int lt = tid - 128;
#define CH_BAR() asm volatile("s_waitcnt lgkmcnt(0)\n\ts_barrier" ::: "memory")
    if (wave >= 2) {
        LdSet A, B;
        chain_ld(A, pb, qb, 0, lt); chain_ld(B, pb, qb, 1, lt); chain_st(A, sm, lt); chain_ld(A, pb, qb, 2, lt);
        CH_BAR();
        for (int g = 0; g < 64; g += 2) {
            chain_st(B, sm + 65536, lt); if (g + 3 < 64) chain_ld(B, pb, qb, g + 3, lt);
            CH_BAR();
            if (g + 2 < 64) { chain_st(A, sm, lt); if (g + 4 < 64) chain_ld(A, pb, qb, g + 4, lt); }
            CH_BAR();
        }
    } else {
        f32x16 c0 = zero16(), c1 = zero16();
        u32x4* sbase = (u32x4*)p.qbuf + (size_t)bh * 256 * 512 + wave * 256 + lane;
        LAS unsigned char* pbase = sm + lane * 16; LAS unsigned char* qbase = sm + 8192 + (wave * 128 + lane) * 32;
        CH_BAR();
        for (int g = 0; g < 64; g += 2) {
            chain_group(pbase, qbase, c0, c1, sbase + (size_t)(g * 4) * 512);
            CH_BAR();
            chain_group(pbase + 65536, qbase + 65536, c0, c1, sbase + (size_t)((g + 1) * 4) * 512);
            CH_BAR();
        }
    }
#undef CH_BAR
    __syncthreads();
}
__device__ __forceinline__ void phase2v(const P& p, LAS unsigned char* lds, int tid) {
    for (int tile = blockIdx.x; tile < 256; tile += gridDim.x) {
        const int b = tile >> 7, tl = tile & 127; const size_t m0 = (size_t)b * SEQ + tl * 64;
#pragma unroll
        for (int i = 0; i < 8; ++i) { const int idx = tid + i * 512, key = idx >> 6, ch = idx & 63; *(LAS u32x4*)(lds + key * 1040 + ch * 16) = *(const u32x4*)(p.qkv + (m0 + key) * DQKV + 1024 + ch * 8); }
        __syncthreads();
#pragma unroll
        for (int i = 0; i < 8; ++i) { const int o = tid + i * 512, h = o >> 9, g = (o >> 6) & 7, d = o & 63, ks = g >> 1, hk = g & 1; unsigned short e[8];
#pragma unroll
            for (int j = 0; j < 8; ++j) e[j] = ((const LAS unsigned short*)lds)[(16 * ks + 8 * (j >> 2) + 4 * hk + (j & 3)) * 520 + h * 64 + d];
            u32x4 w; w.x = e[0] | ((unsigned)e[1] << 16); w.y = e[2] | ((unsigned)e[3] << 16); w.z = e[4] | ((unsigned)e[5] << 16); w.w = e[6] | ((unsigned)e[7] << 16);
            ((u32x4*)p.vt)[((((size_t)(b * 8 + h) * 128 + tl) * 8 + g) * 64 + d)] = w; }
        __syncthreads();
    }
}
struct KVF { h16x8 k[8]; u32x4 v[8]; };
__device__ __forceinline__ void attn_ld(KVF& f, const h16* kbase, const u32x4* vtb, int jt) {
    const h16* kp = kbase + (size_t)(jt * 64) * DQKV;
#pragma unroll
    for (int d0 = 0; d0 < 4; ++d0) { f.k[2 * d0] = *(const h16x8*)(kp + d0 * 16); f.k[2 * d0 + 1] = *(const h16x8*)(kp + (size_t)32 * DQKV + d0 * 16); }
    const u32x4* vp = vtb + (size_t)jt * 512;
#pragma unroll
    for (int ks = 0; ks < 4; ++ks) { f.v[2 * ks] = vp[ks * 128]; f.v[2 * ks + 1] = vp[ks * 128 + 32]; }
}
__device__ __forceinline__ void attn_wave_unit(const P& p, int unit, int lane) {
    const int bh = unit >> 8, qblk = unit & 255, b = bh >> 3, h = bh & 7, qw0 = qblk * 32, r32 = lane & 31, hi = lane >> 5, qabs = qw0 + r32;
    const h16* base = p.qkv + (size_t)b * SEQ * DQKV + h * 64;
    const h16* kbase = base + 512 + (size_t)r32 * DQKV + hi * 8;
    const u32x4* vtb = (const u32x4*)p.vt + (size_t)bh * 128 * 512 + hi * 64 + r32;
    h16x8 qf[4];
#pragma unroll
    for (int d0 = 0; d0 < 4; ++d0) qf[d0] = *(const h16x8*)(base + (size_t)(qw0 + r32) * DQKV + d0 * 16 + hi * 8);
    f32x16 o0 = zero16(), o1 = zero16();
    float carry = 1.f;
    KVF cur, nxt;
    int jt = (qw0 + 31) >> 6;
    attn_ld(cur, kbase, vtb, jt);
    for (; jt >= 0; --jt) {
        const int k0 = jt * 64;
        if (jt > 0) attn_ld(nxt, kbase, vtb, jt - 1);
        f32x16 p0 = zero16(), p1 = zero16();
#pragma unroll
        for (int d0 = 0; d0 < 4; ++d0) { p0 = __builtin_amdgcn_mfma_f32_32x32x16_f16(cur.k[2 * d0], qf[d0], p0, 0, 0, 0); p1 = __builtin_amdgcn_mfma_f32_32x32x16_f16(cur.k[2 * d0 + 1], qf[d0], p1, 0, 0, 0); }
        float M0[16], M1[16];
#pragma unroll
        for (int r = 0; r < 16; ++r) { const int key = k0 + crow(r, hi);
            const float m0 = __builtin_amdgcn_rcpf(1.f + __builtin_amdgcn_exp2f(p0[r])), m1 = __builtin_amdgcn_rcpf(1.f + __builtin_amdgcn_exp2f(p1[r]));
            M0[r] = (key < qabs) ? m0 : 1.f; M1[r] = (key + 32 < qabs) ? m1 : 1.f; }
        float Gs[8], PG[8], sgo[8];
#pragma unroll
        for (int j = 0; j < 4; ++j) { Gs[j] = (M0[4 * j] * M0[4 * j + 1]) * (M0[4 * j + 2] * M0[4 * j + 3]); Gs[4 + j] = (M1[4 * j] * M1[4 * j + 1]) * (M1[4 * j + 2] * M1[4 * j + 3]); }
#pragma unroll
        for (int j = 0; j < 8; ++j) PG[j] = __shfl_xor(Gs[j], 32);
        float run = 1.f;
#pragma unroll
        for (int j = 7; j >= 0; --j) { const float ev = hi ? PG[j] : Gs[j], od = hi ? Gs[j] : PG[j]; const float so = run; run *= od; const float se = run; run *= ev; sgo[j] = hi ? so : se; }
        h16x8 pa[4];
#pragma unroll
        for (int j = 0; j < 4; ++j) {
            float acc = carry * sgo[j], acc1 = carry * sgo[4 + j];
#pragma unroll
            for (int i = 3; i >= 0; --i) { const int r = 4 * j + i;
                const float a0 = acc * (1.f - M0[r]); acc *= M0[r];
                const float a1 = acc1 * (1.f - M1[r]); acc1 *= M1[r];
                pa[j >> 1][(j & 1) * 4 + i] = (h16)a0; pa[2 + (j >> 1)][(j & 1) * 4 + i] = (h16)a1; }
        }
        carry *= run;
#pragma unroll
        for (int ks = 0; ks < 4; ++ks) { o0 = __builtin_amdgcn_mfma_f32_32x32x16_f16(pa[ks], __builtin_bit_cast(h16x8, cur.v[2 * ks]), o0, 0, 0, 0); o1 = __builtin_amdgcn_mfma_f32_32x32x16_f16(pa[ks], __builtin_bit_cast(h16x8, cur.v[2 * ks + 1]), o1, 0, 0, 0); }
        if (__all(carry < 1.1754944e-38f)) break;
        cur = nxt;
    }
    h16* ob = p.ob + ((size_t)b * SEQ + qw0) * DH + h * 64;
#pragma unroll
    for (int r = 0; r < 16; ++r) { const int q = crow(r, hi); ob[(size_t)q * DH + r32] = (h16)o0[r]; ob[(size_t)q * DH + 32 + r32] = (h16)o1[r]; }
}
__device__ __forceinline__ void phase4b(const P& p, LAS unsigned char* lds, int lane, int wave) {
    const int gw = blockIdx.x * 8 + wave, NGW = gridDim.x * 8, r32 = lane & 31, hi = lane >> 5;
    LAS float* yt = (LAS float*)(lds + wave * 8448);
    for (int unit = gw; unit < NPRE; unit += NGW) {
        const int bh = unit >> 8, c = unit & 255, b = bh >> 3, h = bh & 7; const size_t tok0 = (size_t)b * SEQ + c * 32;
        h16x8 ra[4];
#pragma unroll
        for (int s = 0; s < 4; ++s) ra[s] = __builtin_bit_cast(h16x8, ((const u32x4*)p.rbuf)[(size_t)unit * 256 + s * 64 + lane]);
#pragma unroll
        for (int vt = 0; vt < 2; ++vt) {
            const h16* yl = p.ya + tok0 * DH + h * 64 + 32 * vt + r32; f32x16 y;
#pragma unroll
            for (int r = 0; r < 16; ++r) y[r] = (float)yl[(size_t)crow(r, hi) * DH];
#pragma unroll
            for (int s = 0; s < 4; ++s) { const h16x8 sb = __builtin_bit_cast(h16x8, ((const u32x4*)p.qbuf)[(size_t)unit * 512 + vt * 256 + s * 64 + lane]); y = __builtin_amdgcn_mfma_f32_32x32x16_f16(ra[s], sb, y, 0, 0, 0); }
#pragma unroll
            for (int r = 0; r < 16; ++r) yt[crow(r, hi) * 66 + 32 * vt + r32] = y[r];
        }
        const int col = h * 64 + lane; const float gg = p.gn_g[col], gb = p.gn_b[col], muv = p.mu[1024 + col];
#pragma unroll 4
        for (int t = 0; t < 32; ++t) {
            const size_t gm = tok0 + t;
            const float y = yt[t * 66 + lane], mean = wave_sum(y) * (1.f / 64.f), d = y - mean, var = wave_sum(d * d) * (1.f / 64.f);
            const float gn = d * (1.0f / sqrtf(var + GN_EPS)) * gg + gb;
            float v = (float)p.zrw[gm * DRW + 1024 + col], vp = 0.f; if (c * 32 + t > 0) vp = (float)p.zrw[(gm - 1) * DRW + 1024 + col];
            v += muv * (vp - v);
            const float g = (float)p.lout[gm * DLO + 1024 + col], bon = p.bon[gm * 8 + h];
            p.ya[gm * DH + col] = (h16)((gn + bon * v) * g);
        }
    }
}
template <bool FINAL> __device__ __forceinline__ void phase_ln(const P& p, int lane, int wave) {
    const int gw = blockIdx.x * 8 + wave, NGW = gridDim.x * 8;
    const float* lg = FINAL ? p.ln2g : p.ln1g; const float* lb = FINAL ? p.ln2b : p.ln1b;
    for (int m = gw; m < M; m += NGW) {
        f32x4* xr = (f32x4*)(p.out + (size_t)m * D) + lane; const int b = m >> 13;
        f32x4 v[4]; float s = 0.f;
#pragma unroll
        for (int j = 0; j < 4; ++j) { v[j] = xr[64 * j]; s += (v[j].x + v[j].y) + (v[j].z + v[j].w); }
        float mean = wave_sum(s) * (1.f / D), s2 = 0.f;
#pragma unroll
        for (int j = 0; j < 4; ++j) { v[j] = v[j] - mean; s2 += (v[j].x * v[j].x + v[j].y * v[j].y) + (v[j].z * v[j].z + v[j].w * v[j].w); }
        float rstd = 1.f / sqrtf(wave_sum(s2) * (1.f / D) + LN_EPS);
        s = 0.f;
#pragma unroll
        for (int j = 0; j < 4; ++j) { const int col = 4 * (lane + 64 * j); v[j] = v[j] * rstd * *(const f32x4*)(lg + col) + *(const f32x4*)(lb + col); xr[64 * j] = v[j]; s += (v[j].x + v[j].y) + (v[j].z + v[j].w); }
        if (!FINAL) {
            mean = wave_sum(s) * (1.f / D); s2 = 0.f;
#pragma unroll
            for (int j = 0; j < 4; ++j) { v[j] = v[j] - mean; s2 += (v[j].x * v[j].x + v[j].y * v[j].y) + (v[j].z * v[j].z + v[j].w * v[j].w); }
            rstd = 1.f / sqrtf(wave_sum(s2) * (1.f / D) + ADA_EPS);
            uint2* o8 = (uint2*)(p.h + (size_t)m * D) + lane; const float* ad = p.ada + b * 6144;
#pragma unroll
            for (int j = 0; j < 4; ++j) { const int col = 4 * (lane + 64 * j); const f32x4 sh = *(const f32x4*)(ad + 3072 + col), sc = *(const f32x4*)(ad + 4096 + col);
                const f32x4 r = v[j] * rstd * (sc + 1.0f) + sh; uint2 w; w.x = pkh(r.x, r.y); w.y = pkh(r.z, r.w); o8[64 * j] = w; }
        }
    }
}

typedef __attribute__((address_space(4))) const unsigned char* kargp_t;
__device__ __forceinline__ void make_p(P& p) {
    kargp_t ka = (kargp_t)__builtin_amdgcn_kernarg_segment_ptr(); asm volatile("" : "+s"(ka));
    const float* const __attribute__((address_space(4)))* in = (const float* const __attribute__((address_space(4)))*)ka;
    p.x = in[0]; p.c = in[1]; p.w_ada = in[2]; p.b_ada = in[3]; p.w_in = in[4]; p.mu = in[5]; p.w0 = in[6]; p.w2 = in[7]; p.a0 = in[8]; p.a2 = in[9]; p.g2 = in[10];
    p.kk = in[11]; p.ka = in[12]; p.rk = in[13]; p.gn_g = in[14]; p.gn_b = in[15]; p.wba = in[16]; p.wbb = in[17]; p.wout = in[18]; p.ln1g = in[19]; p.ln1b = in[20];
    p.w1 = in[21]; p.b1 = in[22]; p.wf2 = in[23]; p.b2 = in[24]; p.ln2g = in[25]; p.ln2b = in[26];
    p.out = (float*)in[27]; unsigned char* ws = (unsigned char*)in[28]; p.ws = ws;
    p.ctl = (unsigned*)(ws + WS_CTL); p.adap = (float*)(ws + WS_ADAP); p.ada = (float*)(ws + WS_ADA); p.bon = (float*)(ws + WS_BON);
    p.win_t = (h16*)(ws + WS_WIN); p.wlora_t = (h16*)(ws + WS_WLORA); p.wba_t = (h16*)(ws + WS_WBA); p.wbb_t = (h16*)(ws + WS_WBB); p.wout_t = (h16*)(ws + WS_WOUT); p.w1_t = (h16*)(ws + WS_W1); p.w2_t = (h16*)(ws + WS_W2);
    p.h = (h16*)(ws + WS_H16); p.zrw = (h16*)(ws + WS_ZRW); p.qkv = (h16*)(ws + WS_QKV); p.lin = (h16*)(ws + WS_LIN); p.lout = (h16*)(ws + WS_LOUT); p.mrg = (h16*)(ws + WS_MRG); p.hid = (h16*)(ws + WS_HID);
    p.pbuf = (h16*)(ws + WS_PB); p.rbuf = (h16*)(ws + WS_RB); p.qbuf = (unsigned*)(ws + WS_QB); p.vt = (h16*)(ws + WS_H16); p.ya = (h16*)(ws + WS_H16); p.ob = (h16*)(ws + WS_H16 + 16 * MiB); p.gates = (h16*)p.out;
}
__global__ void __launch_bounds__(512, 2) mk_fwd(KArgs a) {
    extern __shared__ __attribute__((aligned(16))) unsigned char lds_raw[];
    LAS unsigned char* lds = (LAS unsigned char*)lds_raw;
    volatile LAS unsigned* MISC = (volatile LAS unsigned*)(lds + MISC_OFF);
    int tid = threadIdx.x, lane = tid & 63, wave = __builtin_amdgcn_readfirstlane(tid >> 6);
#define FRESH() do { tid = threadIdx.x; asm volatile("" : "+v"(tid)); lane = tid & 63; wave = __builtin_amdgcn_readfirstlane(tid >> 6); make_p(p); } while (0)
    P p; make_p(p);
    for (int u = tid; u < (LDS_BYTES - RING_BYTES) / 4; u += 512) ((LAS unsigned*)(lds + RING_BYTES))[u] = 0u;
    __syncthreads();
    XcdBarrier bar = xcd_barrier_post(p.ctl + CW_BAR, MISC + 8);
#define GRID_BAR() xcd_barrier(bar)

    FRESH();
    phase0(p, lds, tid, lane, wave);
    if (gridDim.x == 0x7fffffffu) cg::this_grid().sync();
    GRID_BAR();
    FRESH();
    phase0b(p, lds, tid, lane, wave);
    GRID_BAR();
    FRESH();
    run_gemm(lds, p.h, p.win_t, DIN, D, F1{p.zrw, p.qkv, p.gates});
    GRID_BAR();
    FRESH();
    phase2(p, tid);
    phase2v(p, lds, tid);
    GRID_BAR();
    FRESH();
    run_gemm(lds, p.lin, p.wlora_t, DLO, 256, F3{p.lout});
    FRESH();
    for (;;) {
        unsigned u = 0; if (lane == 0) u = atomicAdd(p.ctl + CW_ATTQ, 1u);
        u = (unsigned)__builtin_amdgcn_readfirstlane((int)u);
        if (u >= (unsigned)NATT) break;
        attn_wave_unit(p, (int)u, lane);
    }
    GRID_BAR();
    FRESH();
    for (int u = (int)blockIdx.x; u < NPRE; u += (int)gridDim.x) pre_unit(p, lds, u, tid, lane, wave);
    GRID_BAR();
    FRESH();
    if ((int)blockIdx.x < NCHAINB) chain_block(p, lds, (int)blockIdx.x, tid, lane, wave);
    else { run_gemm(lds, p.ob, p.wbb_t, D, DH, F5Y{p.gates}, (int)gridDim.x - NCHAINB, (int)blockIdx.x - NCHAINB);
           __syncthreads(); FRESH(); phase0_late(p, lds, lane, wave, (int)gridDim.x - NCHAINB, (int)blockIdx.x - NCHAINB); }
    GRID_BAR();
    FRESH();
    phase4b(p, lds, lane, wave);
    GRID_BAR();
    FRESH();
    run_gemm(lds, p.ya, p.wba_t, D, DH, F5X{p.mrg, p.gates});
    GRID_BAR();
    FRESH();
    run_gemm(lds, p.mrg, p.wout_t, D, D, F6{p.x, p.out, p.ada});
    GRID_BAR();
    FRESH();
    phase_ln<false>(p, lane, wave);
    GRID_BAR();
    FRESH();
    run_gemm(lds, p.h, p.w1_t, DFF, D, F8{p.hid, p.b1});
    GRID_BAR();
    FRESH();
    run_gemm(lds, p.hid, p.w2_t, D, DFF, F9{p.out, p.ada, p.b2});
    GRID_BAR();
    FRESH();
    phase_ln<true>(p, lane, wave);
}

extern "C" void kernel_launch(void* const* d_in, const int* in_sizes, int n_in, void* d_out, int out_size, void* d_ws, size_t ws_size, hipStream_t stream) {
    static int grid = 0;
    if (grid == 0) {
        if (n_in != 27 || out_size != M * D || ws_size < WS_END) { fprintf(stderr, "kernel_launch: unexpected shapes (n_in %d, out %d, ws %zu)\n", n_in, out_size, ws_size); grid = -1; return; }
        int dev = 0, cus = 0, per_cu = 0;
        hipGetDevice(&dev); hipDeviceGetAttribute(&cus, hipDeviceAttributeMultiprocessorCount, dev);
        if (hipFuncSetAttribute((const void*)mk_fwd, hipFuncAttributeMaxDynamicSharedMemorySize, LDS_BYTES) != hipSuccess) { fprintf(stderr, "kernel_launch: hipFuncSetAttribute failed\n"); grid = -1; return; }
        hipOccupancyMaxActiveBlocksPerMultiprocessor(&per_cu, (const void*)mk_fwd, 512, LDS_BYTES);
        (void)hipGetLastError();
        if (per_cu < 1) fprintf(stderr, "kernel_launch: occupancy query says %d blocks per CU\n", per_cu);
        grid = cus;
    }
    if (grid < 0) return;
    hipMemsetAsync((char*)d_ws + WS_CTL, 0, CTL_ZERO_BYTES, stream);
    KArgs a{};
    for (int i = 0; i < 27; ++i) a.in[i] = (const float*)d_in[i];
    a.out = (float*)d_out; a.ws = (unsigned char*)d_ws;
    void* args[] = {&a};
    hipError_t e = hipLaunchCooperativeKernel((const void*)mk_fwd, dim3(grid), dim3(512), args, LDS_BYTES, stream);
    if (e != hipSuccess) fprintf(stderr, "cooperative launch failed: %s (grid %d)\n", hipGetErrorString(e), grid);
}
```

```cpp
#include <hip/hip_runtime.h>
#include <hip/hip_cooperative_groups.h>
#include <cstdio>
#include <cstdint>
namespace cg = cooperative_groups;
namespace pg8 {
#define PG8_LAS __attribute__((address_space(3)))
typedef unsigned short bf16_t;
typedef _Float16 bf16x8 __attribute__((ext_vector_type(8)));
typedef float f32x4 __attribute__((ext_vector_type(4)));
typedef unsigned u32x4 __attribute__((ext_vector_type(4)));
constexpr int BM = 256, BK = 64, HALF = 128, HTB = HALF * BK * 2  , STAGE_BYTES = 8 * HTB, NXCD = 8, WGM = 8;

__host__ __device__ __forceinline__ int lds_byte(int r, int c) { const int st = (r >> 4) * 2 + (c >> 5), rr = r & 15, cc = c & 31, ob = rr * 64 + cc * 2; return st * 1024 + (ob ^ (((ob >> 9) & 1) << 5)); }
__host__ __device__ __forceinline__ void stage_rc(int b, int& R, int& C) { const int st = b / 1024, sb = b % 1024, swz = sb ^ (((sb >> 9) & 1) << 5); R = (st >> 1) * 16 + swz / 64; C = (st & 1) * 32 + (swz % 64) / 2; }
__host__ __device__ __forceinline__ int perm32(int rho) { const int n = rho >> 4, i = rho & 15; return 8 * (i >> 2) + 4 * n + (i & 3); }

struct Unit { int pm, pn; };
struct Gemm { const bf16_t* A; const bf16_t* Bt; int M, N, K; };

struct StaticOrder {
    int nM, nN, nwg, G, c;
    __host__ __device__ void init(int M, int N, int G_, int c_) { nM = M / BM; nN = N / BM; nwg = nM * nN; G = G_; c = c_; }
    __host__ __device__ bool next(int i, Unit& u) const {
        const long L = (long)i * G + c; if (L >= nwg) return false;
        int wgid = (int)L; { const int q = nwg / NXCD, r = nwg % NXCD, xcd = wgid % NXCD, off = wgid / NXCD; wgid = (xcd < r ? xcd * (q + 1) : r * (q + 1) + (xcd - r) * q) + off; }
        const int nig = WGM * nN, gid = wgid / nig, fm = gid * WGM, gsz = (nM - fm) < WGM ? (nM - fm) : WGM;
        u.pm = fm + ((wgid % nig) % gsz); u.pn = (wgid % nig) / gsz; return true;
    }
    __device__ __forceinline__ void a_ready(const Unit&) const {}
    __device__ __forceinline__ void done(const Unit&) const {}
};
template <class Epi, class Sched, bool ALIGN_EPI = false, bool SP2 = false>
__device__ __forceinline__ void gemm_phase(PG8_LAS unsigned char* lds, const Gemm g, const Sched& S, const Epi& E) {
    int tid_ = threadIdx.x; asm volatile("" : "+v"(tid_)); const int tid = tid_, wid = __builtin_amdgcn_readfirstlane(tid >> 6), lane = tid & 63, wr = wid >> 2, wc = wid & 3, fr = lane & 15, fq = lane >> 4;
    const int K = g.K, nt = K / BK;
    unsigned voffA[2], voffB[2];
#pragma unroll
    for (int i = 0; i < 2; ++i) { int R, C; stage_rc(tid * 16 + i * 8192, R, C); const int Rb = Epi::PERM ? ((R & ~31) + perm32(R & 31)) : R;
        voffA[i] = (unsigned)(R * K + C) * 2u; voffB[i] = (unsigned)(Rb * K + C) * 2u; }
    const size_t kstep = (size_t)(BK * 2);
    const size_t hstep = (size_t)HALF * K * 2;
    const size_t tstep = 2 * hstep;
    const unsigned ldsw = (unsigned)wid * 1024u;
    const int aoff = lds_byte(wr * 64 + fr, fq * 8), boff = lds_byte(wc * 32 + fr, fq * 8);
#define PG8_SA(b, h) (((b) * 2 + (h)) * HTB)
#define PG8_SB(b, h) ((4 + (b) * 2 + (h)) * HTB)
#define PG8_STAGE(bufoff, gbase, voff) do { _Pragma("unroll") for (int _i = 0; _i < 2; ++_i) \
        __builtin_amdgcn_global_load_lds((const unsigned*)((const char*)(gbase) + (voff)[_i]), (PG8_LAS unsigned*)(lds + (bufoff) + ldsw + _i * 8192), 16, 0, 0); } while (0)
#define PG8_LDA(dst, b, h) do { _Pragma("unroll") for (int m = 0; m < 4; ++m) _Pragma("unroll") for (int k = 0; k < 2; ++k) dst[m][k] = *(const PG8_LAS bf16x8*)(lds + PG8_SA(b, h) + aoff + m * 2048 + k * 1024); } while (0)
#define PG8_LDB(dst, b, h) do { _Pragma("unroll") for (int n = 0; n < 2; ++n) _Pragma("unroll") for (int k = 0; k < 2; ++k) dst[n][k] = *(const PG8_LAS bf16x8*)(lds + PG8_SB(b, h) + boff + n * 2048 + k * 1024); } while (0)
#define PG8_MMA(ai, bj, At, Bt) do { __builtin_amdgcn_s_setprio(1); _Pragma("unroll") for (int m = 0; m < 4; ++m) _Pragma("unroll") for (int n = 0; n < 2; ++n) _Pragma("unroll") for (int k = 0; k < 2; ++k) \
        acc[ai][bj][m][n] = __builtin_amdgcn_mfma_f32_16x16x32_f16(Bt[n][k], At[m][k], acc[ai][bj][m][n], 0, 0, 0); __builtin_amdgcn_s_setprio(0); } while (0)
#define PG8_WAIT_V(n) asm volatile("s_waitcnt vmcnt(" #n ")" ::: "memory")
#define PG8_WAIT_L(n) asm volatile("s_waitcnt lgkmcnt(" #n ")" ::: "memory")
#define PG8_BAR __builtin_amdgcn_s_barrier()
#define PG8_SCHED __builtin_amdgcn_sched_barrier(0)
    Unit cur, nxt; int ui = 0;
    if (!S.next(0, cur)) return;
    f32x4 acc[2][2][4][2];
#pragma unroll
    for (int a = 0; a < 2; ++a)
#pragma unroll
        for (int b = 0; b < 2; ++b)
#pragma unroll
            for (int m = 0; m < 4; ++m)
#pragma unroll
                for (int n = 0; n < 2; ++n) acc[a][b][m][n] = (f32x4){0.f, 0.f, 0.f, 0.f};
    bf16x8 At[4][2], B0[2][2], B1[2][2];
    const char* cA = (const char*)g.A + (size_t)cur.pm * tstep; const char* cB = (const char*)g.Bt + (size_t)cur.pn * tstep;
    S.a_ready(cur);
    if constexpr (SP2) {
        PG8_STAGE(PG8_SB(0, 0), cB, voffB); PG8_STAGE(PG8_SB(0, 1), cB + hstep, voffB); PG8_STAGE(PG8_SA(0, 0), cA, voffA); PG8_STAGE(PG8_SA(0, 1), cA + hstep, voffA);
        if (wr == 1) PG8_BAR;
        PG8_WAIT_V(2); PG8_BAR;
        PG8_STAGE(PG8_SB(1, 0), cB + kstep, voffB); PG8_STAGE(PG8_SA(1, 0), cA + kstep, voffA); PG8_STAGE(PG8_SB(1, 1), cB + hstep + kstep, voffB);
        PG8_WAIT_V(6); PG8_BAR;
    } else {
        PG8_STAGE(PG8_SB(0, 0), cB, voffB); PG8_STAGE(PG8_SA(0, 0), cA, voffA); PG8_STAGE(PG8_SB(0, 1), cB + hstep, voffB); PG8_STAGE(PG8_SA(0, 1), cA + hstep, voffA);
        if (wr == 1) PG8_BAR;
        PG8_WAIT_V(4); PG8_BAR;
        PG8_STAGE(PG8_SB(1, 0), cB + kstep, voffB); PG8_STAGE(PG8_SA(1, 0), cA + kstep, voffA); PG8_STAGE(PG8_SB(1, 1), cB + hstep + kstep, voffB);
        PG8_WAIT_V(6); PG8_BAR;
    }
    for (;;) {
        const bool has_next = S.next(ui + 1, nxt);
        const char* nA = has_next ? (const char*)g.A + (size_t)nxt.pm * tstep : cA; const char* nB = has_next ? (const char*)g.Bt + (size_t)nxt.pn * tstep : cB;
        for (int t = 0; t < nt; t += 2) {
            const bool last = (t == nt - 2);
            const char* a1 = cA + (size_t)(t + 1) * kstep;
            const char* a2 = last ? nA : cA + (size_t)(t + 2) * kstep; const char* b2 = last ? nB : cB + (size_t)(t + 2) * kstep;
            const char* a3 = a2 + kstep; const char* b3 = b2 + kstep;
            if (last && has_next) S.a_ready(nxt);
            if constexpr (SP2) {
            PG8_LDB(B0, 0, 0); PG8_LDB(B1, 0, 1); PG8_SCHED; PG8_LDA(At, 0, 0); PG8_STAGE(PG8_SA(1, 1), a1 + hstep, voffA);
            PG8_WAIT_V(8); PG8_WAIT_L(0); PG8_BAR; PG8_MMA(0, 0, At, B0); PG8_MMA(0, 1, At, B1); PG8_BAR; PG8_SCHED;
            PG8_LDA(At, 0, 1); PG8_STAGE(PG8_SB(0, 0), b2, voffB); PG8_STAGE(PG8_SB(0, 1), b2 + hstep, voffB); PG8_STAGE(PG8_SA(0, 0), a2, voffA);
            PG8_WAIT_V(8); PG8_WAIT_L(0); PG8_BAR; PG8_MMA(1, 0, At, B0); PG8_MMA(1, 1, At, B1); PG8_BAR; PG8_SCHED;
            PG8_LDB(B0, 1, 0); PG8_LDB(B1, 1, 1); PG8_SCHED; PG8_LDA(At, 1, 0); PG8_STAGE(PG8_SA(0, 1), a2 + hstep, voffA);
            PG8_WAIT_V(8); PG8_WAIT_L(0); PG8_BAR; PG8_MMA(0, 0, At, B0); PG8_MMA(0, 1, At, B1); PG8_BAR; PG8_SCHED;
            PG8_LDA(At, 1, 1); PG8_STAGE(PG8_SB(1, 0), b3, voffB); PG8_STAGE(PG8_SB(1, 1), b3 + hstep, voffB); PG8_STAGE(PG8_SA(1, 0), a3, voffA);
            PG8_WAIT_V(8); PG8_WAIT_L(0); PG8_BAR; PG8_MMA(1, 0, At, B0); PG8_MMA(1, 1, At, B1); PG8_BAR; PG8_SCHED;
            } else {
            PG8_LDB(B0, 0, 0); PG8_SCHED; PG8_LDA(At, 0, 0); PG8_STAGE(PG8_SA(1, 1), a1 + hstep, voffA);
            PG8_WAIT_L(8); PG8_BAR; PG8_WAIT_L(0); PG8_MMA(0, 0, At, B0); PG8_BAR; PG8_SCHED;
            PG8_LDB(B1, 0, 1); PG8_STAGE(PG8_SB(0, 0), b2, voffB);
            PG8_BAR; PG8_WAIT_L(0); PG8_MMA(0, 1, At, B1); PG8_BAR;
            PG8_LDA(At, 0, 1); PG8_STAGE(PG8_SA(0, 0), a2, voffA);
            PG8_BAR; PG8_WAIT_L(0); PG8_MMA(1, 0, At, B0); PG8_BAR; PG8_SCHED;
            PG8_STAGE(PG8_SB(0, 1), b2 + hstep, voffB);
            PG8_WAIT_V(6); PG8_BAR; PG8_MMA(1, 1, At, B1); PG8_BAR;
            PG8_LDB(B0, 1, 0); PG8_SCHED; PG8_LDA(At, 1, 0); PG8_STAGE(PG8_SA(0, 1), a2 + hstep, voffA);
            PG8_WAIT_L(8); PG8_BAR; PG8_WAIT_L(0); PG8_MMA(0, 0, At, B0); PG8_BAR; PG8_SCHED;
            PG8_LDB(B1, 1, 1); PG8_STAGE(PG8_SB(1, 0), b3, voffB);
            PG8_BAR; PG8_WAIT_L(0); PG8_MMA(0, 1, At, B1); PG8_BAR;
            PG8_LDA(At, 1, 1); PG8_STAGE(PG8_SA(1, 0), a3, voffA);
            PG8_BAR; PG8_WAIT_L(0); PG8_MMA(1, 0, At, B0); PG8_BAR; PG8_SCHED;
            PG8_STAGE(PG8_SB(1, 1), b3 + hstep, voffB);
            PG8_WAIT_V(6); PG8_BAR; PG8_MMA(1, 1, At, B1); PG8_BAR;
            }
        }
        if constexpr (ALIGN_EPI) { if (wr == 0) PG8_BAR; }
        if constexpr (!Epi::AFTER_DRAIN) { E(acc, cur, wr, wc, fr, fq); S.done(cur); }
        if (!has_next) break;
#pragma unroll
        for (int a = 0; a < 2; ++a)
#pragma unroll
            for (int b = 0; b < 2; ++b)
#pragma unroll
                for (int m = 0; m < 4; ++m)
#pragma unroll
                    for (int n = 0; n < 2; ++n) acc[a][b][m][n] = (f32x4){0.f, 0.f, 0.f, 0.f};
        cur = nxt; cA = nA; cB = nB; ++ui;
        if constexpr (ALIGN_EPI) { if (wr == 1) PG8_BAR; }
    }
    PG8_WAIT_V(0);
    if constexpr (!ALIGN_EPI) { if (wr == 0) PG8_BAR; }
    PG8_BAR;
    if constexpr (Epi::AFTER_DRAIN) { E.fused(acc, cur, wr, wc, fr, fq, lds, wid, lane); S.done(cur); }
#undef PG8_SA
#undef PG8_SB
#undef PG8_STAGE
#undef PG8_LDA
#undef PG8_LDB
#undef PG8_MMA
#undef PG8_WAIT_V
#undef PG8_WAIT_L
#undef PG8_BAR
#undef PG8_SCHED
}
}
#define GAS __attribute__((address_space(1)))
#define LAS __attribute__((address_space(3)))
typedef unsigned short bf16;
typedef unsigned v4u __attribute__((ext_vector_type(4)));
typedef float f32x4 __attribute__((ext_vector_type(4)));
typedef short bf16x8 __attribute__((ext_vector_type(8)));
typedef GAS unsigned gu32;
typedef GAS unsigned long long gu64;
#define RLX_AGENT __ATOMIC_RELAXED, __HIP_MEMORY_SCOPE_AGENT
#define LDS_WAIT() asm volatile("s_waitcnt lgkmcnt(0)" ::: "memory")
#define VM_WAIT() asm volatile("s_waitcnt vmcnt(0)" ::: "memory")
__device__ __forceinline__ unsigned long long rt() { return __builtin_amdgcn_s_memrealtime(); }
__device__ __forceinline__ unsigned f2bf(float f) { unsigned u = __builtin_bit_cast(unsigned, f); return (u + 0x7fffu + ((u >> 16) & 1u)) >> 16; }
__device__ __forceinline__ unsigned pk2(float lo, float hi) { return f2bf(lo) | (f2bf(hi) << 16); }

#define XB_TMO      128
#define XB_XCNT(j)  (256  + 64 * (j))
#define XB_XSUB(j)  (1280 + 64 * (j))
#define XB_XGEN(j)  (2304 + 64 * (j))
#define XB_TOP      3328
#define XB_TOPGEN   3392
#define XCD_BAR_WORDS 3456
#define XB_SPIN_CAP (1u << 18)

__device__ __forceinline__ unsigned xb_ld(unsigned* p)              { return __hip_atomic_load(p, __ATOMIC_RELAXED, __HIP_MEMORY_SCOPE_AGENT); }
__device__ __forceinline__ unsigned xb_add(unsigned* p, unsigned v) { return __hip_atomic_fetch_add(p, v, __ATOMIC_RELAXED, __HIP_MEMORY_SCOPE_AGENT); }
__device__ __forceinline__ unsigned xb_xcc_id() { return (unsigned)__builtin_amdgcn_s_getreg((3 << 11) | 20) & 0xFu; }
#define XB_SPIN(cond, bar) do { unsigned _sp = 0; while (cond) { __builtin_amdgcn_s_sleep(1); \
    if ((++_sp & 255u) == 0u) { if (xb_ld(&(bar)[XB_TMO])) break; if (_sp > XB_SPIN_CAP) { atomicAdd(&(bar)[XB_TMO], 1u); break; } } } } while (0)

struct XcdBarrier {
    unsigned* bar; unsigned x;
    volatile LAS unsigned* st;
};

__device__ __forceinline__ XcdBarrier xcd_barrier_post(unsigned* bar, volatile LAS unsigned* st) {
    XcdBarrier b; b.bar = bar; b.x = xb_xcc_id(); b.st = st;
    if (threadIdx.x == 0) (void)xb_add(&bar[XB_XCNT(b.x)], 1u);
    return b;
}
__device__ __forceinline__ void xcd_barrier_complete(unsigned* bar, unsigned x, unsigned& nloc, unsigned& nx) {
    const unsigned G = gridDim.x * gridDim.y * gridDim.z;
    unsigned sum, cnt, mine, sp = 0u;
    for (;;) {
        sum = 0u; cnt = 0u; mine = 0u;
#pragma unroll
        for (unsigned j = 0; j < 16; ++j) { const unsigned c = xb_ld(&bar[XB_XCNT(j)]); sum += c; cnt += (c > 0u) ? 1u : 0u; mine = (j == x) ? c : mine; }
        if (sum == G) break;
        __builtin_amdgcn_s_sleep(1);
        if ((++sp & 255u) == 0u) { if (xb_ld(&bar[XB_TMO])) break; if (sp > XB_SPIN_CAP) { atomicAdd(&bar[XB_TMO], 1u); break; } }
    }
    nloc = mine > 0u ? mine : 1u; nx = cnt > 0u ? cnt : 1u;
}

__device__ __forceinline__ void xcd_barrier(const XcdBarrier& b) {
    asm volatile("s_waitcnt vmcnt(0)" ::: "memory");
    __syncthreads();
    if (threadIdx.x == 0) {
        unsigned* bar = b.bar;
        __builtin_amdgcn_s_waitcnt(0);
        unsigned nloc = b.st[0], nx = b.st[1];
        if (nloc == 0u) { xcd_barrier_complete(bar, b.x, nloc, nx); b.st[0] = nloc; b.st[1] = nx; }
        const unsigned old = xb_add(&bar[XB_XSUB(b.x)], 1u);
        const unsigned gen = old / nloc;
        if (old + 1u == (gen + 1u) * nloc) {
            __builtin_amdgcn_fence(__ATOMIC_RELEASE, "agent");
            asm volatile("s_waitcnt vmcnt(0)" ::: "memory");
            const unsigned og = xb_add(&bar[XB_TOP], 1u);
            const unsigned tg = og / nx;
            if (og + 1u == (tg + 1u) * nx) xb_add(&bar[XB_TOPGEN], 1u);
            else XB_SPIN(xb_ld(&bar[XB_TOPGEN]) == tg, bar);
            __builtin_amdgcn_fence(__ATOMIC_ACQUIRE, "agent");
            xb_add(&bar[XB_XGEN(b.x)], 1u);
            asm volatile("s_waitcnt vmcnt(0)" ::: "memory");
        } else {
            XB_SPIN(xb_ld(&bar[XB_XGEN(b.x)]) == gen, bar);
            __builtin_amdgcn_fence(__ATOMIC_ACQUIRE, "agent");
            asm volatile("s_waitcnt vmcnt(0)" ::: "memory");
        }
    }
    __syncthreads();
}
typedef _Float16 h16;
typedef _Float16 h16x8 __attribute__((ext_vector_type(8)));
typedef _Float16 h16x2 __attribute__((ext_vector_type(2)));
typedef float f32x16 __attribute__((ext_vector_type(16)));
typedef unsigned u32x4 __attribute__((ext_vector_type(4)));
typedef unsigned u32x2 __attribute__((ext_vector_type(2)));
constexpr int NB = 2, SEQ = 8192, M = NB * SEQ, D = 1024, DIN = 5376, DRW = 1792, DQKV = 1536, DG = 2048, DFF = 4096, DH = 512, DLO = 1536;
constexpr float ALPHA = 1.189207115002721f;
constexpr float QSCALE = 0.125f * 1.4426950408889634f;
constexpr float LN_EPS = 1e-5f, ADA_EPS = 1e-6f, GN_EPS = 64e-5f;
constexpr size_t MiB = 1u << 20, KiB = 1u << 10;
constexpr size_t WS_CTL = 0, CTL_ZERO_BYTES = 1 * MiB;
constexpr size_t WS_ADAP = 1 * MiB, WS_ADA = 1 * MiB + 896 * KiB, WS_BON = 2 * MiB;
constexpr size_t WS_WIN = 3 * MiB, WS_WLORA = 13 * MiB + 512 * KiB, WS_WBA = 14 * MiB + 256 * KiB, WS_WBB = 15 * MiB + 256 * KiB, WS_WOUT = 16 * MiB + 256 * KiB,
                 WS_W1 = 18 * MiB + 256 * KiB, WS_W2 = 26 * MiB + 256 * KiB;
constexpr size_t WS_H16 = 36 * MiB, WS_ZRW = 68 * MiB, WS_QKV = 124 * MiB, WS_LOUT = 172 * MiB, WS_LIN = 220 * MiB, WS_PB = 124 * MiB, WS_RB = 156 * MiB, WS_QB = 220 * MiB, WS_MRG = 68 * MiB, WS_HID = 68 * MiB, WS_END = 252 * MiB;
constexpr int CW_ATTQ = 64, CW_BAR = 4096;
constexpr int RING_BYTES = 131072, MISC_OFF = RING_BYTES + 64, LDS_BYTES = RING_BYTES + 512;
constexpr int NATT = 16 * 256, NPRE = 16 * 256, NCHAINB = 16;

struct KArgs { const float* in[27]; float* out; unsigned char* ws; };
struct P {
    const float *x, *c, *w_ada, *b_ada, *w_in, *mu, *w0, *w2, *a0, *a2, *g2, *kk, *ka, *rk, *gn_g, *gn_b, *wba, *wbb, *wout, *ln1g, *ln1b, *w1, *b1, *wf2, *b2, *ln2g, *ln2b;
    float* out; unsigned char* ws;
    unsigned* ctl; float *adap, *ada, *bon;
    h16 *pbuf, *rbuf, *vt; unsigned* qbuf; h16 *win_t, *wlora_t, *wba_t, *wbb_t, *wout_t, *w1_t, *w2_t, *h, *zrw, *qkv, *lin, *lout, *mrg, *hid, *ya, *ob, *gates;
};

__device__ __forceinline__ unsigned pkh(float a, float b) { h16x2 v = {(h16)a, (h16)b}; return __builtin_bit_cast(unsigned, v); }
__device__ __forceinline__ void store8h(h16* p, const f32x4& v0, const f32x4& v1) { u32x4 w; w.x = pkh(v0.x, v0.y); w.y = pkh(v0.z, v0.w); w.z = pkh(v1.x, v1.y); w.w = pkh(v1.z, v1.w); *(u32x4*)p = w; }
__device__ __forceinline__ void load8h(const h16* p, f32x4& v0, f32x4& v1) { const h16x8 t = *(const h16x8*)p; v0 = (f32x4){(float)t[0], (float)t[1], (float)t[2], (float)t[3]}; v1 = (f32x4){(float)t[4], (float)t[5], (float)t[6], (float)t[7]}; }
__device__ __forceinline__ float sigmoidf_(float x) { return __builtin_amdgcn_rcpf(1.0f + __expf(-x)); }
template <int CTRL> __device__ __forceinline__ float dppmov(float x) { return __builtin_bit_cast(float, __builtin_amdgcn_update_dpp(0, __builtin_bit_cast(int, x), CTRL, 0xf, 0xf, true)); }
__device__ __forceinline__ float red16(float v) { v += dppmov<0xB1>(v); v += dppmov<0x4E>(v); v += dppmov<0x124>(v); v += dppmov<0x128>(v); return v; }

__device__ __forceinline__ float wave_sum(float v) {
    v = red16(v);
    const int b = __builtin_bit_cast(int, v);
    return (__builtin_bit_cast(float, __builtin_amdgcn_readlane(b, 0)) + __builtin_bit_cast(float, __builtin_amdgcn_readlane(b, 16))) +
           (__builtin_bit_cast(float, __builtin_amdgcn_readlane(b, 32)) + __builtin_bit_cast(float, __builtin_amdgcn_readlane(b, 48)));
}
template <class F> struct EpiGen {
    static constexpr bool PERM = true, AFTER_DRAIN = false;
    F f;
    __device__ __forceinline__ void operator()(const f32x4 (&acc)[2][2][4][2], const pg8::Unit& u, int wr, int wc, int fr, int fq) const {
        const int row0 = u.pm * 256 + wr * 64 + fr, col0 = u.pn * 256 + wc * 32 + 8 * fq;
#pragma unroll
        for (int ai = 0; ai < 2; ++ai)
#pragma unroll
            for (int m = 0; m < 4; ++m)
#pragma unroll
                for (int bj = 0; bj < 2; ++bj) f(row0 + ai * 128 + m * 16, col0 + bj * 128, acc[ai][bj][m][0], acc[ai][bj][m][1]);
    }
};
struct F1 {
    h16 *zrw, *qkv, *gates;
    __device__ __forceinline__ void operator()(int row, int col, f32x4 v0, f32x4 v1) const {
        if (col < DRW) store8h(zrw + (size_t)row * DRW + col, v0, v1);
        else if (col < DRW + DQKV) { const int c = col - DRW; if (c < 512) { v0 = v0 * QSCALE; v1 = v1 * QSCALE; } store8h(qkv + (size_t)row * DQKV + c, v0, v1); }
        else { const int c = col - DRW - DQKV;
#pragma unroll
            for (int i = 0; i < 4; ++i) { v0[i] = sigmoidf_(v0[i]); v1[i] = sigmoidf_(v1[i]); }
            store8h(gates + (size_t)row * DG + c, v0, v1); }
    }
};
struct F3 {
    h16* lout;
    __device__ __forceinline__ void operator()(int row, int col, f32x4 v0, f32x4 v1) const { store8h(lout + (size_t)row * DLO + col, v0, v1); }
};
struct F5Y { h16* gates;
    __device__ __forceinline__ void operator()(int row, int col, f32x4 v0, f32x4 v1) const {
        f32x4 g0, g1; h16* gp = gates + (size_t)row * DG + 1024 + col; load8h(gp, g0, g1); store8h(gp, v0 * g0, v1 * g1); } };
struct F5X { h16* mrg; const h16* gates;
    __device__ __forceinline__ void operator()(int row, int col, f32x4 v0, f32x4 v1) const {
        f32x4 g0, g1, m0, m1; load8h(gates + (size_t)row * DG + col, g0, g1); load8h(gates + (size_t)row * DG + 1024 + col, m0, m1); store8h(mrg + (size_t)row * D + col, m0 + v0 * g0, m1 + v1 * g1); } };
struct F6 { const float* x; float* out; const float* ada;
    __device__ __forceinline__ void operator()(int row, int col, f32x4 v0, f32x4 v1) const {
        const float* g = ada + (row >> 13) * 6144 + 2048 + col; const size_t o = (size_t)row * D + col;
        const f32x4 x0 = *(const f32x4*)(x + o), x1 = *(const f32x4*)(x + o + 4), g0 = *(const f32x4*)g, g1 = *(const f32x4*)(g + 4);
        *(f32x4*)(out + o) = x0 * ALPHA + g0 * v0; *(f32x4*)(out + o + 4) = x1 * ALPHA + g1 * v1; } };
struct F8 { h16* hid; const float* b1;
    __device__ __forceinline__ void operator()(int row, int col, f32x4 v0, f32x4 v1) const {
        const f32x4 c0 = *(const f32x4*)(b1 + col), c1 = *(const f32x4*)(b1 + col + 4);
#pragma unroll
        for (int i = 0; i < 4; ++i) { float a = fmaxf(v0[i] + c0[i], 0.f); v0[i] = a * a; a = fmaxf(v1[i] + c1[i], 0.f); v1[i] = a * a; }
        store8h(hid + (size_t)row * DFF + col, v0, v1); } };
struct F9 { float* out; const float* ada; const float* b2;
    __device__ __forceinline__ void operator()(int row, int col, f32x4 v0, f32x4 v1) const {
        const float* g = ada + (row >> 13) * 6144 + 5120 + col; const size_t o = (size_t)row * D + col;
        const f32x4 x0 = *(const f32x4*)(out + o), x1 = *(const f32x4*)(out + o + 4), g0 = *(const f32x4*)g, g1 = *(const f32x4*)(g + 4), c0 = *(const f32x4*)(b2 + col), c1 = *(const f32x4*)(b2 + col + 4);
        *(f32x4*)(out + o) = x0 * ALPHA + g0 * (v0 + c0); *(f32x4*)(out + o + 4) = x1 * ALPHA + g1 * (v1 + c1); } };

template <class F> __device__ __forceinline__ void run_gemm(LAS unsigned char* lds, const h16* A, const h16* Bt, int N, int K, const F& f, int gsz = -1, int gidx = -1) {
    asm volatile("" : "+s"(N), "+s"(K));
    if (gsz < 0) { gsz = (int)gridDim.x; gidx = (int)blockIdx.x; }
    pg8::Gemm g{(const pg8::bf16_t*)A, (const pg8::bf16_t*)Bt, M, N, K}; pg8::StaticOrder S; S.init(M, N, gsz, gidx);
    EpiGen<F> E{f};
    pg8::gemm_phase<EpiGen<F>, pg8::StaticOrder, true, true>(lds, g, S, E);
}

__device__ __forceinline__ void p0_transpose_item(const float* W, int K, int N, h16* WT, LAS float* scr, int item, int lane) {
    const int nblk = N / 32, kb = item / nblk, nb = item % nblk, k0 = 64 * kb, n0 = 32 * nb;
#pragma unroll 8
    for (int i = 0; i < 32; ++i) { const int kk = 2 * i + (lane >> 5); scr[kk * 33 + (lane & 31)] = W[(size_t)(k0 + kk) * N + n0 + (lane & 31)]; }
    LDS_WAIT(); asm volatile("" ::: "memory");
    const int c = lane & 7;
#pragma unroll
    for (int j = 0; j < 4; ++j) { const int n = (lane >> 3) + 8 * j; const LAS float* s = scr + (8 * c) * 33 + n;
        u32x4 o; o.x = pkh(s[0 * 33], s[1 * 33]); o.y = pkh(s[2 * 33], s[3 * 33]); o.z = pkh(s[4 * 33], s[5 * 33]); o.w = pkh(s[6 * 33], s[7 * 33]);
        *(u32x4*)(WT + (size_t)(n0 + n) * K + k0 + 8 * c) = o; }
    LDS_WAIT(); asm volatile("" ::: "memory");
}
__device__ __forceinline__ void phase0(const P& p, LAS unsigned char* lds, int tid, int lane, int wave) {
    LAS float* scr = (LAS float*)(lds + wave * 16384);
    const int G = gridDim.x, gw = blockIdx.x * 8 + wave, NGW = G * 8;
    constexpr int I_IN = (D / 64) * (DIN / 32), I_BA = (DH / 64) * (D / 32), I_OUT = (D / 64) * (D / 32), I_1 = (D / 64) * (DFF / 32), I_2 = (DFF / 64) * (D / 32);
    constexpr int NITEMS = I_IN + 2 * I_BA + I_OUT + I_1 + I_2;
    for (int it = gw; it < I_IN + I_BA; it += NGW) {
        int r = it;
        if (r < I_IN) { p0_transpose_item(p.w_in, D, DIN, p.win_t, scr, r, lane); continue; } r -= I_IN;
        p0_transpose_item(p.wbb, DH, D, p.wbb_t, scr, r, lane);
    }
    for (int idx = blockIdx.x * 512 + tid; idx < DLO * 256; idx += G * 512) {
        const int n = idx >> 8, k = idx & 255; float v = 0.f;
        if (n < 512) { if (k < 64) v = p.w2[k * 512 + n]; }
        else if (n < 1024) { if (k >= 64 && k < 128) v = p.a2[(k - 64) * 512 + n - 512]; }
        else { if (k >= 128) v = p.g2[(k - 128) * 512 + n - 1024]; }
        p.wlora_t[idx] = (h16)v;
    }
    for (int u = blockIdx.x; u < 192; u += G) {
        const int slice = u / 12, n = (u % 12) * 512 + tid; float a0 = 0.f, a1 = 0.f;
#pragma unroll 8
        for (int kk = 0; kk < 64; ++kk) { const int k = slice * 64 + kk; const float c0 = p.c[k], c1 = p.c[1024 + k], w = p.w_ada[(size_t)k * 6144 + n];
            a0 += c0 * sigmoidf_(c0) * w; a1 += c1 * sigmoidf_(c1) * w; }
        p.adap[(slice * 2 + 0) * 6144 + n] = a0; p.adap[(slice * 2 + 1) * 6144 + n] = a1;
    }
}
__device__ __forceinline__ void phase0_late(const P& p, LAS unsigned char* lds, int lane, int wave, int gsz, int gidx) {
    LAS float* scr = (LAS float*)(lds + wave * 16384);
    const int gw = gidx * 8 + wave, NGW = gsz * 8;
    constexpr int I_BA = (DH / 64) * (D / 32), I_OUT = (D / 64) * (D / 32), I_1 = (D / 64) * (DFF / 32), I_2 = (DFF / 64) * (D / 32);
    for (int it = gw; it < I_BA + I_OUT + I_1 + I_2; it += NGW) {
        int r = it;
        if (r < I_BA) { p0_transpose_item(p.wba, DH, D, p.wba_t, scr, r, lane); continue; } r -= I_BA;
        if (r < I_OUT) { p0_transpose_item(p.wout, D, D, p.wout_t, scr, r, lane); continue; } r -= I_OUT;
        if (r < I_1) { p0_transpose_item(p.w1, D, DFF, p.w1_t, scr, r, lane); continue; } r -= I_1;
        p0_transpose_item(p.wf2, DFF, D, p.w2_t, scr, r, lane);
    }
}
__device__ __forceinline__ void phase0b(const P& p, LAS unsigned char* lds, int tid, int lane, int wave) {
    LAS float* mod = (LAS float*)lds;
    for (int i = tid; i < 4096; i += 512) { const int b = i >> 11, j = i & 2047; float s = p.b_ada[j];
#pragma unroll
        for (int sl = 0; sl < 16; ++sl) s += p.adap[(sl * 2 + b) * 6144 + j];
        mod[i] = s; }
    if (blockIdx.x == 0) for (int i = tid; i < 2 * 6144; i += 512) { const int b = i / 6144, j = i % 6144; float s = p.b_ada[j];
#pragma unroll
        for (int sl = 0; sl < 16; ++sl) s += p.adap[(sl * 2 + b) * 6144 + j];
        p.ada[i] = s; }
    __syncthreads();
    const int gw = blockIdx.x * 8 + wave, NGW = gridDim.x * 8;
    for (int m = gw; m < M; m += NGW) {
        const f32x4* xr = (const f32x4*)(p.x + (size_t)m * D) + lane; const int b = m >> 13;
        f32x4 v[4]; float s = 0.f;
#pragma unroll
        for (int j = 0; j < 4; ++j) { v[j] = xr[64 * j]; s += (v[j].x + v[j].y) + (v[j].z + v[j].w); }
        const float mean = wave_sum(s) * (1.f / D); float s2 = 0.f;
#pragma unroll
        for (int j = 0; j < 4; ++j) { v[j] = v[j] - mean; s2 += (v[j].x * v[j].x + v[j].y * v[j].y) + (v[j].z * v[j].z + v[j].w * v[j].w); }
        const float rstd = 1.f / sqrtf(wave_sum(s2) * (1.f / D) + ADA_EPS);
        uint2* o8 = (uint2*)(p.h + (size_t)m * D) + lane;
#pragma unroll
        for (int j = 0; j < 4; ++j) { const int col = 4 * (lane + 64 * j); const f32x4 sh = *(const LAS f32x4*)(mod + b * 2048 + col), sc = *(const LAS f32x4*)(mod + b * 2048 + 1024 + col);
            const f32x4 r = v[j] * rstd * (sc + 1.0f) + sh; uint2 w; w.x = pkh(r.x, r.y); w.y = pkh(r.z, r.w); o8[64 * j] = w; }
    }
}
__device__ __forceinline__ void phase2(const P& p, int tid) {
    for (int idx = blockIdx.x * 512 + tid; idx < M * 32; idx += gridDim.x * 512) {
        const int t = idx >> 5, j8 = (idx & 31) * 8, col = 1536 + j8;
        f32x4 c0, c1, q0 = {0.f, 0.f, 0.f, 0.f}, q1 = {0.f, 0.f, 0.f, 0.f};
        load8h(p.zrw + (size_t)t * DRW + col, c0, c1); if (t & (SEQ - 1)) load8h(p.zrw + (size_t)(t - 1) * DRW + col, q0, q1);
        const f32x4 m0 = *(const f32x4*)(p.mu + col), m1 = *(const f32x4*)(p.mu + col + 4);
        c0 = c0 + m0 * (q0 - c0); c1 = c1 + m1 * (q1 - c1);
#pragma unroll
        for (int i = 0; i < 4; ++i) { if (j8 < 64) { c0[i] = tanhf(c0[i]); c1[i] = tanhf(c1[i]); } else if (j8 >= 128) { c0[i] = sigmoidf_(c0[i]); c1[i] = sigmoidf_(c1[i]); } }
        store8h(p.lin + (size_t)t * 256 + j8, c0, c1);
    }
}
constexpr int P64 = 72, P32 = 40;
constexpr int L_AM = 0, L_BM = 4608, L_KM = 9216, L_RM = 13824, L_AMT = 18432, L_BMT = 23552, L_KMT = 28672, L_VT = 33792, L_NR0 = 38912, L_NR1 = 41472, L_NT0 = 44032, L_NT1 = 46592,
              L_TR0 = 49152, L_TR1 = 51712, L_AAK = 54272, L_ARB = 56832, L_ARK = 59392, L_W1T = 61952, L_UT = 67072, L_TAT = 72192, L_CUM = 77312, L_GM = 85504, L_GL = 85760;
__device__ __forceinline__ int crow(int r, int hi) { return (r & 3) + 8 * (r >> 2) + 4 * hi; }
template <int KS> __device__ __forceinline__ f32x16 mm_tile(LAS unsigned char* A, int arow, int apitch, LAS unsigned char* B, int brow, int bpitch, f32x16 acc, int hi) {
#pragma unroll
    for (int s = 0; s < KS; ++s) { const h16x8 a = *(const LAS h16x8*)(A + (arow * apitch + 16 * s + 8 * hi) * 2), b = *(const LAS h16x8*)(B + (brow * bpitch + 16 * s + 8 * hi) * 2);
        acc = __builtin_amdgcn_mfma_f32_32x32x16_f16(a, b, acc, 0, 0, 0); }
    return acc;
}
__device__ __forceinline__ void wr_row(LAS unsigned char* arr, const f32x16& v, int n, int hi) {
#pragma unroll
    for (int r = 0; r < 16; ++r) ((LAS h16*)arr)[crow(r, hi) * P32 + n] = (h16)v[r];
}
__device__ __forceinline__ void wr_tr(LAS unsigned char* arr, const f32x16& v, int nrow, int hi) {
#pragma unroll
    for (int jj = 0; jj < 4; ++jj) { u32x2 w; w.x = pkh(v[4 * jj], v[4 * jj + 1]); w.y = pkh(v[4 * jj + 2], v[4 * jj + 3]); *(LAS u32x2*)(arr + (nrow * P32 + 8 * jj + 4 * hi) * 2) = w; }
}
__device__ __forceinline__ f32x16 zero16() { f32x16 z;
#pragma unroll
    for (int r = 0; r < 16; ++r) z[r] = 0.f;
    return z; }
constexpr int S_AM = 0, S_BM = 4608, S_KM = 9216, S_RM = 13824, S_AMT = 18432, S_BMT = 23552, S_KMT = 28672, S_VT = 33792, S_GM = 38912, S_GL = 39168, S_GF = 39424, SET_BYTES = 39680;
constexpr int X_NR0 = 79360, X_NR1 = X_NR0 + 2560, X_NT0 = X_NR0 + 5120, X_NT1 = X_NR0 + 7680, X_TR0 = X_NR0 + 10240, X_TR1 = X_NR0 + 12800, X_AAK = X_NR0 + 15360, X_ARB = X_NR0 + 17920, X_ARK = X_NR0 + 20480, X_W1T = X_NR0 + 23040, X_UT = X_NR0 + 28160, X_TAT = X_NR0 + 33280, X_CUM = X_NR0 + 38400;
static_assert(2 * SET_BYTES <= X_NR0 && X_CUM + 1024 <= RING_BYTES, "pre_phase LDS map");
#define PB_BAR() asm volatile("s_waitcnt lgkmcnt(0)\n\ts_barrier" ::: "memory")
__device__ __forceinline__ void pre_phase(const P& p, LAS unsigned char* sm, int lane, int wave) {
    const int G = (int)gridDim.x, nun = ((int)blockIdx.x < NPRE) ? (NPRE - (int)blockIdx.x + G - 1) / G : 0, r32 = lane & 31, hi = lane >> 5;
    LAS float* CUM = (LAS float*)(sm + X_CUM);
    if (wave >= 4) {
        const int pw = wave - 4;
        for (int k = 0; k <= nun; ++k) {
            float av[8], bv[8], kv[8], rv[8], vv[8], lwv[8], cumv[8];
            LAS unsigned char* set = sm + (k & 1) * SET_BYTES;
            if (k < nun) {
                const int unit = (int)blockIdx.x + k * G, bh = unit >> 8, c = unit & 255, b = bh >> 3, h = bh & 7, col = h * 64 + lane;
                const float mu_r = p.mu[col], mu_k = p.mu[512 + col], mu_v = p.mu[1024 + col], ckk = p.kk[col], cka = p.ka[col], crk = p.rk[col], cw0 = p.w0[col], ca0 = p.a0[col];
                float zr0[8], zk0[8], zv0[8], zr1[8], zk1[8], zv1[8], lo0[8], lo1[8], bonv[8];
                const size_t gm0 = (size_t)b * SEQ + c * 32 + pw * 8;
#pragma unroll
                for (int i = 0; i < 8; ++i) {
                    const int t = c * 32 + pw * 8 + i; const size_t gm = gm0 + i, gp = gm - (t > 0 ? 1 : 0);
                    const h16* zr = p.zrw + gm * DRW; const h16* zp = p.zrw + gp * DRW; const h16* lo = p.lout + gm * DLO;
                    zr0[i] = (float)zr[col]; zk0[i] = (float)zr[512 + col]; zv0[i] = (float)zr[1024 + col];
                    zr1[i] = (float)zp[col]; zk1[i] = (float)zp[512 + col]; zv1[i] = (float)zp[1024 + col];
                    lo0[i] = (float)lo[col]; lo1[i] = (float)lo[512 + col];
                }
#pragma unroll
                for (int i = 0; i < 8; ++i) {
                    const int t = c * 32 + pw * 8 + i; const float pm = t > 0 ? 1.f : 0.f;
                    float r = zr0[i], kx = zk0[i], v = zv0[i];
                    r += mu_r * (pm * zr1[i] - r); kx += mu_k * (pm * zk1[i] - kx); v += mu_v * (pm * zv1[i] - v);
                    const float xw = -(cw0 + lo0[i]), spw = fmaxf(xw, 0.f) + __logf(1.f + __expf(-fabsf(xw))), ar = sigmoidf_(ca0 + lo1[i]);
                    const float lw = -__expf(-spw - 0.5f);
                    const float kkv = kx * ckk, kkn = kkv * __builtin_amdgcn_rsqf(fmaxf(wave_sum(kkv * kkv), 1e-24f));
                    const float k2 = kx * (1.0f + (ar - 1.0f) * cka);
                    bonv[i] = wave_sum(r * k2 * crk);
                    av[i] = -kkn; bv[i] = kkn * ar; kv[i] = k2; rv[i] = r; vv[i] = v; lwv[i] = lw;
                }
                if (lane < 8) { float bsel = bonv[0];
#pragma unroll
                    for (int i = 1; i < 8; ++i) bsel = (lane == i) ? bonv[i] : bsel;
                    p.bon[(gm0 + lane) * 8 + h] = bsel; }
                cumv[0] = lwv[0];
#pragma unroll
                for (int i = 1; i < 8; ++i) cumv[i] = cumv[i - 1] + lwv[i];
                CUM[pw * 64 + lane] = cumv[7];
            }
            PB_BAR();
            if (k < nun) {
                const float t0 = CUM[lane], t1 = CUM[64 + lane], t2 = CUM[128 + lane], t3 = CUM[192 + lane];
                const float mid = t0 + t1, tot = (t0 + t1) + (t2 + t3), off = (pw > 0 ? t0 : 0.f) + (pw > 1 ? t1 : 0.f) + (pw > 2 ? t2 : 0.f);
                if (pw == 0) { ((LAS float*)(set + S_GM))[lane] = __expf(mid); ((LAS float*)(set + S_GL))[lane] = __expf(tot); ((LAS float*)(set + S_GF))[lane] = __expf(tot - mid); }
#pragma unroll
                for (int i = 0; i < 8; ++i) { const int tt = pw * 8 + i; const float cum = off + cumv[i], cp = cum - lwv[i];
                    const float e1 = __expf(mid - cum);
                    const h16 am = (h16)(av[i] * __expf(cp - mid)), bm = (h16)(bv[i] * e1), km = (h16)(kv[i] * e1), rm = (h16)(rv[i] * __expf(cum - mid));
                    ((LAS h16*)(set + S_AM))[tt * P64 + lane] = am; ((LAS h16*)(set + S_BM))[tt * P64 + lane] = bm; ((LAS h16*)(set + S_KM))[tt * P64 + lane] = km; ((LAS h16*)(set + S_RM))[tt * P64 + lane] = rm;
                    ((LAS h16*)(set + S_AMT))[lane * P32 + tt] = am; ((LAS h16*)(set + S_BMT))[lane * P32 + tt] = bm; ((LAS h16*)(set + S_KMT))[lane * P32 + tt] = km; ((LAS h16*)(set + S_VT))[lane * P32 + tt] = (h16)vv[i]; }
            }
            PB_BAR();
            PB_BAR();
        }
    } else {
        for (int k = 0; k <= nun; ++k) {
            const int unit = (int)blockIdx.x + (k - 1) * G, bh = unit >> 8, c = unit & 255, b = bh >> 3, h = bh & 7;
            LAS unsigned char* set = sm + ((k - 1) & 1) * SET_BYTES;
            LAS float* GM = (LAS float*)(set + S_GM); LAS float* GL = (LAS float*)(set + S_GL); LAS float* GF = (LAS float*)(set + S_GF);
            if (k >= 1) {
                f32x16 acc = mm_tile<4>(set + (wave < 2 ? S_AM : S_RM), r32, P64, set + ((wave & 1) ? S_KM : S_BM), r32, P64, zero16(), hi);
#pragma unroll
                for (int r = 0; r < 16; ++r) { const int t = crow(r, hi); const bool keep = (wave < 2) ? (r32 < t) : (r32 <= t); acc[r] = keep ? acc[r] : 0.f; }
                if (wave == 0) {
                    wr_row(sm + X_NR0, acc, r32, hi); wr_tr(sm + X_NT0, acc, r32, hi);
                    f32x16 tacc = acc;
#pragma unroll
                    for (int r = 0; r < 16; ++r) if (crow(r, hi) == r32) tacc[r] += 1.0f;
                    wr_row(sm + X_TR0, tacc, r32, hi);
#pragma unroll
                    for (int i = 0; i < 4; ++i) {
                        LAS unsigned char* nr = sm + ((i & 1) ? X_NR1 : X_NR0); LAS unsigned char* nt = sm + ((i & 1) ? X_NT1 : X_NT0);
                        LAS unsigned char* nr2 = sm + ((i & 1) ? X_NR0 : X_NR1); LAS unsigned char* nt2 = sm + ((i & 1) ? X_NT0 : X_NT1);
                        LAS unsigned char* tr = sm + ((i & 1) ? X_TR1 : X_TR0); LAS unsigned char* tr2 = sm + ((i & 1) ? X_TR0 : X_TR1);
                        const f32x16 nacc = mm_tile<2>(nr, r32, P32, nt, r32, P32, zero16(), hi);
                        wr_row(nr2, nacc, r32, hi); wr_tr(nt2, nacc, r32, hi);
                        tacc = mm_tile<2>(tr, r32, P32, nt2, r32, P32, tacc, hi);
                        wr_row(tr2, tacc, r32, hi);
                    }
                } else if (wave == 1) {
                    wr_row(sm + X_AAK, acc, r32, hi);
#pragma unroll
                    for (int vt = 0; vt < 2; ++vt) { const f32x16 w1 = mm_tile<2>(sm + X_AAK, r32, P32, set + S_VT, 32 * vt + r32, P32, zero16(), hi); wr_tr(sm + X_W1T, w1, 32 * vt + r32, hi); }
                } else if (wave == 2) wr_row(sm + X_ARB, acc, r32, hi);
                else wr_row(sm + X_ARK, acc, r32, hi);
            }
            PB_BAR();
            if (k >= 1) {
                if (wave < 2) { const f32x16 u = mm_tile<2>(sm + X_TR0, r32, P32, sm + X_W1T, 32 * wave + r32, P32, zero16(), hi); wr_tr(sm + X_UT, u, 32 * wave + r32, hi); }
                else { const f32x16 ta = mm_tile<2>(sm + X_TR0, r32, P32, set + S_AMT, 32 * (wave - 2) + r32, P32, zero16(), hi); wr_tr(sm + X_TAT, ta, 32 * (wave - 2) + r32, hi); }
            }
            PB_BAR();
            if (k >= 1) {
                {   const int kt = wave >> 1, mt = wave & 1, kk = 32 * mt + r32;
                    const f32x16 x = mm_tile<2>(sm + X_TAT, 32 * kt + r32, P32, set + S_BMT, kk, P32, zero16(), hi);
                    const float gl = GL[kk], f1 = GF[kk]; float pv[16];
#pragma unroll
                    for (int r = 0; r < 16; ++r) { const int k2 = 32 * kt + crow(r, hi); pv[r] = f1 * x[r] * GM[k2] + (k2 == kk ? gl : 0.f); }
                    u32x4 w0, w1; w0.x = pkh(pv[0], pv[1]); w0.y = pkh(pv[2], pv[3]); w0.z = pkh(pv[4], pv[5]); w0.w = pkh(pv[6], pv[7]); w1.x = pkh(pv[8], pv[9]); w1.y = pkh(pv[10], pv[11]); w1.z = pkh(pv[12], pv[13]); w1.w = pkh(pv[14], pv[15]);
                    u32x4* dst = (u32x4*)p.pbuf + (size_t)unit * 512 + (mt * 4 + 2 * kt) * 64 + lane;
                    dst[0] = w0; dst[64] = w1; }
                if (wave < 2) {
                    const int kt = wave;
                    const f32x16 x = mm_tile<2>(sm + X_TAT, 32 * kt + r32, P32, sm + X_ARB, r32, P32, zero16(), hi);
                    float pv[16];
#pragma unroll
                    for (int r = 0; r < 16; ++r) { const int k2 = 32 * kt + crow(r, hi); pv[r] = (x[r] + (float)((LAS h16*)(set + S_RM))[r32 * P64 + k2]) * GM[k2]; }
                    u32x4 w0, w1; w0.x = pkh(pv[0], pv[1]); w0.y = pkh(pv[2], pv[3]); w0.z = pkh(pv[4], pv[5]); w0.w = pkh(pv[6], pv[7]); w1.x = pkh(pv[8], pv[9]); w1.y = pkh(pv[10], pv[11]); w1.z = pkh(pv[12], pv[13]); w1.w = pkh(pv[14], pv[15]);
                    u32x4* dst = (u32x4*)p.rbuf + (size_t)unit * 256 + (2 * kt) * 64 + lane;
                    dst[0] = w0; dst[64] = w1;
                } else {
                    const int vt = wave - 2;
                    f32x16 y = mm_tile<2>(sm + X_ARB, r32, P32, sm + X_UT, 32 * vt + r32, P32, zero16(), hi);
                    y = mm_tile<2>(sm + X_ARK, r32, P32, set + S_VT, 32 * vt + r32, P32, y, hi);
                    h16* dst = p.ya + ((size_t)b * SEQ + c * 32) * DH + h * 64 + 32 * vt + r32;
#pragma unroll
                    for (int r = 0; r < 16; ++r) dst[(size_t)crow(r, hi) * DH] = (h16)y[r];
                }
                {   const int mt = wave >> 1, vt = wave & 1;
                    f32x16 q = mm_tile<2>(set + S_BMT, 32 * mt + r32, P32, sm + X_UT, 32 * vt + r32, P32, zero16(), hi);
                    q = mm_tile<2>(set + S_KMT, 32 * mt + r32, P32, set + S_VT, 32 * vt + r32, P32, q, hi);
                    unsigned qw[8];
#pragma unroll
                    for (int r2 = 0; r2 < 8; ++r2) { const int k0 = 32 * mt + crow(2 * r2, hi), k1 = 32 * mt + crow(2 * r2 + 1, hi);
                        qw[r2] = pkh(q[2 * r2] * GF[k0], q[2 * r2 + 1] * GF[k1]); }
                    u32x4* dst = (u32x4*)(p.qbuf + (size_t)unit * 2048 + ((vt * 2 + mt) * 64 + lane) * 8);
                    dst[0] = (u32x4){qw[0], qw[1], qw[2], qw[3]}; dst[1] = (u32x4){qw[4], qw[5], qw[6], qw[7]}; }
            }
            PB_BAR();
        }
    }
    __syncthreads();
}
#undef PB_BAR
__device__ __forceinline__ float h_lo(unsigned w) { return (float)__builtin_bit_cast(h16x2, w)[0]; }
__device__ __forceinline__ float h_hi(unsigned w) { return (float)__builtin_bit_cast(h16x2, w)[1]; }
struct LdSet { u32x4 v[11]; };
__device__ __forceinline__ void chain_ld(LdSet& d, const unsigned char* pb, const unsigned char* qb, int grp, int lt) {
#pragma unroll
    for (int i = 0; i < 11; ++i) { const int idx = lt + i * 384; if (idx < 4096) { const int ch = idx >> 10, w = idx & 1023; const size_t u = (size_t)(grp * 4 + ch) * 8192;
        d.v[i] = *(const u32x4*)((w < 512 ? pb : qb - 8192) + u + (size_t)w * 16); } }
}
__device__ __forceinline__ void chain_st(const LdSet& d, LAS unsigned char* set, int lt) {
    LAS unsigned char* b = set + lt * 16;
#pragma unroll
    for (int i = 0; i < 10; ++i) *(LAS u32x4*)(b + i * 6144) = d.v[i];
    if (lt < 256) *(LAS u32x4*)(b + 10 * 6144) = d.v[10];
}
__device__ __forceinline__ void chain_group(LAS unsigned char* pbase, LAS unsigned char* qbase, f32x16& c0, f32x16& c1, u32x4* sdst) {
#pragma unroll
    for (int cc = 0; cc < 4; ++cc) {
        h16x8 pa[8]; u32x4 q[4];
#pragma unroll
        for (int i = 0; i < 8; ++i) pa[i] = *(const LAS h16x8*)(pbase + cc * 16384 + i * 1024);
#pragma unroll
        for (int i = 0; i < 4; ++i) q[i] = *(const LAS u32x4*)(qbase + cc * 16384 + (i >> 1) * 2048 + (i & 1) * 16);
        h16x8 bs[4];
#pragma unroll
        for (int e = 0; e < 8; ++e) { bs[0][e] = (h16)c0[e]; bs[1][e] = (h16)c0[8 + e]; bs[2][e] = (h16)c1[e]; bs[3][e] = (h16)c1[8 + e]; }
#pragma unroll
        for (int s = 0; s < 4; ++s) sdst[cc * 512 + s * 64] = __builtin_bit_cast(u32x4, bs[s]);
        f32x16 n0, n1;
#pragma unroll
        for (int w = 0; w < 4; ++w) { n0[2 * w] = h_lo(q[0][w]); n0[2 * w + 1] = h_hi(q[0][w]); n0[8 + 2 * w] = h_lo(q[1][w]); n0[8 + 2 * w + 1] = h_hi(q[1][w]);
                                      n1[2 * w] = h_lo(q[2][w]); n1[2 * w + 1] = h_hi(q[2][w]); n1[8 + 2 * w] = h_lo(q[3][w]); n1[8 + 2 * w + 1] = h_hi(q[3][w]); }
#pragma unroll
        for (int s = 0; s < 4; ++s) { n0 = __builtin_amdgcn_mfma_f32_32x32x16_f16(pa[s], bs[s], n0, 0, 0, 0); n1 = __builtin_amdgcn_mfma_f32_32x32x16_f16(pa[4 + s], bs[s], n1, 0, 0, 0); }
        c0 = n0; c1 = n1;
        asm volatile("" ::: "memory");
    }
}
__device__ __forceinline__ void chain_block(const P& p, LAS unsigned char* sm, int bh, int tid, int lane, int wave) {
    const unsigned char* pb = (const unsigned char*)p.pbuf + (size_t)bh * 256 * 8192;
    const unsigned char* qb = (const unsigned char*)p.qbuf + (size_t)bh * 256 * 8192;
    const int lt = tid - 128;
#define CH_BAR() asm volatile("s_waitcnt lgkmcnt(0)\n\ts_barrier" ::: "memory")
    if (wave >= 2) {
        LdSet A, B;
        chain_ld(A, pb, qb, 0, lt); chain_ld(B, pb, qb, 1, lt); chain_st(A, sm, lt); chain_ld(A, pb, qb, 2, lt);
        CH_BAR();
        for (int g = 0; g < 64; g += 2) {
            chain_st(B, sm + 65536, lt); if (g + 3 < 64) chain_ld(B, pb, qb, g + 3, lt);
            CH_BAR();
            if (g + 2 < 64) { chain_st(A, sm, lt); if (g + 4 < 64) chain_ld(A, pb, qb, g + 4, lt); }
            CH_BAR();
        }
    } else {
        f32x16 c0 = zero16(), c1 = zero16();
        u32x4* sbase = (u32x4*)p.qbuf + (size_t)bh * 256 * 512 + wave * 256 + lane;
        LAS unsigned char* pbase = sm + lane * 16; LAS unsigned char* qbase = sm + 8192 + (wave * 128 + lane) * 32;
        CH_BAR();
        for (int g = 0; g < 64; g += 2) {
            chain_group(pbase, qbase, c0, c1, sbase + (size_t)(g * 4) * 512);
            CH_BAR();
            chain_group(pbase + 65536, qbase + 65536, c0, c1, sbase + (size_t)((g + 1) * 4) * 512);
            CH_BAR();
        }
    }
#undef CH_BAR
    __syncthreads();
}
__device__ __forceinline__ void phase2v(const P& p, LAS unsigned char* lds, int tid) {
    for (int tile = blockIdx.x; tile < 256; tile += gridDim.x) {
        const int b = tile >> 7, tl = tile & 127; const size_t m0 = (size_t)b * SEQ + tl * 64;
#pragma unroll
        for (int i = 0; i < 8; ++i) { const int idx = tid + i * 512, key = idx >> 6, ch = idx & 63; *(LAS u32x4*)(lds + key * 1040 + ch * 16) = *(const u32x4*)(p.qkv + (m0 + key) * DQKV + 1024 + ch * 8); }
        __syncthreads();
#pragma unroll
        for (int i = 0; i < 8; ++i) { const int o = tid + i * 512, h = o >> 9, g = (o >> 6) & 7, d = o & 63, ks = g >> 1, hk = g & 1; unsigned short e[8];
#pragma unroll
            for (int j = 0; j < 8; ++j) e[j] = ((const LAS unsigned short*)lds)[(16 * ks + 8 * (j >> 2) + 4 * hk + (j & 3)) * 520 + h * 64 + d];
            u32x4 w; w.x = e[0] | ((unsigned)e[1] << 16); w.y = e[2] | ((unsigned)e[3] << 16); w.z = e[4] | ((unsigned)e[5] << 16); w.w = e[6] | ((unsigned)e[7] << 16);
            ((u32x4*)p.vt)[((((size_t)(b * 8 + h) * 128 + tl) * 8 + g) * 64 + d)] = w; }
        __syncthreads();
    }
}
struct KVF { h16x8 k[8]; u32x4 v[8]; };
__device__ __forceinline__ void attn_ld(KVF& f, const h16* kbase, const u32x4* vtb, int jt) {
    const h16* kp = kbase + (size_t)(jt * 64) * DQKV;
#pragma unroll
    for (int d0 = 0; d0 < 4; ++d0) { f.k[2 * d0] = *(const h16x8*)(kp + d0 * 16); f.k[2 * d0 + 1] = *(const h16x8*)(kp + (size_t)32 * DQKV + d0 * 16); }
    const u32x4* vp = vtb + (size_t)jt * 512;
#pragma unroll
    for (int ks = 0; ks < 4; ++ks) { f.v[2 * ks] = vp[ks * 128]; f.v[2 * ks + 1] = vp[ks * 128 + 32]; }
}
__device__ __forceinline__ void attn_wave_unit(const P& p, int unit, int lane) {
    const int bh = unit >> 8, qblk = unit & 255, b = bh >> 3, h = bh & 7, qw0 = qblk * 32, r32 = lane & 31, hi = lane >> 5, qabs = qw0 + r32;
    const h16* base = p.qkv + (size_t)b * SEQ * DQKV + h * 64;
    const h16* kbase = base + 512 + (size_t)r32 * DQKV + hi * 8;
    const u32x4* vtb = (const u32x4*)p.vt + (size_t)bh * 128 * 512 + hi * 64 + r32;
    h16x8 qf[4];
#pragma unroll
    for (int d0 = 0; d0 < 4; ++d0) qf[d0] = *(const h16x8*)(base + (size_t)(qw0 + r32) * DQKV + d0 * 16 + hi * 8);
    f32x16 o0 = zero16(), o1 = zero16();
    float carry = 1.f;
    KVF cur, nxt;
    int jt = (qw0 + 31) >> 6;
    attn_ld(cur, kbase, vtb, jt);
    for (; jt >= 0; --jt) {
        const int k0 = jt * 64;
        if (jt > 0) attn_ld(nxt, kbase, vtb, jt - 1);
        f32x16 p0 = zero16(), p1 = zero16();
#pragma unroll
        for (int d0 = 0; d0 < 4; ++d0) { p0 = __builtin_amdgcn_mfma_f32_32x32x16_f16(cur.k[2 * d0], qf[d0], p0, 0, 0, 0); p1 = __builtin_amdgcn_mfma_f32_32x32x16_f16(cur.k[2 * d0 + 1], qf[d0], p1, 0, 0, 0); }
        float M0[16], M1[16];
#pragma unroll
        for (int r = 0; r < 16; ++r) { const int key = k0 + crow(r, hi);
            const float m0 = __builtin_amdgcn_rcpf(1.f + __builtin_amdgcn_exp2f(p0[r])), m1 = __builtin_amdgcn_rcpf(1.f + __builtin_amdgcn_exp2f(p1[r]));
            M0[r] = (key < qabs) ? m0 : 1.f; M1[r] = (key + 32 < qabs) ? m1 : 1.f; }
        float Gs[8], PG[8], sgo[8];
#pragma unroll
        for (int j = 0; j < 4; ++j) { Gs[j] = (M0[4 * j] * M0[4 * j + 1]) * (M0[4 * j + 2] * M0[4 * j + 3]); Gs[4 + j] = (M1[4 * j] * M1[4 * j + 1]) * (M1[4 * j + 2] * M1[4 * j + 3]); }
#pragma unroll
        for (int j = 0; j < 8; ++j) PG[j] = __shfl_xor(Gs[j], 32);
        float run = 1.f;
#pragma unroll
        for (int j = 7; j >= 0; --j) { const float ev = hi ? PG[j] : Gs[j], od = hi ? Gs[j] : PG[j]; const float so = run; run *= od; const float se = run; run *= ev; sgo[j] = hi ? so : se; }
        h16x8 pa[4];
#pragma unroll
        for (int j = 0; j < 4; ++j) {
            float acc = carry * sgo[j], acc1 = carry * sgo[4 + j];
#pragma unroll
            for (int i = 3; i >= 0; --i) { const int r = 4 * j + i;
                const float a0 = acc * (1.f - M0[r]); acc *= M0[r];
                const float a1 = acc1 * (1.f - M1[r]); acc1 *= M1[r];
                pa[j >> 1][(j & 1) * 4 + i] = (h16)a0; pa[2 + (j >> 1)][(j & 1) * 4 + i] = (h16)a1; }
        }
        carry *= run;
#pragma unroll
        for (int ks = 0; ks < 4; ++ks) { o0 = __builtin_amdgcn_mfma_f32_32x32x16_f16(pa[ks], __builtin_bit_cast(h16x8, cur.v[2 * ks]), o0, 0, 0, 0); o1 = __builtin_amdgcn_mfma_f32_32x32x16_f16(pa[ks], __builtin_bit_cast(h16x8, cur.v[2 * ks + 1]), o1, 0, 0, 0); }
        if (__all(carry < 1.1754944e-38f)) break;
        cur = nxt;
    }
    h16* ob = p.ob + ((size_t)b * SEQ + qw0) * DH + h * 64;
#pragma unroll
    for (int r = 0; r < 16; ++r) { const int q = crow(r, hi); ob[(size_t)q * DH + r32] = (h16)o0[r]; ob[(size_t)q * DH + 32 + r32] = (h16)o1[r]; }
}
__device__ __forceinline__ void phase4b(const P& p, LAS unsigned char* lds, int lane, int wave) {
    const int gw = blockIdx.x * 8 + wave, NGW = gridDim.x * 8, r32 = lane & 31, hi = lane >> 5;
    LAS float* yt = (LAS float*)(lds + wave * 8448);
    for (int unit = gw; unit < NPRE; unit += NGW) {
        const int bh = unit >> 8, c = unit & 255, b = bh >> 3, h = bh & 7; const size_t tok0 = (size_t)b * SEQ + c * 32;
        h16x8 ra[4];
#pragma unroll
        for (int s = 0; s < 4; ++s) ra[s] = __builtin_bit_cast(h16x8, ((const u32x4*)p.rbuf)[(size_t)unit * 256 + s * 64 + lane]);
#pragma unroll
        for (int vt = 0; vt < 2; ++vt) {
            const h16* yl = p.ya + tok0 * DH + h * 64 + 32 * vt + r32; f32x16 y;
#pragma unroll
            for (int r = 0; r < 16; ++r) y[r] = (float)yl[(size_t)crow(r, hi) * DH];
#pragma unroll
            for (int s = 0; s < 4; ++s) { const h16x8 sb = __builtin_bit_cast(h16x8, ((const u32x4*)p.qbuf)[(size_t)unit * 512 + vt * 256 + s * 64 + lane]); y = __builtin_amdgcn_mfma_f32_32x32x16_f16(ra[s], sb, y, 0, 0, 0); }
#pragma unroll
            for (int r = 0; r < 16; ++r) yt[crow(r, hi) * 66 + 32 * vt + r32] = y[r];
        }
        const int col = h * 64 + lane; const float gg = p.gn_g[col], gb = p.gn_b[col], muv = p.mu[1024 + col];
#pragma unroll 4
        for (int t = 0; t < 32; ++t) {
            const size_t gm = tok0 + t;
            const float y = yt[t * 66 + lane], mean = wave_sum(y) * (1.f / 64.f), d = y - mean, var = wave_sum(d * d) * (1.f / 64.f);
            const float gn = d * __builtin_amdgcn_rsqf(var + GN_EPS) * gg + gb;
            float v = (float)p.zrw[gm * DRW + 1024 + col], vp = 0.f; if (c * 32 + t > 0) vp = (float)p.zrw[(gm - 1) * DRW + 1024 + col];
            v += muv * (vp - v);
            const float g = (float)p.lout[gm * DLO + 1024 + col], bon = p.bon[gm * 8 + h];
            p.ya[gm * DH + col] = (h16)((gn + bon * v) * g);
        }
    }
}
template <bool FINAL> __device__ __forceinline__ void phase_ln(const P& p, int lane, int wave) {
    const int gw = blockIdx.x * 8 + wave, NGW = gridDim.x * 8;
    const float* lg = FINAL ? p.ln2g : p.ln1g; const float* lb = FINAL ? p.ln2b : p.ln1b;
    for (int m = gw; m < M; m += NGW) {
        f32x4* xr = (f32x4*)(p.out + (size_t)m * D) + lane; const int b = m >> 13;
        f32x4 v[4]; float s = 0.f;
#pragma unroll
        for (int j = 0; j < 4; ++j) { v[j] = xr[64 * j]; s += (v[j].x + v[j].y) + (v[j].z + v[j].w); }
        float mean = wave_sum(s) * (1.f / D), s2 = 0.f;
#pragma unroll
        for (int j = 0; j < 4; ++j) { v[j] = v[j] - mean; s2 += (v[j].x * v[j].x + v[j].y * v[j].y) + (v[j].z * v[j].z + v[j].w * v[j].w); }
        float rstd = 1.f / sqrtf(wave_sum(s2) * (1.f / D) + LN_EPS);
        s = 0.f;
#pragma unroll
        for (int j = 0; j < 4; ++j) { const int col = 4 * (lane + 64 * j); v[j] = v[j] * rstd * *(const f32x4*)(lg + col) + *(const f32x4*)(lb + col); xr[64 * j] = v[j]; s += (v[j].x + v[j].y) + (v[j].z + v[j].w); }
        if (!FINAL) {
            mean = wave_sum(s) * (1.f / D); s2 = 0.f;
#pragma unroll
            for (int j = 0; j < 4; ++j) { v[j] = v[j] - mean; s2 += (v[j].x * v[j].x + v[j].y * v[j].y) + (v[j].z * v[j].z + v[j].w * v[j].w); }
            rstd = 1.f / sqrtf(wave_sum(s2) * (1.f / D) + ADA_EPS);
            uint2* o8 = (uint2*)(p.h + (size_t)m * D) + lane; const float* ad = p.ada + b * 6144;
#pragma unroll
            for (int j = 0; j < 4; ++j) { const int col = 4 * (lane + 64 * j); const f32x4 sh = *(const f32x4*)(ad + 3072 + col), sc = *(const f32x4*)(ad + 4096 + col);
                const f32x4 r = v[j] * rstd * (sc + 1.0f) + sh; uint2 w; w.x = pkh(r.x, r.y); w.y = pkh(r.z, r.w); o8[64 * j] = w; }
        }
    }
}

typedef __attribute__((address_space(4))) const unsigned char* kargp_t;
__device__ __forceinline__ void make_p(P& p) {
    kargp_t ka = (kargp_t)__builtin_amdgcn_kernarg_segment_ptr(); asm volatile("" : "+s"(ka));
    const float* const __attribute__((address_space(4)))* in = (const float* const __attribute__((address_space(4)))*)ka;
    p.x = in[0]; p.c = in[1]; p.w_ada = in[2]; p.b_ada = in[3]; p.w_in = in[4]; p.mu = in[5]; p.w0 = in[6]; p.w2 = in[7]; p.a0 = in[8]; p.a2 = in[9]; p.g2 = in[10];
    p.kk = in[11]; p.ka = in[12]; p.rk = in[13]; p.gn_g = in[14]; p.gn_b = in[15]; p.wba = in[16]; p.wbb = in[17]; p.wout = in[18]; p.ln1g = in[19]; p.ln1b = in[20];
    p.w1 = in[21]; p.b1 = in[22]; p.wf2 = in[23]; p.b2 = in[24]; p.ln2g = in[25]; p.ln2b = in[26];
    p.out = (float*)in[27]; unsigned char* ws = (unsigned char*)in[28]; p.ws = ws;
    p.ctl = (unsigned*)(ws + WS_CTL); p.adap = (float*)(ws + WS_ADAP); p.ada = (float*)(ws + WS_ADA); p.bon = (float*)(ws + WS_BON);
    p.win_t = (h16*)(ws + WS_WIN); p.wlora_t = (h16*)(ws + WS_WLORA); p.wba_t = (h16*)(ws + WS_WBA); p.wbb_t = (h16*)(ws + WS_WBB); p.wout_t = (h16*)(ws + WS_WOUT); p.w1_t = (h16*)(ws + WS_W1); p.w2_t = (h16*)(ws + WS_W2);
    p.h = (h16*)(ws + WS_H16); p.zrw = (h16*)(ws + WS_ZRW); p.qkv = (h16*)(ws + WS_QKV); p.lin = (h16*)(ws + WS_LIN); p.lout = (h16*)(ws + WS_LOUT); p.mrg = (h16*)(ws + WS_MRG); p.hid = (h16*)(ws + WS_HID);
    p.pbuf = (h16*)(ws + WS_PB); p.rbuf = (h16*)(ws + WS_RB); p.qbuf = (unsigned*)(ws + WS_QB); p.vt = (h16*)(ws + WS_H16); p.ya = (h16*)(ws + WS_H16); p.ob = (h16*)(ws + WS_H16 + 16 * MiB); p.gates = (h16*)p.out;
}
__global__ void __launch_bounds__(512, 2) mk_fwd(KArgs a) {
    extern __shared__ __attribute__((aligned(16))) unsigned char lds_raw[];
    LAS unsigned char* lds = (LAS unsigned char*)lds_raw;
    volatile LAS unsigned* MISC = (volatile LAS unsigned*)(lds + MISC_OFF);
    int tid = threadIdx.x, lane = tid & 63, wave = __builtin_amdgcn_readfirstlane(tid >> 6);
#define FRESH() do { tid = threadIdx.x; asm volatile("" : "+v"(tid)); lane = tid & 63; wave = __builtin_amdgcn_readfirstlane(tid >> 6); make_p(p); } while (0)
    P p; make_p(p);
    for (int u = tid; u < (LDS_BYTES - RING_BYTES) / 4; u += 512) ((LAS unsigned*)(lds + RING_BYTES))[u] = 0u;
    __syncthreads();
    XcdBarrier bar = xcd_barrier_post(p.ctl + CW_BAR, MISC + 8);
#define GRID_BAR() xcd_barrier(bar)

    FRESH();
    phase0(p, lds, tid, lane, wave);
    if (gridDim.x == 0x7fffffffu) cg::this_grid().sync();
    GRID_BAR();
    FRESH();
    phase0b(p, lds, tid, lane, wave);
    GRID_BAR();
    FRESH();
    run_gemm(lds, p.h, p.win_t, DIN, D, F1{p.zrw, p.qkv, p.gates});
    GRID_BAR();
    FRESH();
    phase2(p, tid);
    phase2v(p, lds, tid);
    GRID_BAR();
    FRESH();
    run_gemm(lds, p.lin, p.wlora_t, DLO, 256, F3{p.lout});
    FRESH();
    for (;;) {
        unsigned u = 0; if (lane == 0) u = atomicAdd(p.ctl + CW_ATTQ, 1u);
        u = (unsigned)__builtin_amdgcn_readfirstlane((int)u);
        if (u >= (unsigned)NATT) break;
        attn_wave_unit(p, (int)u, lane);
    }
    GRID_BAR();
    FRESH();
    pre_phase(p, lds, lane, wave);
    GRID_BAR();
    FRESH();
    if ((int)blockIdx.x < NCHAINB) chain_block(p, lds, (int)blockIdx.x, tid, lane, wave);
    else { run_gemm(lds, p.ob, p.wbb_t, D, DH, F5Y{p.gates}, (int)gridDim.x - NCHAINB, (int)blockIdx.x - NCHAINB);
           __syncthreads(); FRESH(); phase0_late(p, lds, lane, wave, (int)gridDim.x - NCHAINB, (int)blockIdx.x - NCHAINB); }
    GRID_BAR();
    FRESH();
    phase4b(p, lds, lane, wave);
    GRID_BAR();
    FRESH();
    run_gemm(lds, p.ya, p.wba_t, D, DH, F5X{p.mrg, p.gates});
    GRID_BAR();
    FRESH();
    run_gemm(lds, p.mrg, p.wout_t, D, D, F6{p.x, p.out, p.ada});
    GRID_BAR();
    FRESH();
    phase_ln<false>(p, lane, wave);
    GRID_BAR();
    FRESH();
    run_gemm(lds, p.h, p.w1_t, DFF, D, F8{p.hid, p.b1});
    GRID_BAR();
    FRESH();
    run_gemm(lds, p.hid, p.w2_t, D, DFF, F9{p.out, p.ada, p.b2});
    GRID_BAR();
    FRESH();
    phase_ln<true>(p, lane, wave);
}

extern "C" void kernel_launch(void* const* d_in, const int* in_sizes, int n_in, void* d_out, int out_size, void* d_ws, size_t ws_size, hipStream_t stream) {
    static int grid = 0;
    if (grid == 0) {
        if (n_in != 27 || out_size != M * D || ws_size < WS_END) { fprintf(stderr, "kernel_launch: unexpected shapes (n_in %d, out %d, ws %zu)\n", n_in, out_size, ws_size); grid = -1; return; }
        int dev = 0, cus = 0, per_cu = 0;
        hipGetDevice(&dev); hipDeviceGetAttribute(&cus, hipDeviceAttributeMultiprocessorCount, dev);
        if (hipFuncSetAttribute((const void*)mk_fwd, hipFuncAttributeMaxDynamicSharedMemorySize, LDS_BYTES) != hipSuccess) { fprintf(stderr, "kernel_launch: hipFuncSetAttribute failed\n"); grid = -1; return; }
        hipOccupancyMaxActiveBlocksPerMultiprocessor(&per_cu, (const void*)mk_fwd, 512, LDS_BYTES);
        (void)hipGetLastError();
        if (per_cu < 1) fprintf(stderr, "kernel_launch: occupancy query says %d blocks per CU\n", per_cu);
        grid = cus;
    }
    if (grid < 0) return;
    hipMemsetAsync((char*)d_ws + WS_CTL, 0, CTL_ZERO_BYTES, stream);
    KArgs a{};
    for (int i = 0; i < 27; ++i) a.in[i] = (const float*)d_in[i];
    a.out = (float*)d_out; a.ws = (unsigned char*)d_ws;
    void* args[] = {&a};
    hipError_t e = hipLaunchCooperativeKernel((const void*)mk_fwd, dim3(grid), dim3(512), args, LDS_BYTES, stream);
    if (e != hipSuccess) fprintf(stderr, "cooperative launch failed: %s (grid %d)\n", hipGetErrorString(e), grid);
}
```

```cpp
#include <hip/hip_runtime.h>
#include <hip/hip_cooperative_groups.h>
#include <cstdio>
#include <cstdint>
namespace cg = cooperative_groups;
namespace pg8 {
#define PG8_LAS __attribute__((address_space(3)))
typedef unsigned short bf16_t;
typedef _Float16 bf16x8 __attribute__((ext_vector_type(8)));
typedef float f32x4 __attribute__((ext_vector_type(4)));
typedef unsigned u32x4 __attribute__((ext_vector_type(4)));
constexpr int BM = 256, BK = 64, HALF = 128, HTB = HALF * BK * 2  , STAGE_BYTES = 8 * HTB, NXCD = 8, WGM = 8;

__host__ __device__ __forceinline__ int lds_byte(int r, int c) { const int st = (r >> 4) * 2 + (c >> 5), rr = r & 15, cc = c & 31, ob = rr * 64 + cc * 2; return st * 1024 + (ob ^ (((ob >> 9) & 1) << 5)); }
__host__ __device__ __forceinline__ void stage_rc(int b, int& R, int& C) { const int st = b / 1024, sb = b % 1024, swz = sb ^ (((sb >> 9) & 1) << 5); R = (st >> 1) * 16 + swz / 64; C = (st & 1) * 32 + (swz % 64) / 2; }
__host__ __device__ __forceinline__ int perm32(int rho) { const int n = rho >> 4, i = rho & 15; return 8 * (i >> 2) + 4 * n + (i & 3); }

struct Unit { int pm, pn; };
struct Gemm { const bf16_t* A; const bf16_t* Bt; int M, N, K; };

struct StaticOrder {
    int nM, nN, nwg, G, c;
    __host__ __device__ void init(int M, int N, int G_, int c_) { nM = M / BM; nN = N / BM; nwg = nM * nN; G = G_; c = c_; }
    __host__ __device__ bool next(int i, Unit& u) const {
        const long L = (long)i * G + c; if (L >= nwg) return false;
        int wgid = (int)L; { const int q = nwg / NXCD, r = nwg % NXCD, xcd = wgid % NXCD, off = wgid / NXCD; wgid = (xcd < r ? xcd * (q + 1) : r * (q + 1) + (xcd - r) * q) + off; }
        const int nig = WGM * nN, gid = wgid / nig, fm = gid * WGM, gsz = (nM - fm) < WGM ? (nM - fm) : WGM;
        u.pm = fm + ((wgid % nig) % gsz); u.pn = (wgid % nig) / gsz; return true;
    }
    __device__ __forceinline__ void a_ready(const Unit&) const {}
    __device__ __forceinline__ void done(const Unit&) const {}
};
template <class Epi, class Sched, bool ALIGN_EPI = false, bool SP2 = false>
__device__ __forceinline__ void gemm_phase(PG8_LAS unsigned char* lds, const Gemm g, const Sched& S, const Epi& E) {
    int tid_ = threadIdx.x; asm volatile("" : "+v"(tid_)); const int tid = tid_, wid = __builtin_amdgcn_readfirstlane(tid >> 6), lane = tid & 63, wr = wid >> 2, wc = wid & 3, fr = lane & 15, fq = lane >> 4;
    const int K = g.K, nt = K / BK;
    unsigned voffA[2], voffB[2];
#pragma unroll
    for (int i = 0; i < 2; ++i) { int R, C; stage_rc(tid * 16 + i * 8192, R, C); const int Rb = Epi::PERM ? ((R & ~31) + perm32(R & 31)) : R;
        voffA[i] = (unsigned)(R * K + C) * 2u; voffB[i] = (unsigned)(Rb * K + C) * 2u; }
    const size_t kstep = (size_t)(BK * 2);
    const size_t hstep = (size_t)HALF * K * 2;
    const size_t tstep = 2 * hstep;
    const unsigned ldsw = (unsigned)wid * 1024u;
    const int aoff = lds_byte(wr * 64 + fr, fq * 8), boff = lds_byte(wc * 32 + fr, fq * 8);
#define PG8_SA(b, h) (((b) * 2 + (h)) * HTB)
#define PG8_SB(b, h) ((4 + (b) * 2 + (h)) * HTB)
#define PG8_STAGE(bufoff, gbase, voff) do { _Pragma("unroll") for (int _i = 0; _i < 2; ++_i) \
        __builtin_amdgcn_global_load_lds((const unsigned*)((const char*)(gbase) + (voff)[_i]), (PG8_LAS unsigned*)(lds + (bufoff) + ldsw + _i * 8192), 16, 0, 0); } while (0)
#define PG8_LDA(dst, b, h) do { _Pragma("unroll") for (int m = 0; m < 4; ++m) _Pragma("unroll") for (int k = 0; k < 2; ++k) dst[m][k] = *(const PG8_LAS bf16x8*)(lds + PG8_SA(b, h) + aoff + m * 2048 + k * 1024); } while (0)
#define PG8_LDB(dst, b, h) do { _Pragma("unroll") for (int n = 0; n < 2; ++n) _Pragma("unroll") for (int k = 0; k < 2; ++k) dst[n][k] = *(const PG8_LAS bf16x8*)(lds + PG8_SB(b, h) + boff + n * 2048 + k * 1024); } while (0)
#define PG8_MMA(ai, bj, At, Bt) do { __builtin_amdgcn_s_setprio(1); _Pragma("unroll") for (int m = 0; m < 4; ++m) _Pragma("unroll") for (int n = 0; n < 2; ++n) _Pragma("unroll") for (int k = 0; k < 2; ++k) \
        acc[ai][bj][m][n] = __builtin_amdgcn_mfma_f32_16x16x32_f16(Bt[n][k], At[m][k], acc[ai][bj][m][n], 0, 0, 0); __builtin_amdgcn_s_setprio(0); } while (0)
#define PG8_WAIT_V(n) asm volatile("s_waitcnt vmcnt(" #n ")" ::: "memory")
#define PG8_WAIT_L(n) asm volatile("s_waitcnt lgkmcnt(" #n ")" ::: "memory")
#define PG8_BAR __builtin_amdgcn_s_barrier()
#define PG8_SCHED __builtin_amdgcn_sched_barrier(0)
    Unit cur, nxt; int ui = 0;
    if (!S.next(0, cur)) return;
    f32x4 acc[2][2][4][2];
#pragma unroll
    for (int a = 0; a < 2; ++a)
#pragma unroll
        for (int b = 0; b < 2; ++b)
#pragma unroll
            for (int m = 0; m < 4; ++m)
#pragma unroll
                for (int n = 0; n < 2; ++n) acc[a][b][m][n] = (f32x4){0.f, 0.f, 0.f, 0.f};
    bf16x8 At[4][2], B0[2][2], B1[2][2];
    const char* cA = (const char*)g.A + (size_t)cur.pm * tstep; const char* cB = (const char*)g.Bt + (size_t)cur.pn * tstep;
    S.a_ready(cur);
    if constexpr (SP2) {
        PG8_STAGE(PG8_SB(0, 0), cB, voffB); PG8_STAGE(PG8_SB(0, 1), cB + hstep, voffB); PG8_STAGE(PG8_SA(0, 0), cA, voffA); PG8_STAGE(PG8_SA(0, 1), cA + hstep, voffA);
        if (wr == 1) PG8_BAR;
        PG8_WAIT_V(2); PG8_BAR;
        PG8_STAGE(PG8_SB(1, 0), cB + kstep, voffB); PG8_STAGE(PG8_SA(1, 0), cA + kstep, voffA); PG8_STAGE(PG8_SB(1, 1), cB + hstep + kstep, voffB);
        PG8_WAIT_V(6); PG8_BAR;
    } else {
        PG8_STAGE(PG8_SB(0, 0), cB, voffB); PG8_STAGE(PG8_SA(0, 0), cA, voffA); PG8_STAGE(PG8_SB(0, 1), cB + hstep, voffB); PG8_STAGE(PG8_SA(0, 1), cA + hstep, voffA);
        if (wr == 1) PG8_BAR;
        PG8_WAIT_V(4); PG8_BAR;
        PG8_STAGE(PG8_SB(1, 0), cB + kstep, voffB); PG8_STAGE(PG8_SA(1, 0), cA + kstep, voffA); PG8_STAGE(PG8_SB(1, 1), cB + hstep + kstep, voffB);
        PG8_WAIT_V(6); PG8_BAR;
    }
    for (;;) {
        const bool has_next = S.next(ui + 1, nxt);
        const char* nA = has_next ? (const char*)g.A + (size_t)nxt.pm * tstep : cA; const char* nB = has_next ? (const char*)g.Bt + (size_t)nxt.pn * tstep : cB;
        for (int t = 0; t < nt; t += 2) {
            const bool last = (t == nt - 2);
            const char* a1 = cA + (size_t)(t + 1) * kstep;
            const char* a2 = last ? nA : cA + (size_t)(t + 2) * kstep; const char* b2 = last ? nB : cB + (size_t)(t + 2) * kstep;
            const char* a3 = a2 + kstep; const char* b3 = b2 + kstep;
            if (last && has_next) S.a_ready(nxt);
            if constexpr (SP2) {
            PG8_LDB(B0, 0, 0); PG8_LDB(B1, 0, 1); PG8_SCHED; PG8_LDA(At, 0, 0); PG8_STAGE(PG8_SA(1, 1), a1 + hstep, voffA);
            PG8_WAIT_V(8); PG8_WAIT_L(0); PG8_BAR; PG8_MMA(0, 0, At, B0); PG8_MMA(0, 1, At, B1); PG8_BAR; PG8_SCHED;
            PG8_LDA(At, 0, 1); PG8_STAGE(PG8_SB(0, 0), b2, voffB); PG8_STAGE(PG8_SB(0, 1), b2 + hstep, voffB); PG8_STAGE(PG8_SA(0, 0), a2, voffA);
            PG8_WAIT_V(8); PG8_WAIT_L(0); PG8_BAR; PG8_MMA(1, 0, At, B0); PG8_MMA(1, 1, At, B1); PG8_BAR; PG8_SCHED;
            PG8_LDB(B0, 1, 0); PG8_LDB(B1, 1, 1); PG8_SCHED; PG8_LDA(At, 1, 0); PG8_STAGE(PG8_SA(0, 1), a2 + hstep, voffA);
            PG8_WAIT_V(8); PG8_WAIT_L(0); PG8_BAR; PG8_MMA(0, 0, At, B0); PG8_MMA(0, 1, At, B1); PG8_BAR; PG8_SCHED;
            PG8_LDA(At, 1, 1); PG8_STAGE(PG8_SB(1, 0), b3, voffB); PG8_STAGE(PG8_SB(1, 1), b3 + hstep, voffB); PG8_STAGE(PG8_SA(1, 0), a3, voffA);
            PG8_WAIT_V(8); PG8_WAIT_L(0); PG8_BAR; PG8_MMA(1, 0, At, B0); PG8_MMA(1, 1, At, B1); PG8_BAR; PG8_SCHED;
            } else {
            PG8_LDB(B0, 0, 0); PG8_SCHED; PG8_LDA(At, 0, 0); PG8_STAGE(PG8_SA(1, 1), a1 + hstep, voffA);
            PG8_WAIT_L(8); PG8_BAR; PG8_WAIT_L(0); PG8_MMA(0, 0, At, B0); PG8_BAR; PG8_SCHED;
            PG8_LDB(B1, 0, 1); PG8_STAGE(PG8_SB(0, 0), b2, voffB);
            PG8_BAR; PG8_WAIT_L(0); PG8_MMA(0, 1, At, B1); PG8_BAR;
            PG8_LDA(At, 0, 1); PG8_STAGE(PG8_SA(0, 0), a2, voffA);
            PG8_BAR; PG8_WAIT_L(0); PG8_MMA(1, 0, At, B0); PG8_BAR; PG8_SCHED;
            PG8_STAGE(PG8_SB(0, 1), b2 + hstep, voffB);
            PG8_WAIT_V(6); PG8_BAR; PG8_MMA(1, 1, At, B1); PG8_BAR;
            PG8_LDB(B0, 1, 0); PG8_SCHED; PG8_LDA(At, 1, 0); PG8_STAGE(PG8_SA(0, 1), a2 + hstep, voffA);
            PG8_WAIT_L(8); PG8_BAR; PG8_WAIT_L(0); PG8_MMA(0, 0, At, B0); PG8_BAR; PG8_SCHED;
            PG8_LDB(B1, 1, 1); PG8_STAGE(PG8_SB(1, 0), b3, voffB);
            PG8_BAR; PG8_WAIT_L(0); PG8_MMA(0, 1, At, B1); PG8_BAR;
            PG8_LDA(At, 1, 1); PG8_STAGE(PG8_SA(1, 0), a3, voffA);
            PG8_BAR; PG8_WAIT_L(0); PG8_MMA(1, 0, At, B0); PG8_BAR; PG8_SCHED;
            PG8_STAGE(PG8_SB(1, 1), b3 + hstep, voffB);
            PG8_WAIT_V(6); PG8_BAR; PG8_MMA(1, 1, At, B1); PG8_BAR;
            }
        }
        if constexpr (ALIGN_EPI) { if (wr == 0) PG8_BAR; }
        if constexpr (!Epi::AFTER_DRAIN) { E(acc, cur, wr, wc, fr, fq); S.done(cur); }
        if (!has_next) break;
#pragma unroll
        for (int a = 0; a < 2; ++a)
#pragma unroll
            for (int b = 0; b < 2; ++b)
#pragma unroll
                for (int m = 0; m < 4; ++m)
#pragma unroll
                    for (int n = 0; n < 2; ++n) acc[a][b][m][n] = (f32x4){0.f, 0.f, 0.f, 0.f};
        cur = nxt; cA = nA; cB = nB; ++ui;
        if constexpr (ALIGN_EPI) { if (wr == 1) PG8_BAR; }
    }
    PG8_WAIT_V(0);
    if constexpr (!ALIGN_EPI) { if (wr == 0) PG8_BAR; }
    PG8_BAR;
    if constexpr (Epi::AFTER_DRAIN) { E.fused(acc, cur, wr, wc, fr, fq, lds, wid, lane); S.done(cur); }
#undef PG8_SA
#undef PG8_SB
#undef PG8_STAGE
#undef PG8_LDA
#undef PG8_LDB
#undef PG8_MMA
#undef PG8_WAIT_V
#undef PG8_WAIT_L
#undef PG8_BAR
#undef PG8_SCHED
}
}
#define GAS __attribute__((address_space(1)))
#define LAS __attribute__((address_space(3)))
typedef unsigned short bf16;
typedef unsigned v4u __attribute__((ext_vector_type(4)));
typedef float f32x4 __attribute__((ext_vector_type(4)));
typedef short bf16x8 __attribute__((ext_vector_type(8)));
typedef GAS unsigned gu32;
typedef GAS unsigned long long gu64;
#define RLX_AGENT __ATOMIC_RELAXED, __HIP_MEMORY_SCOPE_AGENT
#define LDS_WAIT() asm volatile("s_waitcnt lgkmcnt(0)" ::: "memory")
#define VM_WAIT() asm volatile("s_waitcnt vmcnt(0)" ::: "memory")
__device__ __forceinline__ unsigned long long rt() { return __builtin_amdgcn_s_memrealtime(); }
__device__ __forceinline__ unsigned f2bf(float f) { unsigned u = __builtin_bit_cast(unsigned, f); return (u + 0x7fffu + ((u >> 16) & 1u)) >> 16; }
__device__ __forceinline__ unsigned pk2(float lo, float hi) { return f2bf(lo) | (f2bf(hi) << 16); }

#define XB_TMO      128
#define XB_XCNT(j)  (256  + 64 * (j))
#define XB_XSUB(j)  (1280 + 64 * (j))
#define XB_XGEN(j)  (2304 + 64 * (j))
#define XB_TOP      3328
#define XB_TOPGEN   3392
#define XCD_BAR_WORDS 3456
#define XB_SPIN_CAP (1u << 18)

__device__ __forceinline__ unsigned xb_ld(unsigned* p)              { return __hip_atomic_load(p, __ATOMIC_RELAXED, __HIP_MEMORY_SCOPE_AGENT); }
__device__ __forceinline__ unsigned xb_add(unsigned* p, unsigned v) { return __hip_atomic_fetch_add(p, v, __ATOMIC_RELAXED, __HIP_MEMORY_SCOPE_AGENT); }
__device__ __forceinline__ unsigned xb_xcc_id() { return (unsigned)__builtin_amdgcn_s_getreg((3 << 11) | 20) & 0xFu; }
#define XB_SPIN(cond, bar) do { unsigned _sp = 0; while (cond) { __builtin_amdgcn_s_sleep(1); \
    if ((++_sp & 255u) == 0u) { if (xb_ld(&(bar)[XB_TMO])) break; if (_sp > XB_SPIN_CAP) { atomicAdd(&(bar)[XB_TMO], 1u); break; } } } } while (0)

struct XcdBarrier {
    unsigned* bar; unsigned x;
    volatile LAS unsigned* st;
};

__device__ __forceinline__ XcdBarrier xcd_barrier_post(unsigned* bar, volatile LAS unsigned* st) {
    XcdBarrier b; b.bar = bar; b.x = xb_xcc_id(); b.st = st;
    if (threadIdx.x == 0) (void)xb_add(&bar[XB_XCNT(b.x)], 1u);
    return b;
}
__device__ __forceinline__ void xcd_barrier_complete(unsigned* bar, unsigned x, unsigned& nloc, unsigned& nx) {
    const unsigned G = gridDim.x * gridDim.y * gridDim.z;
    unsigned sum, cnt, mine, sp = 0u;
    for (;;) {
        sum = 0u; cnt = 0u; mine = 0u;
#pragma unroll
        for (unsigned j = 0; j < 16; ++j) { const unsigned c = xb_ld(&bar[XB_XCNT(j)]); sum += c; cnt += (c > 0u) ? 1u : 0u; mine = (j == x) ? c : mine; }
        if (sum == G) break;
        __builtin_amdgcn_s_sleep(1);
        if ((++sp & 255u) == 0u) { if (xb_ld(&bar[XB_TMO])) break; if (sp > XB_SPIN_CAP) { atomicAdd(&bar[XB_TMO], 1u); break; } }
    }
    nloc = mine > 0u ? mine : 1u; nx = cnt > 0u ? cnt : 1u;
}

__device__ __forceinline__ void xcd_barrier(const XcdBarrier& b) {
    asm volatile("s_waitcnt vmcnt(0)" ::: "memory");
    __syncthreads();
    if (threadIdx.x == 0) {
        unsigned* bar = b.bar;
        __builtin_amdgcn_s_waitcnt(0);
        unsigned nloc = b.st[0], nx = b.st[1];
        if (nloc == 0u) { xcd_barrier_complete(bar, b.x, nloc, nx); b.st[0] = nloc; b.st[1] = nx; }
        const unsigned old = xb_add(&bar[XB_XSUB(b.x)], 1u);
        const unsigned gen = old / nloc;
        if (old + 1u == (gen + 1u) * nloc) {
            __builtin_amdgcn_fence(__ATOMIC_RELEASE, "agent");
            asm volatile("s_waitcnt vmcnt(0)" ::: "memory");
            const unsigned og = xb_add(&bar[XB_TOP], 1u);
            const unsigned tg = og / nx;
            if (og + 1u == (tg + 1u) * nx) xb_add(&bar[XB_TOPGEN], 1u);
            else XB_SPIN(xb_ld(&bar[XB_TOPGEN]) == tg, bar);
            __builtin_amdgcn_fence(__ATOMIC_ACQUIRE, "agent");
            xb_add(&bar[XB_XGEN(b.x)], 1u);
            asm volatile("s_waitcnt vmcnt(0)" ::: "memory");
        } else {
            XB_SPIN(xb_ld(&bar[XB_XGEN(b.x)]) == gen, bar);
            __builtin_amdgcn_fence(__ATOMIC_ACQUIRE, "agent");
            asm volatile("s_waitcnt vmcnt(0)" ::: "memory");
        }
    }
    __syncthreads();
}
typedef _Float16 h16;
typedef _Float16 h16x8 __attribute__((ext_vector_type(8)));
typedef _Float16 h16x2 __attribute__((ext_vector_type(2)));
typedef float f32x16 __attribute__((ext_vector_type(16)));
typedef unsigned u32x4 __attribute__((ext_vector_type(4)));
typedef unsigned u32x2 __attribute__((ext_vector_type(2)));
constexpr int NB = 2, SEQ = 8192, M = NB * SEQ, D = 1024, DIN = 5376, DRW = 1792, DQKV = 1536, DG = 2048, DFF = 4096, DH = 512, DLO = 1536;
constexpr float ALPHA = 1.189207115002721f;
constexpr float QSCALE = 0.125f * 1.4426950408889634f;
constexpr float LN_EPS = 1e-5f, ADA_EPS = 1e-6f, GN_EPS = 64e-5f;
constexpr size_t MiB = 1u << 20, KiB = 1u << 10;
constexpr size_t WS_CTL = 0, CTL_ZERO_BYTES = 1 * MiB;
constexpr size_t WS_ADAP = 1 * MiB, WS_ADA = 1 * MiB + 896 * KiB, WS_BON = 2 * MiB;
constexpr size_t WS_WIN = 3 * MiB, WS_WLORA = 13 * MiB + 512 * KiB, WS_WBA = 14 * MiB + 256 * KiB, WS_WBB = 15 * MiB + 256 * KiB, WS_WOUT = 16 * MiB + 256 * KiB,
                 WS_W1 = 18 * MiB + 256 * KiB, WS_W2 = 26 * MiB + 256 * KiB;
constexpr size_t WS_H16 = 36 * MiB, WS_ZRW = 68 * MiB, WS_QKV = 124 * MiB, WS_LOUT = 172 * MiB, WS_LIN = 220 * MiB, WS_PB = 124 * MiB, WS_RB = 156 * MiB, WS_QB = 220 * MiB, WS_MRG = 68 * MiB, WS_HID = 68 * MiB, WS_END = 252 * MiB;
constexpr int CW_ATTQ = 64, CW_BAR = 4096;
constexpr int RING_BYTES = 131072, MISC_OFF = RING_BYTES + 64, LDS_BYTES = RING_BYTES + 512;
constexpr int NATT = 16 * 256, NPRE = 16 * 256, NCHAINB = 16;

struct KArgs { const float* in[27]; float* out; unsigned char* ws; };
struct P {
    const float *x, *c, *w_ada, *b_ada, *w_in, *mu, *w0, *w2, *a0, *a2, *g2, *kk, *ka, *rk, *gn_g, *gn_b, *wba, *wbb, *wout, *ln1g, *ln1b, *w1, *b1, *wf2, *b2, *ln2g, *ln2b;
    float* out; unsigned char* ws;
    unsigned* ctl; float *adap, *ada, *bon;
    h16 *pbuf, *rbuf, *vt; unsigned* qbuf; h16 *win_t, *wlora_t, *wba_t, *wbb_t, *wout_t, *w1_t, *w2_t, *h, *zrw, *qkv, *lin, *lout, *mrg, *hid, *ya, *ob, *gates;
};

__device__ __forceinline__ unsigned pkh(float a, float b) { h16x2 v = {(h16)a, (h16)b}; return __builtin_bit_cast(unsigned, v); }
__device__ __forceinline__ void store8h(h16* p, const f32x4& v0, const f32x4& v1) { u32x4 w; w.x = pkh(v0.x, v0.y); w.y = pkh(v0.z, v0.w); w.z = pkh(v1.x, v1.y); w.w = pkh(v1.z, v1.w); *(u32x4*)p = w; }
__device__ __forceinline__ void load8h(const h16* p, f32x4& v0, f32x4& v1) { const h16x8 t = *(const h16x8*)p; v0 = (f32x4){(float)t[0], (float)t[1], (float)t[2], (float)t[3]}; v1 = (f32x4){(float)t[4], (float)t[5], (float)t[6], (float)t[7]}; }
__device__ __forceinline__ float sigmoidf_(float x) { return __builtin_amdgcn_rcpf(1.0f + __expf(-x)); }
template <int CTRL> __device__ __forceinline__ float dppmov(float x) { return __builtin_bit_cast(float, __builtin_amdgcn_update_dpp(0, __builtin_bit_cast(int, x), CTRL, 0xf, 0xf, true)); }
__device__ __forceinline__ float red16(float v) { v += dppmov<0xB1>(v); v += dppmov<0x4E>(v); v += dppmov<0x124>(v); v += dppmov<0x128>(v); return v; }

__device__ __forceinline__ float wave_sum(float v) {
    v = red16(v);
    const int b = __builtin_bit_cast(int, v);
    return (__builtin_bit_cast(float, __builtin_amdgcn_readlane(b, 0)) + __builtin_bit_cast(float, __builtin_amdgcn_readlane(b, 16))) +
           (__builtin_bit_cast(float, __builtin_amdgcn_readlane(b, 32)) + __builtin_bit_cast(float, __builtin_amdgcn_readlane(b, 48)));
}
template <class F> struct EpiGen {
    static constexpr bool PERM = true, AFTER_DRAIN = false;
    F f;
    __device__ __forceinline__ void operator()(const f32x4 (&acc)[2][2][4][2], const pg8::Unit& u, int wr, int wc, int fr, int fq) const {
        const int row0 = u.pm * 256 + wr * 64 + fr, col0 = u.pn * 256 + wc * 32 + 8 * fq;
#pragma unroll
        for (int ai = 0; ai < 2; ++ai)
#pragma unroll
            for (int m = 0; m < 4; ++m)
#pragma unroll
                for (int bj = 0; bj < 2; ++bj) f(row0 + ai * 128 + m * 16, col0 + bj * 128, acc[ai][bj][m][0], acc[ai][bj][m][1]);
    }
};
struct F1 {
    h16 *zrw, *qkv, *gates;
    __device__ __forceinline__ void operator()(int row, int col, f32x4 v0, f32x4 v1) const {
        if (col < DRW) store8h(zrw + (size_t)row * DRW + col, v0, v1);
        else if (col < DRW + DQKV) { const int c = col - DRW; if (c < 512) { v0 = v0 * QSCALE; v1 = v1 * QSCALE; } store8h(qkv + (size_t)row * DQKV + c, v0, v1); }
        else { const int c = col - DRW - DQKV;
#pragma unroll
            for (int i = 0; i < 4; ++i) { v0[i] = sigmoidf_(v0[i]); v1[i] = sigmoidf_(v1[i]); }
            store8h(gates + (size_t)row * DG + c, v0, v1); }
    }
};
struct F3 {
    h16* lout;
    __device__ __forceinline__ void operator()(int row, int col, f32x4 v0, f32x4 v1) const { store8h(lout + (size_t)row * DLO + col, v0, v1); }
};
struct F5Y { h16* gates;
    __device__ __forceinline__ void operator()(int row, int col, f32x4 v0, f32x4 v1) const {
        f32x4 g0, g1; h16* gp = gates + (size_t)row * DG + 1024 + col; load8h(gp, g0, g1); store8h(gp, v0 * g0, v1 * g1); } };
struct F5X { h16* mrg; const h16* gates;
    __device__ __forceinline__ void operator()(int row, int col, f32x4 v0, f32x4 v1) const {
        f32x4 g0, g1, m0, m1; load8h(gates + (size_t)row * DG + col, g0, g1); load8h(gates + (size_t)row * DG + 1024 + col, m0, m1); store8h(mrg + (size_t)row * D + col, m0 + v0 * g0, m1 + v1 * g1); } };
struct F6 { const float* x; float* out; const float* ada;
    __device__ __forceinline__ void operator()(int row, int col, f32x4 v0, f32x4 v1) const {
        const float* g = ada + (row >> 13) * 6144 + 2048 + col; const size_t o = (size_t)row * D + col;
        const f32x4 x0 = *(const f32x4*)(x + o), x1 = *(const f32x4*)(x + o + 4), g0 = *(const f32x4*)g, g1 = *(const f32x4*)(g + 4);
        *(f32x4*)(out + o) = x0 * ALPHA + g0 * v0; *(f32x4*)(out + o + 4) = x1 * ALPHA + g1 * v1; } };
struct F8 { h16* hid; const float* b1;
    __device__ __forceinline__ void operator()(int row, int col, f32x4 v0, f32x4 v1) const {
        const f32x4 c0 = *(const f32x4*)(b1 + col), c1 = *(const f32x4*)(b1 + col + 4);
#pragma unroll
        for (int i = 0; i < 4; ++i) { float a = fmaxf(v0[i] + c0[i], 0.f); v0[i] = a * a; a = fmaxf(v1[i] + c1[i], 0.f); v1[i] = a * a; }
        store8h(hid + (size_t)row * DFF + col, v0, v1); } };
struct F9 { float* out; const float* ada; const float* b2;
    __device__ __forceinline__ void operator()(int row, int col, f32x4 v0, f32x4 v1) const {
        const float* g = ada + (row >> 13) * 6144 + 5120 + col; const size_t o = (size_t)row * D + col;
        const f32x4 x0 = *(const f32x4*)(out + o), x1 = *(const f32x4*)(out + o + 4), g0 = *(const f32x4*)g, g1 = *(const f32x4*)(g + 4), c0 = *(const f32x4*)(b2 + col), c1 = *(const f32x4*)(b2 + col + 4);
        *(f32x4*)(out + o) = x0 * ALPHA + g0 * (v0 + c0); *(f32x4*)(out + o + 4) = x1 * ALPHA + g1 * (v1 + c1); } };

template <class F> __device__ __forceinline__ void run_gemm(LAS unsigned char* lds, const h16* A, const h16* Bt, int N, int K, const F& f, int gsz = -1, int gidx = -1) {
    asm volatile("" : "+s"(N), "+s"(K));
    if (gsz < 0) { gsz = (int)gridDim.x; gidx = (int)blockIdx.x; }
    pg8::Gemm g{(const pg8::bf16_t*)A, (const pg8::bf16_t*)Bt, M, N, K}; pg8::StaticOrder S; S.init(M, N, gsz, gidx);
    EpiGen<F> E{f};
    pg8::gemm_phase<EpiGen<F>, pg8::StaticOrder, true, true>(lds, g, S, E);
}

__device__ __forceinline__ void p0_transpose_item(const float* W, int K, int N, h16* WT, LAS float* scr, int item, int lane) {
    const int nblk = N / 32, kb = item / nblk, nb = item % nblk, k0 = 64 * kb, n0 = 32 * nb;
#pragma unroll 8
    for (int i = 0; i < 32; ++i) { const int kk = 2 * i + (lane >> 5); scr[kk * 33 + (lane & 31)] = W[(size_t)(k0 + kk) * N + n0 + (lane & 31)]; }
    LDS_WAIT(); asm volatile("" ::: "memory");
    const int c = lane & 7;
#pragma unroll
    for (int j = 0; j < 4; ++j) { const int n = (lane >> 3) + 8 * j; const LAS float* s = scr + (8 * c) * 33 + n;
        u32x4 o; o.x = pkh(s[0 * 33], s[1 * 33]); o.y = pkh(s[2 * 33], s[3 * 33]); o.z = pkh(s[4 * 33], s[5 * 33]); o.w = pkh(s[6 * 33], s[7 * 33]);
        *(u32x4*)(WT + (size_t)(n0 + n) * K + k0 + 8 * c) = o; }
    LDS_WAIT(); asm volatile("" ::: "memory");
}
__device__ __forceinline__ void phase0(const P& p, LAS unsigned char* lds, int tid, int lane, int wave) {
    LAS float* scr = (LAS float*)(lds + wave * 16384);
    const int G = gridDim.x, gw = blockIdx.x * 8 + wave, NGW = G * 8;
    constexpr int I_IN = (D / 64) * (DIN / 32), I_BA = (DH / 64) * (D / 32), I_OUT = (D / 64) * (D / 32), I_1 = (D / 64) * (DFF / 32), I_2 = (DFF / 64) * (D / 32);
    constexpr int NITEMS = I_IN + 2 * I_BA + I_OUT + I_1 + I_2;
    for (int it = gw; it < I_IN + I_BA; it += NGW) {
        int r = it;
        if (r < I_IN) { p0_transpose_item(p.w_in, D, DIN, p.win_t, scr, r, lane); continue; } r -= I_IN;
        p0_transpose_item(p.wbb, DH, D, p.wbb_t, scr, r, lane);
    }
    for (int idx = blockIdx.x * 512 + tid; idx < DLO * 256; idx += G * 512) {
        const int n = idx >> 8, k = idx & 255; float v = 0.f;
        if (n < 512) { if (k < 64) v = p.w2[k * 512 + n]; }
        else if (n < 1024) { if (k >= 64 && k < 128) v = p.a2[(k - 64) * 512 + n - 512]; }
        else { if (k >= 128) v = p.g2[(k - 128) * 512 + n - 1024]; }
        p.wlora_t[idx] = (h16)v;
    }
    for (int u = blockIdx.x; u < 192; u += G) {
        const int slice = u / 12, n = (u % 12) * 512 + tid; float a0 = 0.f, a1 = 0.f;
#pragma unroll 8
        for (int kk = 0; kk < 64; ++kk) { const int k = slice * 64 + kk; const float c0 = p.c[k], c1 = p.c[1024 + k], w = p.w_ada[(size_t)k * 6144 + n];
            a0 += c0 * sigmoidf_(c0) * w; a1 += c1 * sigmoidf_(c1) * w; }
        p.adap[(slice * 2 + 0) * 6144 + n] = a0; p.adap[(slice * 2 + 1) * 6144 + n] = a1;
    }
}
__device__ __forceinline__ void phase0_late(const P& p, LAS unsigned char* lds, int lane, int wave, int gsz, int gidx) {
    LAS float* scr = (LAS float*)(lds + wave * 16384);
    const int gw = gidx * 8 + wave, NGW = gsz * 8;
    constexpr int I_BA = (DH / 64) * (D / 32), I_OUT = (D / 64) * (D / 32), I_1 = (D / 64) * (DFF / 32), I_2 = (DFF / 64) * (D / 32);
    for (int it = gw; it < I_BA + I_OUT + I_1 + I_2; it += NGW) {
        int r = it;
        if (r < I_BA) { p0_transpose_item(p.wba, DH, D, p.wba_t, scr, r, lane); continue; } r -= I_BA;
        if (r < I_OUT) { p0_transpose_item(p.wout, D, D, p.wout_t, scr, r, lane); continue; } r -= I_OUT;
        if (r < I_1) { p0_transpose_item(p.w1, D, DFF, p.w1_t, scr, r, lane); continue; } r -= I_1;
        p0_transpose_item(p.wf2, DFF, D, p.w2_t, scr, r, lane);
    }
}
__device__ __forceinline__ void phase0b(const P& p, LAS unsigned char* lds, int tid, int lane, int wave) {
    LAS float* mod = (LAS float*)lds;
    for (int i = tid; i < 4096; i += 512) { const int b = i >> 11, j = i & 2047; float s = p.b_ada[j];
#pragma unroll
        for (int sl = 0; sl < 16; ++sl) s += p.adap[(sl * 2 + b) * 6144 + j];
        mod[i] = s; }
    if (blockIdx.x == 0) for (int i = tid; i < 2 * 6144; i += 512) { const int b = i / 6144, j = i % 6144; float s = p.b_ada[j];
#pragma unroll
        for (int sl = 0; sl < 16; ++sl) s += p.adap[(sl * 2 + b) * 6144 + j];
        p.ada[i] = s; }
    __syncthreads();
    const int gw = blockIdx.x * 8 + wave, NGW = gridDim.x * 8;
    for (int m = gw; m < M; m += NGW) {
        const f32x4* xr = (const f32x4*)(p.x + (size_t)m * D) + lane; const int b = m >> 13;
        f32x4 v[4]; float s = 0.f;
#pragma unroll
        for (int j = 0; j < 4; ++j) { v[j] = xr[64 * j]; s += (v[j].x + v[j].y) + (v[j].z + v[j].w); }
        const float mean = wave_sum(s) * (1.f / D); float s2 = 0.f;
#pragma unroll
        for (int j = 0; j < 4; ++j) { v[j] = v[j] - mean; s2 += (v[j].x * v[j].x + v[j].y * v[j].y) + (v[j].z * v[j].z + v[j].w * v[j].w); }
        const float rstd = 1.f / sqrtf(wave_sum(s2) * (1.f / D) + ADA_EPS);
        uint2* o8 = (uint2*)(p.h + (size_t)m * D) + lane;
#pragma unroll
        for (int j = 0; j < 4; ++j) { const int col = 4 * (lane + 64 * j); const f32x4 sh = *(const LAS f32x4*)(mod + b * 2048 + col), sc = *(const LAS f32x4*)(mod + b * 2048 + 1024 + col);
            const f32x4 r = v[j] * rstd * (sc + 1.0f) + sh; uint2 w; w.x = pkh(r.x, r.y); w.y = pkh(r.z, r.w); o8[64 * j] = w; }
    }
}
__device__ __forceinline__ void phase2(const P& p, int tid) {
    for (int idx = blockIdx.x * 512 + tid; idx < M * 32; idx += gridDim.x * 512) {
        const int t = idx >> 5, j8 = (idx & 31) * 8, col = 1536 + j8;
        f32x4 c0, c1, q0 = {0.f, 0.f, 0.f, 0.f}, q1 = {0.f, 0.f, 0.f, 0.f};
        load8h(p.zrw + (size_t)t * DRW + col, c0, c1); if (t & (SEQ - 1)) load8h(p.zrw + (size_t)(t - 1) * DRW + col, q0, q1);
        const f32x4 m0 = *(const f32x4*)(p.mu + col), m1 = *(const f32x4*)(p.mu + col + 4);
        c0 = c0 + m0 * (q0 - c0); c1 = c1 + m1 * (q1 - c1);
#pragma unroll
        for (int i = 0; i < 4; ++i) { if (j8 < 64) { c0[i] = tanhf(c0[i]); c1[i] = tanhf(c1[i]); } else if (j8 >= 128) { c0[i] = sigmoidf_(c0[i]); c1[i] = sigmoidf_(c1[i]); } }
        store8h(p.lin + (size_t)t * 256 + j8, c0, c1);
    }
}
constexpr int P64 = 72, P32 = 40;
constexpr int L_AM = 0, L_BM = 4608, L_KM = 9216, L_RM = 13824, L_AMT = 18432, L_BMT = 23552, L_KMT = 28672, L_VT = 33792, L_NR0 = 38912, L_NR1 = 41472, L_NT0 = 44032, L_NT1 = 46592,
              L_TR0 = 49152, L_TR1 = 51712, L_AAK = 54272, L_ARB = 56832, L_ARK = 59392, L_W1T = 61952, L_UT = 67072, L_TAT = 72192, L_CUM = 77312, L_GM = 85504, L_GL = 85760;
__device__ __forceinline__ int crow(int r, int hi) { return (r & 3) + 8 * (r >> 2) + 4 * hi; }
template <int KS> __device__ __forceinline__ f32x16 mm_tile(LAS unsigned char* A, int arow, int apitch, LAS unsigned char* B, int brow, int bpitch, f32x16 acc, int hi) {
#pragma unroll
    for (int s = 0; s < KS; ++s) { const h16x8 a = *(const LAS h16x8*)(A + (arow * apitch + 16 * s + 8 * hi) * 2), b = *(const LAS h16x8*)(B + (brow * bpitch + 16 * s + 8 * hi) * 2);
        acc = __builtin_amdgcn_mfma_f32_32x32x16_f16(a, b, acc, 0, 0, 0); }
    return acc;
}
__device__ __forceinline__ void wr_row(LAS unsigned char* arr, const f32x16& v, int n, int hi) {
#pragma unroll
    for (int r = 0; r < 16; ++r) ((LAS h16*)arr)[crow(r, hi) * P32 + n] = (h16)v[r];
}
__device__ __forceinline__ void wr_tr(LAS unsigned char* arr, const f32x16& v, int nrow, int hi) {
#pragma unroll
    for (int jj = 0; jj < 4; ++jj) { u32x2 w; w.x = pkh(v[4 * jj], v[4 * jj + 1]); w.y = pkh(v[4 * jj + 2], v[4 * jj + 3]); *(LAS u32x2*)(arr + (nrow * P32 + 8 * jj + 4 * hi) * 2) = w; }
}
__device__ __forceinline__ f32x16 zero16() { f32x16 z;
#pragma unroll
    for (int r = 0; r < 16; ++r) z[r] = 0.f;
    return z; }
constexpr int S_AM = 0, S_BM = 4608, S_KM = 9216, S_RM = 13824, S_AMT = 18432, S_BMT = 23552, S_KMT = 28672, S_VT = 33792, S_GM = 38912, S_GL = 39168, S_GF = 39424, SET_BYTES = 39680;
constexpr int X_NR0 = 79360, X_NR1 = X_NR0 + 2560, X_NT0 = X_NR0 + 5120, X_NT1 = X_NR0 + 7680, X_TR0 = X_NR0 + 10240, X_TR1 = X_NR0 + 12800, X_AAK = X_NR0 + 15360, X_ARB = X_NR0 + 17920, X_ARK = X_NR0 + 20480, X_W1T = X_NR0 + 23040, X_UT = X_NR0 + 28160, X_TAT = X_NR0 + 33280, X_CUM = X_NR0 + 38400;
static_assert(2 * SET_BYTES <= X_NR0 && X_CUM + 1024 <= RING_BYTES, "pre_phase LDS map");
#define PB_BAR() asm volatile("s_waitcnt lgkmcnt(0)\n\ts_barrier" ::: "memory")
__device__ __forceinline__ void pre_phase(const P& p, LAS unsigned char* sm, int lane, int wave) {
    const int G = (int)gridDim.x, nun = ((int)blockIdx.x < NPRE) ? (NPRE - (int)blockIdx.x + G - 1) / G : 0, r32 = lane & 31, hi = lane >> 5;
    LAS float* CUM = (LAS float*)(sm + X_CUM);
    if (wave >= 4) {
        const int pw = wave - 4;
        for (int k = 0; k <= nun; ++k) {
            float av[8], bv[8], kv[8], rv[8], vv[8], lwv[8], cumv[8];
            LAS unsigned char* set = sm + (k & 1) * SET_BYTES;
            if (k < nun) {
                const int unit = (int)blockIdx.x + k * G, bh = unit >> 8, c = unit & 255, b = bh >> 3, h = bh & 7, col = h * 64 + lane;
                const float mu_r = p.mu[col], mu_k = p.mu[512 + col], mu_v = p.mu[1024 + col], ckk = p.kk[col], cka = p.ka[col], crk = p.rk[col], cw0 = p.w0[col], ca0 = p.a0[col];
                float zr0[8], zk0[8], zv0[8], zr1[8], zk1[8], zv1[8], lo0[8], lo1[8], bonv[8];
                const size_t gm0 = (size_t)b * SEQ + c * 32 + pw * 8;
#pragma unroll
                for (int i = 0; i < 8; ++i) {
                    const int t = c * 32 + pw * 8 + i; const size_t gm = gm0 + i, gp = gm - (t > 0 ? 1 : 0);
                    const h16* zr = p.zrw + gm * DRW; const h16* zp = p.zrw + gp * DRW; const h16* lo = p.lout + gm * DLO;
                    zr0[i] = (float)zr[col]; zk0[i] = (float)zr[512 + col]; zv0[i] = (float)zr[1024 + col];
                    zr1[i] = (float)zp[col]; zk1[i] = (float)zp[512 + col]; zv1[i] = (float)zp[1024 + col];
                    lo0[i] = (float)lo[col]; lo1[i] = (float)lo[512 + col];
                }
#pragma unroll
                for (int i = 0; i < 8; ++i) {
                    const int t = c * 32 + pw * 8 + i; const float pm = t > 0 ? 1.f : 0.f;
                    float r = zr0[i], kx = zk0[i], v = zv0[i];
                    r += mu_r * (pm * zr1[i] - r); kx += mu_k * (pm * zk1[i] - kx); v += mu_v * (pm * zv1[i] - v);
                    const float xw = -(cw0 + lo0[i]), spw = fmaxf(xw, 0.f) + __logf(1.f + __expf(-fabsf(xw))), ar = sigmoidf_(ca0 + lo1[i]);
                    const float lw = -__expf(-spw - 0.5f);
                    const float kkv = kx * ckk, kkn = kkv * __builtin_amdgcn_rsqf(fmaxf(wave_sum(kkv * kkv), 1e-24f));
                    const float k2 = kx * (1.0f + (ar - 1.0f) * cka);
                    bonv[i] = wave_sum(r * k2 * crk);
                    av[i] = -kkn; bv[i] = kkn * ar; kv[i] = k2; rv[i] = r; vv[i] = v; lwv[i] = lw;
                }
                if (lane < 8) { float bsel = bonv[0];
#pragma unroll
                    for (int i = 1; i < 8; ++i) bsel = (lane == i) ? bonv[i] : bsel;
                    p.bon[(gm0 + lane) * 8 + h] = bsel; }
                cumv[0] = lwv[0];
#pragma unroll
                for (int i = 1; i < 8; ++i) cumv[i] = cumv[i - 1] + lwv[i];
                CUM[pw * 64 + lane] = cumv[7];
            }
            PB_BAR();
            if (k < nun) {
                const float t0 = CUM[lane], t1 = CUM[64 + lane], t2 = CUM[128 + lane], t3 = CUM[192 + lane];
                const float mid = t0 + t1, tot = (t0 + t1) + (t2 + t3), off = (pw > 0 ? t0 : 0.f) + (pw > 1 ? t1 : 0.f) + (pw > 2 ? t2 : 0.f);
                if (pw == 0) { ((LAS float*)(set + S_GM))[lane] = __expf(mid); ((LAS float*)(set + S_GL))[lane] = __expf(tot); ((LAS float*)(set + S_GF))[lane] = __expf(tot - mid); }
#pragma unroll
                for (int i = 0; i < 8; ++i) { const int tt = pw * 8 + i; const float cum = off + cumv[i], cp = cum - lwv[i];
                    const float e1 = __expf(mid - cum);
                    const h16 am = (h16)(av[i] * __expf(cp - mid)), bm = (h16)(bv[i] * e1), km = (h16)(kv[i] * e1), rm = (h16)(rv[i] * __expf(cum - mid));
                    ((LAS h16*)(set + S_AM))[tt * P64 + lane] = am; ((LAS h16*)(set + S_BM))[tt * P64 + lane] = bm; ((LAS h16*)(set + S_KM))[tt * P64 + lane] = km; ((LAS h16*)(set + S_RM))[tt * P64 + lane] = rm;
                    ((LAS h16*)(set + S_AMT))[lane * P32 + tt] = am; ((LAS h16*)(set + S_BMT))[lane * P32 + tt] = bm; ((LAS h16*)(set + S_KMT))[lane * P32 + tt] = km; ((LAS h16*)(set + S_VT))[lane * P32 + tt] = (h16)vv[i]; }
            }
            PB_BAR();
            PB_BAR();
        }
    } else {
        for (int k = 0; k <= nun; ++k) {
            const int unit = (int)blockIdx.x + (k - 1) * G, bh = unit >> 8, c = unit & 255, b = bh >> 3, h = bh & 7;
            LAS unsigned char* set = sm + ((k - 1) & 1) * SET_BYTES;
            LAS float* GM = (LAS float*)(set + S_GM); LAS float* GL = (LAS float*)(set + S_GL); LAS float* GF = (LAS float*)(set + S_GF);
            if (k >= 1) {
                f32x16 acc = mm_tile<4>(set + (wave < 2 ? S_AM : S_RM), r32, P64, set + ((wave & 1) ? S_KM : S_BM), r32, P64, zero16(), hi);
#pragma unroll
                for (int r = 0; r < 16; ++r) { const int t = crow(r, hi); const bool keep = (wave < 2) ? (r32 < t) : (r32 <= t); acc[r] = keep ? acc[r] : 0.f; }
                if (wave == 0) {
                    wr_row(sm + X_NR0, acc, r32, hi); wr_tr(sm + X_NT0, acc, r32, hi);
                    f32x16 tacc = acc;
#pragma unroll
                    for (int r = 0; r < 16; ++r) if (crow(r, hi) == r32) tacc[r] += 1.0f;
                    wr_row(sm + X_TR0, tacc, r32, hi);
#pragma unroll
                    for (int i = 0; i < 4; ++i) {
                        LAS unsigned char* nr = sm + ((i & 1) ? X_NR1 : X_NR0); LAS unsigned char* nt = sm + ((i & 1) ? X_NT1 : X_NT0);
                        LAS unsigned char* nr2 = sm + ((i & 1) ? X_NR0 : X_NR1); LAS unsigned char* nt2 = sm + ((i & 1) ? X_NT0 : X_NT1);
                        LAS unsigned char* tr = sm + ((i & 1) ? X_TR1 : X_TR0); LAS unsigned char* tr2 = sm + ((i & 1) ? X_TR0 : X_TR1);
                        const f32x16 nacc = mm_tile<2>(nr, r32, P32, nt, r32, P32, zero16(), hi);
                        wr_row(nr2, nacc, r32, hi); wr_tr(nt2, nacc, r32, hi);
                        tacc = mm_tile<2>(tr, r32, P32, nt2, r32, P32, tacc, hi);
                        wr_row(tr2, tacc, r32, hi);
                    }
                } else if (wave == 1) {
                    wr_row(sm + X_AAK, acc, r32, hi);
#pragma unroll
                    for (int vt = 0; vt < 2; ++vt) { const f32x16 w1 = mm_tile<2>(sm + X_AAK, r32, P32, set + S_VT, 32 * vt + r32, P32, zero16(), hi); wr_tr(sm + X_W1T, w1, 32 * vt + r32, hi); }
                } else if (wave == 2) wr_row(sm + X_ARB, acc, r32, hi);
                else wr_row(sm + X_ARK, acc, r32, hi);
            }
            PB_BAR();
            if (k >= 1) {
                if (wave < 2) { const f32x16 u = mm_tile<2>(sm + X_TR0, r32, P32, sm + X_W1T, 32 * wave + r32, P32, zero16(), hi); wr_tr(sm + X_UT, u, 32 * wave + r32, hi); }
                else { const f32x16 ta = mm_tile<2>(sm + X_TR0, r32, P32, set + S_AMT, 32 * (wave - 2) + r32, P32, zero16(), hi); wr_tr(sm + X_TAT, ta, 32 * (wave - 2) + r32, hi); }
            }
            PB_BAR();
            if (k >= 1) {
                {   const int kt = wave >> 1, mt = wave & 1, kk = 32 * mt + r32;
                    const f32x16 x = mm_tile<2>(sm + X_TAT, 32 * kt + r32, P32, set + S_BMT, kk, P32, zero16(), hi);
                    const float gl = GL[kk], f1 = GF[kk]; float pv[16];
#pragma unroll
                    for (int r = 0; r < 16; ++r) { const int k2 = 32 * kt + crow(r, hi); pv[r] = f1 * x[r] * GM[k2] + (k2 == kk ? gl : 0.f); }
                    u32x4 w0, w1; w0.x = pkh(pv[0], pv[1]); w0.y = pkh(pv[2], pv[3]); w0.z = pkh(pv[4], pv[5]); w0.w = pkh(pv[6], pv[7]); w1.x = pkh(pv[8], pv[9]); w1.y = pkh(pv[10], pv[11]); w1.z = pkh(pv[12], pv[13]); w1.w = pkh(pv[14], pv[15]);
                    u32x4* dst = (u32x4*)p.pbuf + (size_t)unit * 512 + (mt * 4 + 2 * kt) * 64 + lane;
                    dst[0] = w0; dst[64] = w1; }
                if (wave < 2) {
                    const int kt = wave;
                    const f32x16 x = mm_tile<2>(sm + X_TAT, 32 * kt + r32, P32, sm + X_ARB, r32, P32, zero16(), hi);
                    float pv[16];
#pragma unroll
                    for (int r = 0; r < 16; ++r) { const int k2 = 32 * kt + crow(r, hi); pv[r] = (x[r] + (float)((LAS h16*)(set + S_RM))[r32 * P64 + k2]) * GM[k2]; }
                    u32x4 w0, w1; w0.x = pkh(pv[0], pv[1]); w0.y = pkh(pv[2], pv[3]); w0.z = pkh(pv[4], pv[5]); w0.w = pkh(pv[6], pv[7]); w1.x = pkh(pv[8], pv[9]); w1.y = pkh(pv[10], pv[11]); w1.z = pkh(pv[12], pv[13]); w1.w = pkh(pv[14], pv[15]);
                    u32x4* dst = (u32x4*)p.rbuf + (size_t)unit * 256 + (2 * kt) * 64 + lane;
                    dst[0] = w0; dst[64] = w1;
                } else {
                    const int vt = wave - 2;
                    f32x16 y = mm_tile<2>(sm + X_ARB, r32, P32, sm + X_UT, 32 * vt + r32, P32, zero16(), hi);
                    y = mm_tile<2>(sm + X_ARK, r32, P32, set + S_VT, 32 * vt + r32, P32, y, hi);
                    h16* dst = p.ya + ((size_t)b * SEQ + c * 32) * DH + h * 64 + 32 * vt + r32;
#pragma unroll
                    for (int r = 0; r < 16; ++r) dst[(size_t)crow(r, hi) * DH] = (h16)y[r];
                }
                {   const int mt = wave >> 1, vt = wave & 1;
                    f32x16 q = mm_tile<2>(set + S_BMT, 32 * mt + r32, P32, sm + X_UT, 32 * vt + r32, P32, zero16(), hi);
                    q = mm_tile<2>(set + S_KMT, 32 * mt + r32, P32, set + S_VT, 32 * vt + r32, P32, q, hi);
                    unsigned qw[8];
#pragma unroll
                    for (int r2 = 0; r2 < 8; ++r2) { const int k0 = 32 * mt + crow(2 * r2, hi), k1 = 32 * mt + crow(2 * r2 + 1, hi);
                        qw[r2] = pkh(q[2 * r2] * GF[k0], q[2 * r2 + 1] * GF[k1]); }
                    u32x4* dst = (u32x4*)(p.qbuf + (size_t)unit * 2048 + ((vt * 2 + mt) * 64 + lane) * 8);
                    dst[0] = (u32x4){qw[0], qw[1], qw[2], qw[3]}; dst[1] = (u32x4){qw[4], qw[5], qw[6], qw[7]}; }
            }
            PB_BAR();
        }
    }
    __syncthreads();
}
#undef PB_BAR
__device__ __forceinline__ float h_lo(unsigned w) { return (float)__builtin_bit_cast(h16x2, w)[0]; }
__device__ __forceinline__ float h_hi(unsigned w) { return (float)__builtin_bit_cast(h16x2, w)[1]; }
struct LdSet { u32x4 v[11]; };
__device__ __forceinline__ void chain_ld(LdSet& d, const unsigned char* pb, const unsigned char* qb, int grp, int lt) {
#pragma unroll
    for (int i = 0; i < 11; ++i) { const int idx = lt + i * 384; if (idx < 4096) { const int ch = idx >> 10, w = idx & 1023; const size_t u = (size_t)(grp * 4 + ch) * 8192;
        d.v[i] = *(const u32x4*)((w < 512 ? pb : qb - 8192) + u + (size_t)w * 16); } }
}
__device__ __forceinline__ void chain_st(const LdSet& d, LAS unsigned char* set, int lt) {
    LAS unsigned char* b = set + lt * 16;
#pragma unroll
    for (int i = 0; i < 10; ++i) *(LAS u32x4*)(b + i * 6144) = d.v[i];
    if (lt < 256) *(LAS u32x4*)(b + 10 * 6144) = d.v[10];
}
__device__ __forceinline__ void chain_group(LAS unsigned char* pbase, LAS unsigned char* qbase, f32x16& c0, f32x16& c1, u32x4* sdst) {
#pragma unroll
    for (int cc = 0; cc < 4; ++cc) {
        h16x8 pa[8]; u32x4 q[4];
#pragma unroll
        for (int i = 0; i < 8; ++i) pa[i] = *(const LAS h16x8*)(pbase + cc * 16384 + i * 1024);
#pragma unroll
        for (int i = 0; i < 4; ++i) q[i] = *(const LAS u32x4*)(qbase + cc * 16384 + (i >> 1) * 2048 + (i & 1) * 16);
        h16x8 bs[4];
#pragma unroll
        for (int e = 0; e < 8; ++e) { bs[0][e] = (h16)c0[e]; bs[1][e] = (h16)c0[8 + e]; bs[2][e] = (h16)c1[e]; bs[3][e] = (h16)c1[8 + e]; }
#pragma unroll
        for (int s = 0; s < 4; ++s) sdst[cc * 512 + s * 64] = __builtin_bit_cast(u32x4, bs[s]);
        f32x16 n0, n1;
#pragma unroll
        for (int w = 0; w < 4; ++w) { n0[2 * w] = h_lo(q[0][w]); n0[2 * w + 1] = h_hi(q[0][w]); n0[8 + 2 * w] = h_lo(q[1][w]); n0[8 + 2 * w + 1] = h_hi(q[1][w]);
                                      n1[2 * w] = h_lo(q[2][w]); n1[2 * w + 1] = h_hi(q[2][w]); n1[8 + 2 * w] = h_lo(q[3][w]); n1[8 + 2 * w + 1] = h_hi(q[3][w]); }
#pragma unroll
        for (int s = 0; s < 4; ++s) { n0 = __builtin_amdgcn_mfma_f32_32x32x16_f16(pa[s], bs[s], n0, 0, 0, 0); n1 = __builtin_amdgcn_mfma_f32_32x32x16_f16(pa[4 + s], bs[s], n1, 0, 0, 0); }
        c0 = n0; c1 = n1;
        asm volatile("" ::: "memory");
    }
}
__device__ __forceinline__ void chain_block(const P& p, LAS unsigned char* sm, int bh, int tid, int lane, int wave) {
    const unsigned char* pb = (const unsigned char*)p.pbuf + (size_t)bh * 256 * 8192;
    const unsigned char* qb = (const unsigned char*)p.qbuf + (size_t)bh * 256 * 8192;
    const int lt = tid - 128;
#define CH_BAR() asm volatile("s_waitcnt lgkmcnt(0)\n\ts_barrier" ::: "memory")
    if (wave >= 2) {
        LdSet A, B;
        chain_ld(A, pb, qb, 0, lt); chain_ld(B, pb, qb, 1, lt); chain_st(A, sm, lt); chain_ld(A, pb, qb, 2, lt);
        CH_BAR();
        for (int g = 0; g < 64; g += 2) {
            chain_st(B, sm + 65536, lt); if (g + 3 < 64) chain_ld(B, pb, qb, g + 3, lt);
            CH_BAR();
            if (g + 2 < 64) { chain_st(A, sm, lt); if (g + 4 < 64) chain_ld(A, pb, qb, g + 4, lt); }
            CH_BAR();
        }
    } else {
        f32x16 c0 = zero16(), c1 = zero16();
        u32x4* sbase = (u32x4*)p.qbuf + (size_t)bh * 256 * 512 + wave * 256 + lane;
        LAS unsigned char* pbase = sm + lane * 16; LAS unsigned char* qbase = sm + 8192 + (wave * 128 + lane) * 32;
        CH_BAR();
        for (int g = 0; g < 64; g += 2) {
            chain_group(pbase, qbase, c0, c1, sbase + (size_t)(g * 4) * 512);
            CH_BAR();
            chain_group(pbase + 65536, qbase + 65536, c0, c1, sbase + (size_t)((g + 1) * 4) * 512);
            CH_BAR();
        }
    }
#undef CH_BAR
    __syncthreads();
}
__device__ __forceinline__ void phase2v(const P& p, LAS unsigned char* lds, int tid) {
    for (int tile = blockIdx.x; tile < 256; tile += gridDim.x) {
        const int b = tile >> 7, tl = tile & 127; const size_t m0 = (size_t)b * SEQ + tl * 64;
#pragma unroll
        for (int i = 0; i < 8; ++i) { const int idx = tid + i * 512, key = idx >> 6, ch = idx & 63; *(LAS u32x4*)(lds + key * 1040 + ch * 16) = *(const u32x4*)(p.qkv + (m0 + key) * DQKV + 1024 + ch * 8); }
        __syncthreads();
#pragma unroll
        for (int i = 0; i < 8; ++i) { const int o = tid + i * 512, h = o >> 9, g = (o >> 6) & 7, d = o & 63, ks = g >> 1, hk = g & 1; unsigned short e[8];
#pragma unroll
            for (int j = 0; j < 8; ++j) e[j] = ((const LAS unsigned short*)lds)[(16 * ks + 8 * (j >> 2) + 4 * hk + (j & 3)) * 520 + h * 64 + d];
            u32x4 w; w.x = e[0] | ((unsigned)e[1] << 16); w.y = e[2] | ((unsigned)e[3] << 16); w.z = e[4] | ((unsigned)e[5] << 16); w.w = e[6] | ((unsigned)e[7] << 16);
            ((u32x4*)p.vt)[((((size_t)(b * 8 + h) * 128 + tl) * 8 + g) * 64 + d)] = w; }
        __syncthreads();
    }
}
struct KVF { h16x8 k[8]; u32x4 v[8]; };
__device__ __forceinline__ void attn_ld(KVF& f, const h16* kbase, const u32x4* vtb, int jt) {
    const h16* kp = kbase + (size_t)(jt * 64) * DQKV;
#pragma unroll
    for (int d0 = 0; d0 < 4; ++d0) { f.k[2 * d0] = *(const h16x8*)(kp + d0 * 16); f.k[2 * d0 + 1] = *(const h16x8*)(kp + (size_t)32 * DQKV + d0 * 16); }
    const u32x4* vp = vtb + (size_t)jt * 512;
#pragma unroll
    for (int ks = 0; ks < 4; ++ks) { f.v[2 * ks] = vp[ks * 128]; f.v[2 * ks + 1] = vp[ks * 128 + 32]; }
}
__device__ __forceinline__ void attn_wave_unit(const P& p, int unit, int lane) {
    const int bh = unit >> 8, qblk = unit & 255, b = bh >> 3, h = bh & 7, qw0 = qblk * 32, r32 = lane & 31, hi = lane >> 5, qabs = qw0 + r32;
    const h16* base = p.qkv + (size_t)b * SEQ * DQKV + h * 64;
    const h16* kbase = base + 512 + (size_t)r32 * DQKV + hi * 8;
    const u32x4* vtb = (const u32x4*)p.vt + (size_t)bh * 128 * 512 + hi * 64 + r32;
    h16x8 qf[4];
#pragma unroll
    for (int d0 = 0; d0 < 4; ++d0) qf[d0] = *(const h16x8*)(base + (size_t)(qw0 + r32) * DQKV + d0 * 16 + hi * 8);
    f32x16 o0 = zero16(), o1 = zero16();
    float carry = 1.f;
    KVF cur, nxt;
    int jt = (qw0 + 31) >> 6;
    attn_ld(cur, kbase, vtb, jt);
    for (; jt >= 0; --jt) {
        const int k0 = jt * 64;
        if (jt > 0) attn_ld(nxt, kbase, vtb, jt - 1);
        f32x16 p0 = zero16(), p1 = zero16();
#pragma unroll
        for (int d0 = 0; d0 < 4; ++d0) { p0 = __builtin_amdgcn_mfma_f32_32x32x16_f16(cur.k[2 * d0], qf[d0], p0, 0, 0, 0); p1 = __builtin_amdgcn_mfma_f32_32x32x16_f16(cur.k[2 * d0 + 1], qf[d0], p1, 0, 0, 0); }
        float M0[16], M1[16];
#pragma unroll
        for (int r = 0; r < 16; ++r) { const int key = k0 + crow(r, hi);
            const float m0 = __builtin_amdgcn_rcpf(1.f + __builtin_amdgcn_exp2f(p0[r])), m1 = __builtin_amdgcn_rcpf(1.f + __builtin_amdgcn_exp2f(p1[r]));
            M0[r] = (key < qabs) ? m0 : 1.f; M1[r] = (key + 32 < qabs) ? m1 : 1.f; }
        float Gs[8], PG[8], sgo[8];
#pragma unroll
        for (int j = 0; j < 4; ++j) { Gs[j] = (M0[4 * j] * M0[4 * j + 1]) * (M0[4 * j + 2] * M0[4 * j + 3]); Gs[4 + j] = (M1[4 * j] * M1[4 * j + 1]) * (M1[4 * j + 2] * M1[4 * j + 3]); }
#pragma unroll
        for (int j = 0; j < 8; ++j) PG[j] = __shfl_xor(Gs[j], 32);
        float run = 1.f;
#pragma unroll
        for (int j = 7; j >= 0; --j) { const float ev = hi ? PG[j] : Gs[j], od = hi ? Gs[j] : PG[j]; const float so = run; run *= od; const float se = run; run *= ev; sgo[j] = hi ? so : se; }
        h16x8 pa[4];
#pragma unroll
        for (int j = 0; j < 4; ++j) {
            float acc = carry * sgo[j], acc1 = carry * sgo[4 + j];
#pragma unroll
            for (int i = 3; i >= 0; --i) { const int r = 4 * j + i;
                const float a0 = acc * (1.f - M0[r]); acc *= M0[r];
                const float a1 = acc1 * (1.f - M1[r]); acc1 *= M1[r];
                pa[j >> 1][(j & 1) * 4 + i] = (h16)a0; pa[2 + (j >> 1)][(j & 1) * 4 + i] = (h16)a1; }
        }
        carry *= run;
#pragma unroll
        for (int ks = 0; ks < 4; ++ks) { o0 = __builtin_amdgcn_mfma_f32_32x32x16_f16(pa[ks], __builtin_bit_cast(h16x8, cur.v[2 * ks]), o0, 0, 0, 0); o1 = __builtin_amdgcn_mfma_f32_32x32x16_f16(pa[ks], __builtin_bit_cast(h16x8, cur.v[2 * ks + 1]), o1, 0, 0, 0); }
        if (__all(carry < 1.1754944e-38f)) break;
        cur = nxt;
    }
    h16* ob = p.ob + ((size_t)b * SEQ + qw0) * DH + h * 64;
#pragma unroll
    for (int r = 0; r < 16; ++r) { const int q = crow(r, hi); ob[(size_t)q * DH + r32] = (h16)o0[r]; ob[(size_t)q * DH + 32 + r32] = (h16)o1[r]; }
}
__device__ __forceinline__ void phase4b(const P& p, LAS unsigned char* lds, int lane, int wave) {
    const int gw = blockIdx.x * 8 + wave, NGW = gridDim.x * 8, r32 = lane & 31, hi = lane >> 5;
    LAS float* yt = (LAS float*)(lds + wave * 8448);
    for (int unit = gw; unit < NPRE; unit += NGW) {
        const int bh = unit >> 8, c = unit & 255, b = bh >> 3, h = bh & 7; const size_t tok0 = (size_t)b * SEQ + c * 32;
        h16x8 ra[4];
#pragma unroll
        for (int s = 0; s < 4; ++s) ra[s] = __builtin_bit_cast(h16x8, ((const u32x4*)p.rbuf)[(size_t)unit * 256 + s * 64 + lane]);
#pragma unroll
        for (int vt = 0; vt < 2; ++vt) {
            const h16* yl = p.ya + tok0 * DH + h * 64 + 32 * vt + r32; f32x16 y;
#pragma unroll
            for (int r = 0; r < 16; ++r) y[r] = (float)yl[(size_t)crow(r, hi) * DH];
#pragma unroll
            for (int s = 0; s < 4; ++s) { const h16x8 sb = __builtin_bit_cast(h16x8, ((const u32x4*)p.qbuf)[(size_t)unit * 512 + vt * 256 + s * 64 + lane]); y = __builtin_amdgcn_mfma_f32_32x32x16_f16(ra[s], sb, y, 0, 0, 0); }
#pragma unroll
            for (int r = 0; r < 16; ++r) yt[crow(r, hi) * 66 + 32 * vt + r32] = y[r];
        }
        const int col = h * 64 + lane; const float gg = p.gn_g[col], gb = p.gn_b[col], muv = p.mu[1024 + col];
#pragma unroll 4
        for (int t = 0; t < 32; ++t) {
            const size_t gm = tok0 + t;
            const float y = yt[t * 66 + lane], mean = wave_sum(y) * (1.f / 64.f), d = y - mean, var = wave_sum(d * d) * (1.f / 64.f);
            const float gn = d * __builtin_amdgcn_rsqf(var + GN_EPS) * gg + gb;
            float v = (float)p.zrw[gm * DRW + 1024 + col], vp = 0.f; if (c * 32 + t > 0) vp = (float)p.zrw[(gm - 1) * DRW + 1024 + col];
            v += muv * (vp - v);
            const float g = (float)p.lout[gm * DLO + 1024 + col], bon = p.bon[gm * 8 + h];
            p.ya[gm * DH + col] = (h16)((gn + bon * v) * g);
        }
    }
}
template <bool FINAL> __device__ __forceinline__ void phase_ln(const P& p, int lane, int wave) {
    const int gw = blockIdx.x * 8 + wave, NGW = gridDim.x * 8;
    const float* lg = FINAL ? p.ln2g : p.ln1g; const float* lb = FINAL ? p.ln2b : p.ln1b;
    for (int m = gw; m < M; m += NGW) {
        f32x4* xr = (f32x4*)(p.out + (size_t)m * D) + lane; const int b = m >> 13;
        f32x4 v[4]; float s = 0.f;
#pragma unroll
        for (int j = 0; j < 4; ++j) { v[j] = xr[64 * j]; s += (v[j].x + v[j].y) + (v[j].z + v[j].w); }
        float mean = wave_sum(s) * (1.f / D), s2 = 0.f;
#pragma unroll
        for (int j = 0; j < 4; ++j) { v[j] = v[j] - mean; s2 += (v[j].x * v[j].x + v[j].y * v[j].y) + (v[j].z * v[j].z + v[j].w * v[j].w); }
        float rstd = 1.f / sqrtf(wave_sum(s2) * (1.f / D) + LN_EPS);
        s = 0.f;
#pragma unroll
        for (int j = 0; j < 4; ++j) { const int col = 4 * (lane + 64 * j); v[j] = v[j] * rstd * *(const f32x4*)(lg + col) + *(const f32x4*)(lb + col); xr[64 * j] = v[j]; s += (v[j].x + v[j].y) + (v[j].z + v[j].w); }
        if (!FINAL) {
            mean = wave_sum(s) * (1.f / D); s2 = 0.f;
#pragma unroll
            for (int j = 0; j < 4; ++j) { v[j] = v[j] - mean; s2 += (v[j].x * v[j].x + v[j].y * v[j].y) + (v[j].z * v[j].z + v[j].w * v[j].w); }
            rstd = 1.f / sqrtf(wave_sum(s2) * (1.f / D) + ADA_EPS);
            uint2* o8 = (uint2*)(p.h + (size_t)m * D) + lane; const float* ad = p.ada + b * 6144;
#pragma unroll
            for (int j = 0; j < 4; ++j) { const int col = 4 * (lane + 64 * j); const f32x4 sh = *(const f32x4*)(ad + 3072 + col), sc = *(const f32x4*)(ad + 4096 + col);
                const f32x4 r = v[j] * rstd * (sc + 1.0f) + sh; uint2 w; w.x = pkh(r.x, r.y); w.y = pkh(r.z, r.w); o8[64 * j] = w; }
        }
    }
}

typedef __attribute__((address_space(4))) const unsigned char* kargp_t;
__device__ __forceinline__ void make_p(P& p) {
    kargp_t ka = (kargp_t)__builtin_amdgcn_kernarg_segment_ptr(); asm volatile("" : "+s"(ka));
    const float* const __attribute__((address_space(4)))* in = (const float* const __attribute__((address_space(4)))*)ka;
    p.x = in[0]; p.c = in[1]; p.w_ada = in[2]; p.b_ada = in[3]; p.w_in = in[4]; p.mu = in[5]; p.w0 = in[6]; p.w2 = in[7]; p.a0 = in[8]; p.a2 = in[9]; p.g2 = in[10];
    p.kk = in[11]; p.ka = in[12]; p.rk = in[13]; p.gn_g = in[14]; p.gn_b = in[15]; p.wba = in[16]; p.wbb = in[17]; p.wout = in[18]; p.ln1g = in[19]; p.ln1b = in[20];
    p.w1 = in[21]; p.b1 = in[22]; p.wf2 = in[23]; p.b2 = in[24]; p.ln2g = in[25]; p.ln2b = in[26];
    p.out = (float*)in[27]; unsigned char* ws = (unsigned char*)in[28]; p.ws = ws;
    p.ctl = (unsigned*)(ws + WS_CTL); p.adap = (float*)(ws + WS_ADAP); p.ada = (float*)(ws + WS_ADA); p.bon = (float*)(ws + WS_BON);
    p.win_t = (h16*)(ws + WS_WIN); p.wlora_t = (h16*)(ws + WS_WLORA); p.wba_t = (h16*)(ws + WS_WBA); p.wbb_t = (h16*)(ws + WS_WBB); p.wout_t = (h16*)(ws + WS_WOUT); p.w1_t = (h16*)(ws + WS_W1); p.w2_t = (h16*)(ws + WS_W2);
    p.h = (h16*)(ws + WS_H16); p.zrw = (h16*)(ws + WS_ZRW); p.qkv = (h16*)(ws + WS_QKV); p.lin = (h16*)(ws + WS_LIN); p.lout = (h16*)(ws + WS_LOUT); p.mrg = (h16*)(ws + WS_MRG); p.hid = (h16*)(ws + WS_HID);
    p.pbuf = (h16*)(ws + WS_PB); p.rbuf = (h16*)(ws + WS_RB); p.qbuf = (unsigned*)(ws + WS_QB); p.vt = (h16*)(ws + WS_H16); p.ya = (h16*)(ws + WS_H16); p.ob = (h16*)(ws + WS_H16 + 16 * MiB); p.gates = (h16*)p.out;
}
__global__ void __launch_bounds__(512, 2) mk_fwd(KArgs a) {
    extern __shared__ __attribute__((aligned(16))) unsigned char lds_raw[];
    LAS unsigned char* lds = (LAS unsigned char*)lds_raw;
    volatile LAS unsigned* MISC = (volatile LAS unsigned*)(lds + MISC_OFF);
    int tid = threadIdx.x, lane = tid & 63, wave = __builtin_amdgcn_readfirstlane(tid >> 6);
#define FRESH() do { tid = threadIdx.x; asm volatile("" : "+v"(tid)); lane = tid & 63; wave = __builtin_amdgcn_readfirstlane(tid >> 6); make_p(p); } while (0)
    P p; make_p(p);
    for (int u = tid; u < (LDS_BYTES - RING_BYTES) / 4; u += 512) ((LAS unsigned*)(lds + RING_BYTES))[u] = 0u;
    __syncthreads();
    XcdBarrier bar = xcd_barrier_post(p.ctl + CW_BAR, MISC + 8);
#define GRID_BAR() xcd_barrier(bar)

    FRESH();
    phase0(p, lds, tid, lane, wave);
    if (gridDim.x == 0x7fffffffu) cg::this_grid().sync();
    GRID_BAR();
    FRESH();
    phase0b(p, lds, tid, lane, wave);
    GRID_BAR();
    FRESH();
    run_gemm(lds, p.h, p.win_t, DIN, D, F1{p.zrw, p.qkv, p.gates});
    GRID_BAR();
    FRESH();
    phase2(p, tid);
    phase2v(p, lds, tid);
    GRID_BAR();
    FRESH();
    run_gemm(lds, p.lin, p.wlora_t, DLO, 256, F3{p.lout});
    FRESH();
    {
        const unsigned myq = bar.x & 7u;
        for (unsigned qi = 0; qi < 8u; ++qi) {
            const unsigned qx = (myq + qi) & 7u;
            for (;;) {
                unsigned u = 0; if (lane == 0) u = atomicAdd(p.ctl + CW_ATTQ + 64 * qx, 1u);
                u = (unsigned)__builtin_amdgcn_readfirstlane((int)u);
                if (u >= 512u) break;
                attn_wave_unit(p, (int)(((qx + 8u * (u >> 8)) << 8) | (u & 255u)), lane);
            }
        }
    }
    GRID_BAR();
    FRESH();
    pre_phase(p, lds, lane, wave);
    GRID_BAR();
    FRESH();
    if ((int)blockIdx.x < NCHAINB) chain_block(p, lds, (int)blockIdx.x, tid, lane, wave);
    else { run_gemm(lds, p.ob, p.wbb_t, D, DH, F5Y{p.gates}, (int)gridDim.x - NCHAINB, (int)blockIdx.x - NCHAINB);
           __syncthreads(); FRESH(); phase0_late(p, lds, lane, wave, (int)gridDim.x - NCHAINB, (int)blockIdx.x - NCHAINB); }
    GRID_BAR();
    FRESH();
    phase4b(p, lds, lane, wave);
    GRID_BAR();
    FRESH();
    run_gemm(lds, p.ya, p.wba_t, D, DH, F5X{p.mrg, p.gates});
    GRID_BAR();
    FRESH();
    run_gemm(lds, p.mrg, p.wout_t, D, D, F6{p.x, p.out, p.ada});
    GRID_BAR();
    FRESH();
    phase_ln<false>(p, lane, wave);
    GRID_BAR();
    FRESH();
    run_gemm(lds, p.h, p.w1_t, DFF, D, F8{p.hid, p.b1});
    GRID_BAR();
    FRESH();
    run_gemm(lds, p.hid, p.w2_t, D, DFF, F9{p.out, p.ada, p.b2});
    GRID_BAR();
    FRESH();
    phase_ln<true>(p, lane, wave);
}

extern "C" void kernel_launch(void* const* d_in, const int* in_sizes, int n_in, void* d_out, int out_size, void* d_ws, size_t ws_size, hipStream_t stream) {
    static int grid = 0;
    if (grid == 0) {
        if (n_in != 27 || out_size != M * D || ws_size < WS_END) { fprintf(stderr, "kernel_launch: unexpected shapes (n_in %d, out %d, ws %zu)\n", n_in, out_size, ws_size); grid = -1; return; }
        int dev = 0, cus = 0, per_cu = 0;
        hipGetDevice(&dev); hipDeviceGetAttribute(&cus, hipDeviceAttributeMultiprocessorCount, dev);
        if (hipFuncSetAttribute((const void*)mk_fwd, hipFuncAttributeMaxDynamicSharedMemorySize, LDS_BYTES) != hipSuccess) { fprintf(stderr, "kernel_launch: hipFuncSetAttribute failed\n"); grid = -1; return; }
        hipOccupancyMaxActiveBlocksPerMultiprocessor(&per_cu, (const void*)mk_fwd, 512, LDS_BYTES);
        (void)hipGetLastError();
        if (per_cu < 1) fprintf(stderr, "kernel_launch: occupancy query says %d blocks per CU\n", per_cu);
        grid = cus;
    }
    if (grid < 0) return;
    hipMemsetAsync((char*)d_ws + WS_CTL, 0, CTL_ZERO_BYTES, stream);
    KArgs a{};
    for (int i = 0; i < 27; ++i) a.in[i] = (const float*)d_in[i];
    a.out = (float*)d_out; a.ws = (unsigned char*)d_ws;
    void* args[] = {&a};
    hipError_t e = hipLaunchCooperativeKernel((const void*)mk_fwd, dim3(grid), dim3(512), args, LDS_BYTES, stream);
    if (e != hipSuccess) fprintf(stderr, "cooperative launch failed: %s (grid %d)\n", hipGetErrorString(e), grid);
}
```
